# Optimizing an MI355X kernel written in HIP

```python
import math
import jax
import jax.numpy as jnp
from jax import lax
import numpy as np

D_MODEL = 2048
BATCH = 1
SEQ = 8192
DEPTH = 1

N_META = 16
GDN_HEADS = 8
GDN_DIM = 128
GDN_WIDTH = GDN_HEADS * GDN_DIM
CONV_WIDTH = 4
CHUNK = 64
DIFF_HEADS = 8
DIFF_DIM = 64
DIFF_VDIM = 2 * DIFF_DIM
DIFF_QK_WIDTH = DIFF_HEADS * 2 * DIFF_DIM
DIFF_WIDTH = DIFF_HEADS * DIFF_VDIM
Q_BLOCK = 128
ROPE_THETA = 10000.0
MIX_WIDTH = GDN_WIDTH + DIFF_WIDTH
PROJ_SIZES = (GDN_WIDTH, GDN_WIDTH, GDN_WIDTH, GDN_WIDTH, GDN_HEADS, GDN_HEADS,
              DIFF_QK_WIDTH, DIFF_QK_WIDTH, DIFF_WIDTH)
PROJ_WIDTH = 4 * GDN_WIDTH + 2 * GDN_HEADS + 2 * DIFF_QK_WIDTH + DIFF_WIDTH
D_FF = (8 * D_MODEL + 3 * 256 - 1) // (3 * 256) * 256
NORM_EPS = 1e-6
MASK_VALUE = -1e30

kernel_name = "hymba_gdn_diffattn_swiglu"


def rms_norm(x, gain):
    xf = x.astype(jnp.float32)
    y = xf * lax.rsqrt(jnp.mean(xf * xf, axis=-1, keepdims=True) + NORM_EPS) * gain.astype(jnp.float32)
    return y.astype(x.dtype)


def l2_normalize(x):
    return x * lax.rsqrt(jnp.sum(x * x, axis=-1, keepdims=True) + NORM_EPS)


def causal_conv(x, w):
    L = x.shape[1]
    xp = jnp.pad(x, ((0, 0), (CONV_WIDTH - 1, 0), (0, 0)))
    y = xp[:, 0:L] * w[0]
    for j in range(1, CONV_WIDTH):
        y = y + xp[:, j:j + L] * w[j]
    return y


def rotary(x, positions):
    half = DIFF_DIM // 2
    inv_freq = ROPE_THETA ** (-jnp.arange(half, dtype=jnp.float32) / half)
    ang = positions.astype(jnp.float32)[:, None] * inv_freq[None, :]
    cos = jnp.cos(ang)[None, :, None, None, :]
    sin = jnp.sin(ang)[None, :, None, None, :]
    xf = x.astype(jnp.float32)
    x1, x2 = xf[..., :half], xf[..., half:]
    return jnp.concatenate([x1 * cos - x2 * sin, x2 * cos + x1 * sin], axis=-1).astype(x.dtype)


def gated_deltanet(q, k, v, z, b, a, conv_w, a_log, dt_bias, o_gain):
    B, L, _ = q.shape
    out_dtype = q.dtype
    qkv = jax.nn.silu(causal_conv(jnp.concatenate([q, k, v], axis=-1), conv_w))
    q, k, v = jnp.split(qkv, 3, axis=-1)
    heads = lambda t: t.reshape(B, L, GDN_HEADS, GDN_DIM).astype(jnp.float32)
    q = l2_normalize(heads(q)) * (GDN_DIM ** -0.5)
    k = l2_normalize(heads(k))
    v = heads(v)
    beta = jax.nn.sigmoid(b.astype(jnp.float32))
    g = -jnp.exp(a_log.astype(jnp.float32)) * jax.nn.softplus(
        a.astype(jnp.float32) + dt_bias.astype(jnp.float32))

    pad = (-L) % CHUNK
    n_chunks = (L + pad) // CHUNK

    def to_chunks(t):
        t = jnp.pad(t, [(0, 0), (pad, 0)] + [(0, 0)] * (t.ndim - 2))
        t = t.reshape((B, n_chunks, CHUNK) + t.shape[2:])
        return jnp.moveaxis(t, 3, 1)

    q, k, v, beta, g = to_chunks(q), to_chunks(k), to_chunks(v), to_chunks(beta), to_chunks(g)
    gc = jnp.cumsum(g, axis=-1)
    idx = jnp.arange(CHUNK)
    incl = idx[:, None] >= idx[None, :]
    strict = idx[:, None] > idx[None, :]
    decay = jnp.exp(jnp.where(incl, gc[..., :, None] - gc[..., None, :], MASK_VALUE))

    k_beta = k * beta[..., None]
    v_beta = v * beta[..., None]
    lmat = jnp.where(strict, jnp.einsum('bhncd,bhnsd->bhncs', k_beta, k) * decay, 0.0)
    eye = jnp.broadcast_to(jnp.eye(CHUNK, dtype=jnp.float32), lmat.shape)
    t_inv = lax.linalg.triangular_solve(lmat, eye, left_side=True, lower=True,
                                        unit_diagonal=True)
    u = jnp.einsum('bhncs,bhnsd->bhncd', t_inv, v_beta)
    w = jnp.einsum('bhncs,bhnsd->bhncd', t_inv, k_beta * jnp.exp(gc)[..., None])
    attn = jnp.einsum('bhncd,bhnsd->bhncs', q, k) * decay

    def step(state, inp):
        q_i, k_i, u_i, w_i, a_i, gc_i = inp
        v_new = u_i - jnp.einsum('bhck,bhkv->bhcv', w_i, state)
        o_i = (jnp.einsum('bhck,bhkv->bhcv', q_i * jnp.exp(gc_i)[..., None], state)
               + jnp.einsum('bhcs,bhsv->bhcv', a_i, v_new))
        g_last = gc_i[..., -1]
        k_dec = k_i * jnp.exp(g_last[..., None] - gc_i)[..., None]
        state = state * jnp.exp(g_last)[..., None, None] + jnp.einsum('bhck,bhcv->bhkv', k_dec, v_new)
        return state, o_i

    xs = tuple(jnp.moveaxis(t, 2, 0) for t in (q, k, u, w, attn, gc))
    state0 = jnp.zeros((B, GDN_HEADS, GDN_DIM, GDN_DIM), jnp.float32)
    _, o = lax.scan(step, state0, xs)
    o = jnp.transpose(o, (1, 0, 3, 2, 4)).reshape(B, n_chunks * CHUNK, GDN_HEADS, GDN_DIM)[:, pad:]
    zf = z.reshape(B, L, GDN_HEADS, GDN_DIM).astype(jnp.float32)
    o = rms_norm(o, o_gain) * jax.nn.silu(zf)
    return o.reshape(B, L, GDN_WIDTH).astype(out_dtype)


def diff_attention(q, k, v, q_gain, k_gain, lq1, lk1, lq2, lk2, sub_gain, positions, lambda_init):
    B, L, _ = q.shape
    out_dtype = q.dtype
    q = q.reshape(B, L, DIFF_HEADS, 2, DIFF_DIM)
    k = k.reshape(B, L, DIFF_HEADS, 2, DIFF_DIM)
    v = v.reshape(B, L, DIFF_HEADS, DIFF_VDIM)
    q = rotary(rms_norm(q, q_gain), positions)
    k = rotary(rms_norm(k, k_gain), positions)
    f32 = lambda t: t.astype(jnp.float32)
    lam = (jnp.exp(jnp.sum(f32(lq1) * f32(lk1))) - jnp.exp(jnp.sum(f32(lq2) * f32(lk2)))
           + lambda_init)
    scale = DIFF_DIM ** -0.5

    pad = (-L) % Q_BLOCK
    lp = L + pad
    n_blocks = lp // Q_BLOCK
    pad_seq = lambda t: jnp.pad(t, [(0, 0), (pad, 0)] + [(0, 0)] * (t.ndim - 2))
    kp = f32(pad_seq(k))
    vp = f32(pad_seq(v))
    qb = jnp.moveaxis(pad_seq(q).reshape(B, n_blocks, Q_BLOCK, DIFF_HEADS, 2, DIFF_DIM), 1, 0)
    kpos = jnp.arange(lp)

    def block(args):
        q_blk, blk = args
        qpos = blk * Q_BLOCK + jnp.arange(Q_BLOCK)
        s = jnp.einsum('bqhmd,bkhmd->bhmqk', f32(q_blk), kp) * scale
        mask = (kpos[None, :] <= qpos[:, None]) & (kpos[None, :] >= pad)
        p = jax.nn.softmax(jnp.where(mask, s, MASK_VALUE), axis=-1)
        wts = p[:, :, 0] - lam * p[:, :, 1]
        return jnp.einsum('bhqk,bkhe->bqhe', wts, vp)

    o = lax.map(block, (qb, jnp.arange(n_blocks)))
    o = jnp.moveaxis(o, 0, 1).reshape(B, lp, DIFF_HEADS, DIFF_VDIM)[:, pad:]
    o = rms_norm(o, sub_gain) * (1.0 - lambda_init)
    return o.reshape(B, L, DIFF_WIDTH).astype(out_dtype)


def setup_inputs(seed: int = 0) -> dict:
    key = jax.random.key(seed)
    ks = jax.random.split(key, 20)
    nrm = lambda k, shape, s: jax.random.normal(k, shape, jnp.float32) * s
    gain = lambda k, n: 1.0 + nrm(k, (DEPTH, n), 0.02)
    dt = jnp.exp(jax.random.uniform(ks[5], (DEPTH, GDN_HEADS), jnp.float32,
                                    math.log(1e-3), math.log(1e-1)))
    return {
        "x": nrm(ks[0], (BATCH, SEQ, D_MODEL), 1.0),
        "meta_tokens": nrm(ks[1], (N_META, D_MODEL), 1.0),
        "attn_norm": gain(ks[2], D_MODEL),
        "w_in": nrm(ks[3], (DEPTH, D_MODEL, PROJ_WIDTH), D_MODEL ** -0.5),
        "conv_w": nrm(ks[4], (DEPTH, CONV_WIDTH, 3 * GDN_WIDTH), CONV_WIDTH ** -0.5),
        "a_log": jnp.log(jax.random.uniform(ks[6], (DEPTH, GDN_HEADS), jnp.float32, 1.0, 16.0)),
        "dt_bias": dt + jnp.log(-jnp.expm1(-dt)),
        "gdn_norm": gain(ks[7], GDN_DIM),
        "q_norm": gain(ks[8], DIFF_DIM),
        "k_norm": gain(ks[9], DIFF_DIM),
        "lambda_q1": nrm(ks[10], (DEPTH, DIFF_DIM), 0.1),
        "lambda_k1": nrm(ks[11], (DEPTH, DIFF_DIM), 0.1),
        "lambda_q2": nrm(ks[12], (DEPTH, DIFF_DIM), 0.1),
        "lambda_k2": nrm(ks[13], (DEPTH, DIFF_DIM), 0.1),
        "diff_norm": gain(ks[14], DIFF_VDIM),
        "w_out": nrm(ks[15], (DEPTH, MIX_WIDTH, D_MODEL), MIX_WIDTH ** -0.5),
        "ffn_norm": gain(ks[16], D_MODEL),
        "w_gate_up": nrm(ks[17], (DEPTH, D_MODEL, 2 * D_FF), D_MODEL ** -0.5),
        "w_down": nrm(ks[18], (DEPTH, D_FF, D_MODEL), D_FF ** -0.5),
    }


def reference(x, meta_tokens, attn_norm, w_in, conv_w, a_log, dt_bias, gdn_norm, q_norm, k_norm,
              lambda_q1, lambda_k1, lambda_q2, lambda_k2, diff_norm, w_out, ffn_norm,
              w_gate_up, w_down):
    B = x.shape[0]
    meta = jnp.broadcast_to(meta_tokens[None].astype(x.dtype), (B, N_META, D_MODEL))
    h = jnp.concatenate([meta, x], axis=1)
    L = h.shape[1]
    positions = jnp.arange(L)
    split_at = [int(s) for s in np.cumsum(PROJ_SIZES)[:-1]]
    for layer in range(DEPTH):
        lambda_init = 0.8 - 0.6 * math.exp(-0.3 * layer)
        n = rms_norm(h, attn_norm[layer])
        proj = jnp.einsum('bld,dp->blp', n, w_in[layer])
        gq, gk, gv, gz, gb, ga, dq, dk, dv = jnp.split(proj, split_at, axis=-1)
        o_gdn = gated_deltanet(gq, gk, gv, gz, gb, ga, conv_w[layer], a_log[layer],
                               dt_bias[layer], gdn_norm[layer])
        o_diff = diff_attention(dq, dk, dv, q_norm[layer], k_norm[layer], lambda_q1[layer],
                                lambda_k1[layer], lambda_q2[layer], lambda_k2[layer],
                                diff_norm[layer], positions, lambda_init)
        mix = jnp.concatenate([o_gdn, o_diff], axis=-1)
        h = h + jnp.einsum('blm,md->bld', mix, w_out[layer])
        n = rms_norm(h, ffn_norm[layer])
        gate, up = jnp.split(jnp.einsum('bld,df->blf', n, w_gate_up[layer]), 2, axis=-1)
        h = h + jnp.einsum('blf,fd->bld', jax.nn.silu(gate) * up, w_down[layer])
    return h[:, N_META:]
```

```cpp
#include <hip/hip_runtime.h>
#include <hip/hip_bf16.h>
#include <cstdio>
#include <cstdint>
#include <cmath>
namespace pg8 {
#define PG8_LAS __attribute__((address_space(3)))
typedef unsigned short bf16_t;
typedef short bf16x8 __attribute__((ext_vector_type(8)));
typedef float f32x4 __attribute__((ext_vector_type(4)));
typedef unsigned u32x4 __attribute__((ext_vector_type(4)));
constexpr int BM = 256, BK = 64, HALF = 128, HTB = HALF * BK * 2  , STAGE_BYTES = 8 * HTB, NXCD = 8, WGM = 8;

__host__ __device__ __forceinline__ int lds_byte(int r, int c) { const int st = (r >> 4) * 2 + (c >> 5), rr = r & 15, cc = c & 31, ob = rr * 64 + cc * 2; return st * 1024 + (ob ^ (((ob >> 9) & 1) << 5)); }
__host__ __device__ __forceinline__ void stage_rc(int b, int& R, int& C) { const int st = b / 1024, sb = b % 1024, swz = sb ^ (((sb >> 9) & 1) << 5); R = (st >> 1) * 16 + swz / 64; C = (st & 1) * 32 + (swz % 64) / 2; }
__host__ __device__ __forceinline__ int perm32(int rho) { const int n = rho >> 4, i = rho & 15; return 8 * (i >> 2) + 4 * n + (i & 3); }

struct Unit { int pm, pn; };
struct Gemm { const bf16_t* A; const bf16_t* Bt; int M, N, K; };

struct StaticOrder {
    int nM, nN, nwg, G, c;
    __host__ __device__ void init(int M, int N, int G_, int c_) { nM = M / BM; nN = N / BM; nwg = nM * nN; G = G_; c = c_; }
    __host__ __device__ bool next(int i, Unit& u) const {
        const long L = (long)i * G + c; if (L >= nwg) return false;
        int wgid = (int)L; { const int q = nwg / NXCD, r = nwg % NXCD, xcd = wgid % NXCD, off = wgid / NXCD; wgid = (xcd < r ? xcd * (q + 1) : r * (q + 1) + (xcd - r) * q) + off; }
        const int nig = WGM * nN, gid = wgid / nig, fm = gid * WGM, gsz = (nM - fm) < WGM ? (nM - fm) : WGM;
        u.pm = fm + ((wgid % nig) % gsz); u.pn = (wgid % nig) / gsz; return true;
    }
    __device__ __forceinline__ void a_ready(const Unit&) const {}
    __device__ __forceinline__ void done(const Unit&) const {}
};


__device__ __forceinline__ unsigned cvt_pk_bf16(float lo, float hi) { unsigned r; asm volatile("v_cvt_pk_bf16_f32 %0, %1, %2" : "=v"(r) : "v"(lo), "v"(hi)); return r; }
__device__ __forceinline__ u32x4 pack8(const f32x4 a, const f32x4 b) { u32x4 w; w.x = cvt_pk_bf16(a[0], a[1]); w.y = cvt_pk_bf16(a[2], a[3]); w.z = cvt_pk_bf16(b[0], b[1]); w.w = cvt_pk_bf16(b[2], b[3]); return w; }
__device__ __forceinline__ float silu_f(float v) { return v / (1.0f + __expf(-v)); }

__constant__ double REVF[32] = {
    1.59154943091895346e-01, 1.19349378491716507e-01, 8.94994027620097804e-02, 6.71150846704077902e-02, 5.03292117661844479e-02, 3.77415857831133045e-02, 2.83021955739452893e-02, 2.12236507650183370e-02,
    1.59154945463488816e-02, 1.19349361890562274e-02, 8.94994015762130488e-03, 6.71150870420012501e-03, 5.03292093945909881e-03, 3.77415857831133036e-03, 2.83021961668436560e-03, 2.12236537295101661e-03,
    1.59154939534505145e-03, 1.19349366337300009e-03, 8.94994015762130509e-04, 6.71150796307716838e-04, 5.03292116179598621e-04, 3.77415828186214788e-04, 2.83021961668436560e-04, 2.12236529883872083e-04,
    1.59154950651349498e-04, 1.19349375601336978e-04, 8.94993978705982618e-05, 6.71150851891938580e-05, 5.03292106915561601e-05, 3.77415846714288693e-05, 2.83021957036418071e-05, 2.12236539147909035e-05};

struct EpiInProj {
    static constexpr bool PERM = true, AFTER_DRAIN = false;
    const float* rstd;
    bf16_t* graw;
    bf16_t* qbuf;
    bf16_t* kimg;
    bf16_t* vimg;
    float* beta; float* gdec;
    const float* qn; const float* kn; const float* a_log; const float* dt_bias;
    __device__ __forceinline__ void operator()(const f32x4 (&acc)[2][2][4][2], const Unit& u, int wr, int wc, int fr, int fq) const {
        asm volatile("" : "+v"(fr), "+v"(fq));
        const int pn = u.pn, row0 = u.pm * BM + wr * 64 + fr;
        if (pn < 16) {
#pragma unroll
            for (int ai = 0; ai < 2; ++ai)
#pragma unroll
                for (int m = 0; m < 4; ++m) { const int row = row0 + ai * HALF + m * 16; const float rs = rstd[row];
                    bf16_t* rowp = graw + (size_t)row * 4096 + pn * 256 + wc * 32 + 8 * fq;
#pragma unroll
                    for (int bj = 0; bj < 2; ++bj) *(u32x4*)(rowp + bj * HALF) = pack8(acc[ai][bj][m][0] * rs, acc[ai][bj][m][1] * rs); }
        } else if (pn < 24) {
            const int G = 4 * (pn - 16) + wc; const bool isK = G >= 16; const int hm = G & 15;
            const float* gp = (isK ? kn : qn) + 8 * fq;
            f32x4 gn[2][2];
#pragma unroll
            for (int bj = 0; bj < 2; ++bj)
#pragma unroll
                for (int n = 0; n < 2; ++n) gn[bj][n] = *(const f32x4*)(gp + 32 * bj + 4 * n);
            double rf[2][4];
#pragma unroll
            for (int n = 0; n < 2; ++n)
#pragma unroll
                for (int j = 0; j < 4; ++j) rf[n][j] = REVF[8 * fq + 4 * n + j];
            const float osc = isK ? 1.0f : 0.18033688011112042f;
#pragma unroll
            for (int ai = 0; ai < 2; ++ai)
#pragma unroll
                for (int m = 0; m < 4; ++m) { const int row = row0 + ai * HALF + m * 16; const float rs = rstd[row];
                    f32x4 x[2][2]; float ss = 0.f;
#pragma unroll
                    for (int bj = 0; bj < 2; ++bj)
#pragma unroll
                        for (int n = 0; n < 2; ++n) { x[bj][n] = acc[ai][bj][m][n] * rs; ss += (x[bj][n][0] * x[bj][n][0] + x[bj][n][1] * x[bj][n][1]) + (x[bj][n][2] * x[bj][n][2] + x[bj][n][3] * x[bj][n][3]); }
                    ss += __shfl_xor(ss, 16); ss += __shfl_xor(ss, 32);
                    const float rn = __builtin_amdgcn_rsqf(ss * (1.0f / 64.0f) + 1e-6f) * osc;
                    const double pos = (double)(row - 48);
                    f32x4 o[2][2];
#pragma unroll
                    for (int n = 0; n < 2; ++n)
#pragma unroll
                        for (int j = 0; j < 4; ++j) {
                            const double rev = pos * rf[n][j]; const float fr_ = (float)(rev - __builtin_rint(rev));
                            const float sn = __builtin_amdgcn_sinf(fr_), cs = __builtin_amdgcn_cosf(fr_);
                            const float y1 = x[0][n][j] * rn * gn[0][n][j], y2 = x[1][n][j] * rn * gn[1][n][j];
                            o[0][n][j] = y1 * cs - y2 * sn; o[1][n][j] = y2 * cs + y1 * sn; }
                    if (!isK) {
                        if (row >= 64 && row < 8256) { bf16_t* qp = qbuf + ((size_t)hm * 8192 + (row - 64)) * 64 + 8 * fq;
#pragma unroll
                            for (int bj = 0; bj < 2; ++bj) *(u32x4*)(qp + 32 * bj) = pack8(o[bj][0], o[bj][1]); }
                    } else if (row < 8256) { bf16_t* kp = kimg + ((size_t)(hm * 129 + (row >> 6)) * 8 + fq) * 512 + (row & 63) * 8;
#pragma unroll
                        for (int bj = 0; bj < 2; ++bj) *(u32x4*)(kp + bj * 4 * 512) = pack8(o[bj][0], o[bj][1]); }
                }
        } else if (pn < 28) {
#pragma unroll
            for (int ai = 0; ai < 2; ++ai)
#pragma unroll
                for (int m = 0; m < 4; ++m) { const int row = row0 + ai * HALF + m * 16; const float rs = rstd[row];
                    if (row < 8256) {
#pragma unroll
                        for (int bj = 0; bj < 2; ++bj) { const int head = 2 * (pn - 24) + bj;
                            bf16_t* vp = vimg + ((size_t)(head * 129 + (row >> 6)) * 4 + wc) * 2048 + (row & 63) * 32 + 8 * fq;
                            *(u32x4*)vp = pack8(acc[ai][bj][m][0] * rs, acc[ai][bj][m][1] * rs); } } }
        } else {
            if (wc == 0 && fq < 2) {
#pragma unroll
                for (int ai = 0; ai < 2; ++ai)
#pragma unroll
                    for (int m = 0; m < 4; ++m) { const int row = row0 + ai * HALF + m * 16; const float rs = rstd[row];
                        if (row < 8256) {
#pragma unroll
                            for (int n = 0; n < 2; ++n)
#pragma unroll
                                for (int j = 0; j < 4; ++j) { const int hd = 4 * n + j; const float v = acc[ai][0][m][n][j] * rs; float r;
                                    if (fq == 0) { r = 1.0f / (1.0f + __expf(-v)); if (row < 48) r = 0.f; beta[(size_t)hd * 8256 + row] = r; }
                                    else { const float y = v + dt_bias[hd]; const float sp = (y > 20.f) ? y : log1pf(__expf(y)); r = -__expf(a_log[hd]) * sp; if (row < 48) r = 0.f; gdec[(size_t)hd * 8256 + row] = r; } } } }
            }
        }
    }
};

struct EpiOutProj {
    static constexpr bool PERM = true, AFTER_DRAIN = false;
    const float* x; float* h1; bf16_t* h1b; float* ssq;
    __device__ __forceinline__ void operator()(const f32x4 (&acc)[2][2][4][2], const Unit& u, int wr, int wc, int fr, int fq) const {
        asm volatile("" : "+v"(fr), "+v"(fq));
        const int row0 = u.pm * BM + wr * 64 + fr, col0 = u.pn * BM + wc * 32 + 8 * fq;
#pragma unroll
        for (int ai = 0; ai < 2; ++ai)
#pragma unroll
            for (int m = 0; m < 4; ++m) { const int row = row0 + ai * HALF + m * 16; const size_t off = (size_t)row * 2048 + col0; float ss = 0.f;
#pragma unroll
                for (int bj = 0; bj < 2; ++bj) { f32x4 v[2];
#pragma unroll
                    for (int n = 0; n < 2; ++n) { v[n] = *(const f32x4*)(x + off + bj * HALF + 4 * n) + acc[ai][bj][m][n]; *(f32x4*)(h1 + off + bj * HALF + 4 * n) = v[n];
                        ss += (v[n][0] * v[n][0] + v[n][1] * v[n][1]) + (v[n][2] * v[n][2] + v[n][3] * v[n][3]); }
                    *(u32x4*)(h1b + off + bj * HALF) = pack8(v[0], v[1]); }
                ss += __shfl_xor(ss, 16); ss += __shfl_xor(ss, 32);
                if (fq == 0) ssq[(size_t)row * 32 + u.pn * 4 + wc] = ss; }
    }
};

struct EpiGateUp {
    static constexpr bool PERM = true, AFTER_DRAIN = false;
    const float* ssq; bf16_t* hid;
    __device__ __forceinline__ void operator()(const f32x4 (&acc)[2][2][4][2], const Unit& u, int wr, int wc, int fr, int fq) const {
        asm volatile("" : "+v"(fr), "+v"(fq));
        const int row0 = u.pm * BM + wr * 64 + fr, col0 = u.pn * HALF + wc * 32 + 8 * fq;
#pragma unroll
        for (int ai = 0; ai < 2; ++ai)
#pragma unroll
            for (int m = 0; m < 4; ++m) { const int row = row0 + ai * HALF + m * 16; const f32x4* sp = (const f32x4*)(ssq + (size_t)row * 32);
                f32x4 s4 = sp[0];
#pragma unroll
                for (int i = 1; i < 8; ++i) s4 += sp[i];
                const float rs = __builtin_amdgcn_rsqf(((s4[0] + s4[1]) + (s4[2] + s4[3])) * (1.0f / 2048.0f) + 1e-6f);
                f32x4 hv[2];
#pragma unroll
                for (int n = 0; n < 2; ++n)
#pragma unroll
                    for (int j = 0; j < 4; ++j) { const float g = acc[ai][0][m][n][j] * rs, up = acc[ai][1][m][n][j] * rs; hv[n][j] = silu_f(g) * up; }
                *(u32x4*)(hid + (size_t)row * 5632 + col0) = pack8(hv[0], hv[1]); }
    }
};

struct EpiDown {
    static constexpr bool PERM = true, AFTER_DRAIN = false;
    float* out;
    __device__ __forceinline__ void operator()(const f32x4 (&acc)[2][2][4][2], const Unit& u, int wr, int wc, int fr, int fq) const {
        asm volatile("" : "+v"(fr), "+v"(fq));
        const int row0 = u.pm * BM + wr * 64 + fr, col0 = u.pn * BM + wc * 32 + 8 * fq;
#pragma unroll
        for (int ai = 0; ai < 2; ++ai)
#pragma unroll
            for (int m = 0; m < 4; ++m) { float* rp = out + (size_t)(row0 + ai * HALF + m * 16) * 2048 + col0;
#pragma unroll
                for (int bj = 0; bj < 2; ++bj)
#pragma unroll
                    for (int n = 0; n < 2; ++n) { f32x4* p = (f32x4*)(rp + bj * HALF + 4 * n); *p = *p + acc[ai][bj][m][n]; } }
    }
};

template <class Epi, class Sched, bool ALIGN_EPI = false, bool SP2 = false>
__device__ __forceinline__ void gemm_phase(PG8_LAS unsigned char* lds, const Gemm g, const Sched& S, const Epi& E) {
    int tid = threadIdx.x; asm volatile("" : "+v"(tid)); const int wid = __builtin_amdgcn_readfirstlane(tid >> 6), lane = tid & 63, wr = wid >> 2, wc = wid & 3, fr = lane & 15, fq = lane >> 4;
    const int K = g.K, nt = K / BK;
    unsigned voffA[2], voffB[2];
#pragma unroll
    for (int i = 0; i < 2; ++i) { int R, C; stage_rc(tid * 16 + i * 8192, R, C); const int Rb = Epi::PERM ? ((R & ~31) + perm32(R & 31)) : R;
        voffA[i] = (unsigned)(R * K + C) * 2u; voffB[i] = (unsigned)(Rb * K + C) * 2u; }
    const size_t kstep = (size_t)(BK * 2);
    const size_t hstep = (size_t)HALF * K * 2;
    const size_t tstep = 2 * hstep;
    const unsigned ldsw = (unsigned)wid * 1024u;
    const int aoff = lds_byte(wr * 64 + fr, fq * 8), boff = lds_byte(wc * 32 + fr, fq * 8);
#define PG8_SA(b, h) (((b) * 2 + (h)) * HTB)
#define PG8_SB(b, h) ((4 + (b) * 2 + (h)) * HTB)
#define PG8_STAGE(bufoff, gbase, voff) do { _Pragma("unroll") for (int _i = 0; _i < 2; ++_i) \
        __builtin_amdgcn_global_load_lds((const unsigned*)((const char*)(gbase) + (voff)[_i]), (PG8_LAS unsigned*)(lds + (bufoff) + ldsw + _i * 8192), 16, 0, 0); } while (0)
#define PG8_LDA(dst, b, h) do { _Pragma("unroll") for (int m = 0; m < 4; ++m) _Pragma("unroll") for (int k = 0; k < 2; ++k) dst[m][k] = *(const PG8_LAS bf16x8*)(lds + PG8_SA(b, h) + aoff + m * 2048 + k * 1024); } while (0)
#define PG8_LDB(dst, b, h) do { _Pragma("unroll") for (int n = 0; n < 2; ++n) _Pragma("unroll") for (int k = 0; k < 2; ++k) dst[n][k] = *(const PG8_LAS bf16x8*)(lds + PG8_SB(b, h) + boff + n * 2048 + k * 1024); } while (0)
#define PG8_MMA(ai, bj, At, Bt) do { __builtin_amdgcn_s_setprio(1); _Pragma("unroll") for (int m = 0; m < 4; ++m) _Pragma("unroll") for (int n = 0; n < 2; ++n) _Pragma("unroll") for (int k = 0; k < 2; ++k) \
        acc[ai][bj][m][n] = __builtin_amdgcn_mfma_f32_16x16x32_bf16(Bt[n][k], At[m][k], acc[ai][bj][m][n], 0, 0, 0); __builtin_amdgcn_s_setprio(0); } while (0)
#define PG8_WAIT_V(n) asm volatile("s_waitcnt vmcnt(" #n ")" ::: "memory")
#define PG8_WAIT_L(n) asm volatile("s_waitcnt lgkmcnt(" #n ")" ::: "memory")
#define PG8_BAR __builtin_amdgcn_s_barrier()
#define PG8_SCHED __builtin_amdgcn_sched_barrier(0)
    Unit cur, nxt; int ui = 0;
    if (!S.next(0, cur)) return;
    f32x4 acc[2][2][4][2];
#pragma unroll
    for (int a = 0; a < 2; ++a)
#pragma unroll
        for (int b = 0; b < 2; ++b)
#pragma unroll
            for (int m = 0; m < 4; ++m)
#pragma unroll
                for (int n = 0; n < 2; ++n) acc[a][b][m][n] = (f32x4){0.f, 0.f, 0.f, 0.f};
    bf16x8 At[4][2], B0[2][2], B1[2][2];
    const char* cA = (const char*)g.A + (size_t)cur.pm * tstep; const char* cB = (const char*)g.Bt + (size_t)cur.pn * tstep;
    S.a_ready(cur);
    if constexpr (SP2) {
        PG8_STAGE(PG8_SB(0, 0), cB, voffB); PG8_STAGE(PG8_SB(0, 1), cB + hstep, voffB); PG8_STAGE(PG8_SA(0, 0), cA, voffA); PG8_STAGE(PG8_SA(0, 1), cA + hstep, voffA);
        if (wr == 1) PG8_BAR;
        PG8_WAIT_V(2); PG8_BAR;
        PG8_STAGE(PG8_SB(1, 0), cB + kstep, voffB); PG8_STAGE(PG8_SA(1, 0), cA + kstep, voffA); PG8_STAGE(PG8_SB(1, 1), cB + hstep + kstep, voffB);
        PG8_WAIT_V(6); PG8_BAR;
    } else {
        PG8_STAGE(PG8_SB(0, 0), cB, voffB); PG8_STAGE(PG8_SA(0, 0), cA, voffA); PG8_STAGE(PG8_SB(0, 1), cB + hstep, voffB); PG8_STAGE(PG8_SA(0, 1), cA + hstep, voffA);
        if (wr == 1) PG8_BAR;
        PG8_WAIT_V(4); PG8_BAR;
        PG8_STAGE(PG8_SB(1, 0), cB + kstep, voffB); PG8_STAGE(PG8_SA(1, 0), cA + kstep, voffA); PG8_STAGE(PG8_SB(1, 1), cB + hstep + kstep, voffB);
        PG8_WAIT_V(6); PG8_BAR;
    }
    for (;;) {
        const bool has_next = S.next(ui + 1, nxt);
        const char* nA = has_next ? (const char*)g.A + (size_t)nxt.pm * tstep : cA; const char* nB = has_next ? (const char*)g.Bt + (size_t)nxt.pn * tstep : cB;
        for (int t = 0; t < nt; t += 2) {
            const bool last = (t == nt - 2);
            const char* a1 = cA + (size_t)(t + 1) * kstep;
            const char* a2 = last ? nA : cA + (size_t)(t + 2) * kstep; const char* b2 = last ? nB : cB + (size_t)(t + 2) * kstep;
            const char* a3 = a2 + kstep; const char* b3 = b2 + kstep;
            if (last && has_next) S.a_ready(nxt);
            if constexpr (SP2) {
            PG8_LDB(B0, 0, 0); PG8_LDB(B1, 0, 1); PG8_SCHED; PG8_LDA(At, 0, 0); PG8_STAGE(PG8_SA(1, 1), a1 + hstep, voffA);
            PG8_WAIT_V(8); PG8_WAIT_L(0); PG8_BAR; PG8_MMA(0, 0, At, B0); PG8_MMA(0, 1, At, B1); PG8_BAR; PG8_SCHED;
            PG8_LDA(At, 0, 1); PG8_STAGE(PG8_SB(0, 0), b2, voffB); PG8_STAGE(PG8_SB(0, 1), b2 + hstep, voffB); PG8_STAGE(PG8_SA(0, 0), a2, voffA);
            PG8_WAIT_V(8); PG8_WAIT_L(0); PG8_BAR; PG8_MMA(1, 0, At, B0); PG8_MMA(1, 1, At, B1); PG8_BAR; PG8_SCHED;
            PG8_LDB(B0, 1, 0); PG8_LDB(B1, 1, 1); PG8_SCHED; PG8_LDA(At, 1, 0); PG8_STAGE(PG8_SA(0, 1), a2 + hstep, voffA);
            PG8_WAIT_V(8); PG8_WAIT_L(0); PG8_BAR; PG8_MMA(0, 0, At, B0); PG8_MMA(0, 1, At, B1); PG8_BAR; PG8_SCHED;
            PG8_LDA(At, 1, 1); PG8_STAGE(PG8_SB(1, 0), b3, voffB); PG8_STAGE(PG8_SB(1, 1), b3 + hstep, voffB); PG8_STAGE(PG8_SA(1, 0), a3, voffA);
            PG8_WAIT_V(8); PG8_WAIT_L(0); PG8_BAR; PG8_MMA(1, 0, At, B0); PG8_MMA(1, 1, At, B1); PG8_BAR; PG8_SCHED;
            } else {
            PG8_LDB(B0, 0, 0); PG8_SCHED; PG8_LDA(At, 0, 0); PG8_STAGE(PG8_SA(1, 1), a1 + hstep, voffA);
            PG8_WAIT_L(8); PG8_BAR; PG8_WAIT_L(0); PG8_MMA(0, 0, At, B0); PG8_BAR; PG8_SCHED;
            PG8_LDB(B1, 0, 1); PG8_STAGE(PG8_SB(0, 0), b2, voffB);
            PG8_BAR; PG8_WAIT_L(0); PG8_MMA(0, 1, At, B1); PG8_BAR;
            PG8_LDA(At, 0, 1); PG8_STAGE(PG8_SA(0, 0), a2, voffA);
            PG8_BAR; PG8_WAIT_L(0); PG8_MMA(1, 0, At, B0); PG8_BAR; PG8_SCHED;
            PG8_STAGE(PG8_SB(0, 1), b2 + hstep, voffB);
            PG8_WAIT_V(6); PG8_BAR; PG8_MMA(1, 1, At, B1); PG8_BAR;
            PG8_LDB(B0, 1, 0); PG8_SCHED; PG8_LDA(At, 1, 0); PG8_STAGE(PG8_SA(0, 1), a2 + hstep, voffA);
            PG8_WAIT_L(8); PG8_BAR; PG8_WAIT_L(0); PG8_MMA(0, 0, At, B0); PG8_BAR; PG8_SCHED;
            PG8_LDB(B1, 1, 1); PG8_STAGE(PG8_SB(1, 0), b3, voffB);
            PG8_BAR; PG8_WAIT_L(0); PG8_MMA(0, 1, At, B1); PG8_BAR;
            PG8_LDA(At, 1, 1); PG8_STAGE(PG8_SA(1, 0), a3, voffA);
            PG8_BAR; PG8_WAIT_L(0); PG8_MMA(1, 0, At, B0); PG8_BAR; PG8_SCHED;
            PG8_STAGE(PG8_SB(1, 1), b3 + hstep, voffB);
            PG8_WAIT_V(6); PG8_BAR; PG8_MMA(1, 1, At, B1); PG8_BAR;
            }
        }
        if constexpr (ALIGN_EPI) { if (wr == 0) PG8_BAR; }
        if constexpr (!Epi::AFTER_DRAIN) { E(acc, cur, wr, wc, fr, fq); S.done(cur); }
        if (!has_next) break;
#pragma unroll
        for (int a = 0; a < 2; ++a)
#pragma unroll
            for (int b = 0; b < 2; ++b)
#pragma unroll
                for (int m = 0; m < 4; ++m)
#pragma unroll
                    for (int n = 0; n < 2; ++n) acc[a][b][m][n] = (f32x4){0.f, 0.f, 0.f, 0.f};
        cur = nxt; cA = nA; cB = nB; ++ui;
        if constexpr (ALIGN_EPI) { if (wr == 1) PG8_BAR; }
    }
    PG8_WAIT_V(0);
    if constexpr (!ALIGN_EPI) { if (wr == 0) PG8_BAR; }
    PG8_BAR;
    if constexpr (Epi::AFTER_DRAIN) { E.fused(acc, cur, wr, wc, fr, fq, lds, wid, lane); S.done(cur); }
#undef PG8_SA
#undef PG8_SB
#undef PG8_STAGE
#undef PG8_LDA
#undef PG8_LDB
#undef PG8_MMA
#undef PG8_WAIT_V
#undef PG8_WAIT_L
#undef PG8_BAR
#undef PG8_SCHED
}
}
#define GAS __attribute__((address_space(1)))
#define LAS __attribute__((address_space(3)))
typedef unsigned short bf16;
typedef unsigned v4u __attribute__((ext_vector_type(4)));
typedef float f32x4 __attribute__((ext_vector_type(4)));
typedef short bf16x8 __attribute__((ext_vector_type(8)));
typedef GAS unsigned gu32;
typedef GAS unsigned long long gu64;
#define RLX_AGENT __ATOMIC_RELAXED, __HIP_MEMORY_SCOPE_AGENT
#define LDS_WAIT() asm volatile("s_waitcnt lgkmcnt(0)" ::: "memory")
#define VM_WAIT() asm volatile("s_waitcnt vmcnt(0)" ::: "memory")
__device__ __forceinline__ unsigned long long rt() { return __builtin_amdgcn_s_memrealtime(); }
__device__ __forceinline__ unsigned f2bf(float f) { unsigned u = __builtin_bit_cast(unsigned, f); return (u + 0x7fffu + ((u >> 16) & 1u)) >> 16; }
__device__ __forceinline__ unsigned pk2(float lo, float hi) { return f2bf(lo) | (f2bf(hi) << 16); }

#define XB_TMO      128
#define XB_XCNT(j)  (256  + 64 * (j))
#define XB_XSUB(j)  (1280 + 64 * (j))
#define XB_XGEN(j)  (2304 + 64 * (j))
#define XB_TOP      3328
#define XB_TOPGEN   3392
#define XCD_BAR_WORDS 3456
#define XB_SPIN_CAP (1u << 18)

__device__ __forceinline__ unsigned xb_ld(unsigned* p)              { return __hip_atomic_load(p, __ATOMIC_RELAXED, __HIP_MEMORY_SCOPE_AGENT); }
__device__ __forceinline__ unsigned xb_add(unsigned* p, unsigned v) { return __hip_atomic_fetch_add(p, v, __ATOMIC_RELAXED, __HIP_MEMORY_SCOPE_AGENT); }
__device__ __forceinline__ unsigned xb_xcc_id() { return (unsigned)__builtin_amdgcn_s_getreg((3 << 11) | 20) & 0xFu; }
#define XB_SPIN(cond, bar) do { unsigned _sp = 0; while (cond) { __builtin_amdgcn_s_sleep(1); \
    if ((++_sp & 255u) == 0u) { if (xb_ld(&(bar)[XB_TMO])) break; if (_sp > XB_SPIN_CAP) { atomicAdd(&(bar)[XB_TMO], 1u); break; } } } } while (0)

struct XcdBarrier {
    unsigned* bar; unsigned x;
    volatile LAS unsigned* st;
};

__device__ __forceinline__ XcdBarrier xcd_barrier_post(unsigned* bar, volatile LAS unsigned* st) {
    XcdBarrier b; b.bar = bar; b.x = xb_xcc_id(); b.st = st;
    if (threadIdx.x == 0) (void)xb_add(&bar[XB_XCNT(b.x)], 1u);
    return b;
}
__device__ __forceinline__ void xcd_barrier_complete(unsigned* bar, unsigned x, unsigned& nloc, unsigned& nx) {
    const unsigned G = gridDim.x * gridDim.y * gridDim.z;
    unsigned sum, cnt, mine, sp = 0u;
    for (;;) {
        sum = 0u; cnt = 0u; mine = 0u;
#pragma unroll
        for (unsigned j = 0; j < 16; ++j) { const unsigned c = xb_ld(&bar[XB_XCNT(j)]); sum += c; cnt += (c > 0u) ? 1u : 0u; mine = (j == x) ? c : mine; }
        if (sum == G) break;
        __builtin_amdgcn_s_sleep(1);
        if ((++sp & 255u) == 0u) { if (xb_ld(&bar[XB_TMO])) break; if (sp > XB_SPIN_CAP) { atomicAdd(&bar[XB_TMO], 1u); break; } }
    }
    nloc = mine > 0u ? mine : 1u; nx = cnt > 0u ? cnt : 1u;
}

__device__ __forceinline__ void xcd_barrier(const XcdBarrier& b) {
    asm volatile("s_waitcnt vmcnt(0)" ::: "memory");
    __syncthreads();
    if (threadIdx.x == 0) {
        unsigned* bar = b.bar;
        __builtin_amdgcn_s_waitcnt(0);
        unsigned nloc = b.st[0], nx = b.st[1];
        if (nloc == 0u) { xcd_barrier_complete(bar, b.x, nloc, nx); b.st[0] = nloc; b.st[1] = nx; }
        const unsigned old = xb_add(&bar[XB_XSUB(b.x)], 1u);
        const unsigned gen = old / nloc;
        if (old + 1u == (gen + 1u) * nloc) {
            __builtin_amdgcn_fence(__ATOMIC_RELEASE, "agent");
            asm volatile("s_waitcnt vmcnt(0)" ::: "memory");
            const unsigned og = xb_add(&bar[XB_TOP], 1u);
            const unsigned tg = og / nx;
            if (og + 1u == (tg + 1u) * nx) xb_add(&bar[XB_TOPGEN], 1u);
            else XB_SPIN(xb_ld(&bar[XB_TOPGEN]) == tg, bar);
            __builtin_amdgcn_fence(__ATOMIC_ACQUIRE, "agent");
            xb_add(&bar[XB_XGEN(b.x)], 1u);
            asm volatile("s_waitcnt vmcnt(0)" ::: "memory");
        } else {
            XB_SPIN(xb_ld(&bar[XB_XGEN(b.x)]) == gen, bar);
            __builtin_amdgcn_fence(__ATOMIC_ACQUIRE, "agent");
            asm volatile("s_waitcnt vmcnt(0)" ::: "memory");
        }
    }
    __syncthreads();
}


namespace cfg {
constexpr int DMODEL = 2048, SEQ = 8192;
constexpr int LP = 8256;
constexpr int MP = 8448;
constexpr int NCH = 129;
constexpr int NPROJ = 7424;
constexpr int WIN_N = 7184;
constexpr int DFF = 5632;
constexpr size_t MiB = 1u << 20;
constexpr size_t WS_CTL = 0, CTL_ZERO_BYTES = 65536;
constexpr size_t WS_WOUT = 1 * MiB;
constexpr size_t WS_WGU = WS_WOUT + (size_t)2048 * 2048 * 2;
constexpr size_t WS_WDN = WS_WGU + (size_t)11264 * 2048 * 2;
constexpr size_t R1 = WS_WDN + (size_t)2048 * 5632 * 2;
constexpr size_t WS_WIN = R1;
constexpr size_t WS_APAD = WS_WIN + (size_t)NPROJ * 2048 * 2;
constexpr size_t WS_MIX = R1;
constexpr size_t WS_H1B = R1 + (size_t)8192 * 2048 * 2;
constexpr size_t R2 = R1 + (size_t)2 * 8192 * 2048 * 2;
static_assert(WS_APAD + (size_t)MP * 2048 * 2 <= R2, "R1");
constexpr size_t WS_GRAW = R2;
constexpr size_t WS_HID = R2;
constexpr size_t R3 = R2 + (size_t)MP * 4096 * 2;
constexpr size_t WS_Q = R3;
constexpr size_t WS_K = WS_Q + (size_t)16 * 8192 * 64 * 2;
constexpr size_t WS_V = WS_K + (size_t)16 * 129 * 4096 * 2;
constexpr size_t WS_RSTD = WS_V + (size_t)8 * 129 * 8192 * 2;
constexpr size_t WS_BETA = WS_RSTD + (size_t)MP * 4;
constexpr size_t WS_GDEC = WS_BETA + (size_t)8 * LP * 4;
constexpr size_t WS_SSQ = WS_GDEC + (size_t)8 * LP * 4;
constexpr size_t R4 = WS_SSQ + (size_t)8192 * 32 * 4;
static_assert(WS_HID + (size_t)8192 * DFF * 2 <= WS_RSTD, "hidden overlay must stay below the small f32 tables");
constexpr size_t GI_WQ = 0, GI_ATT = 32768, GI_KDT = 40960, GI_UT = 57344, GI_EG = 90112, GI_BYTES = 90368;
constexpr size_t WS_GDNP = R4;
constexpr size_t WS_END = WS_GDNP + (size_t)8 * NCH * GI_BYTES;
static_assert(WS_WGU % 256 == 0 && WS_WDN % 256 == 0 && R1 % 256 == 0 && WS_APAD % 256 == 0 && R2 % 256 == 0 && R3 % 256 == 0 && WS_K % 256 == 0 && WS_V % 256 == 0 && WS_RSTD % 256 == 0 && WS_BETA % 256 == 0 && WS_GDEC % 256 == 0 && WS_SSQ % 256 == 0 && R4 % 256 == 0, "alignment");
constexpr int CW_BAR = 4096;
constexpr int CW_ATTQ = 64;
constexpr int LDS_BYTES = 151552;
constexpr int MISC_OFF = LDS_BYTES - 256;
}
#define CAS __attribute__((address_space(4)))
using pg8::bf16_t; using pg8::bf16x8; using pg8::u32x4;
typedef float f32x16 __attribute__((ext_vector_type(16)));
typedef short s16x4 __attribute__((ext_vector_type(4)));
typedef unsigned u32x2 __attribute__((ext_vector_type(2)));

struct Params {
    const float *x, *meta, *attn_norm, *w_in, *conv_w, *a_log, *dt_bias, *gdn_norm, *q_norm, *k_norm, *lq1, *lk1, *lq2, *lk2, *diff_norm, *w_out, *ffn_norm, *w_gu, *w_dn;
    float* out; unsigned char* ws;
};

__device__ __forceinline__ float wave_sum(float v) {
#pragma unroll
    for (int o = 1; o < 64; o <<= 1) v += __shfl_xor(v, o);
    return v;
}

__device__ __forceinline__ int win_src(int a, int& nvalid) {
    const int pn = a >> 3, b8 = a & 7; nvalid = 32;
    if (pn < 16) return 256 * pn + 32 * b8;
    if (pn < 24) return 4112 + 256 * (pn - 16) + 64 * (b8 & 3) + 32 * (b8 >> 2);
    if (pn < 28) return 6160 + 256 * (pn - 24) + 32 * b8;
    if (b8 == 0) { nvalid = 16; return 4096; }
    nvalid = 0; return 0;
}
__device__ __forceinline__ void p0_transpose_item(const float* W, int Nsrc, int K, bf16* WT, int k0, int dstrow0, int srccol, int nvalid, const float* gain, LAS float* scr, int lane) {
    const int c = lane & 31;
#pragma unroll 8
    for (int i = 0; i < 32; ++i) { const int kk = 2 * i + (lane >> 5); float v = 0.f;
        if (c < nvalid) { v = W[(size_t)(k0 + kk) * Nsrc + srccol + c]; if (gain) v *= gain[k0 + kk]; }
        scr[kk * 33 + c] = v; }
    LDS_WAIT(); asm volatile("" ::: "memory");
    const int c8 = lane & 7;
#pragma unroll
    for (int j = 0; j < 4; ++j) { const int n = (lane >> 3) + 8 * j; const LAS float* s = scr + (8 * c8) * 33 + n;
        v4u o; o.x = pk2(s[0 * 33], s[1 * 33]); o.y = pk2(s[2 * 33], s[3 * 33]); o.z = pk2(s[4 * 33], s[5 * 33]); o.w = pk2(s[6 * 33], s[7 * 33]);
        *(GAS v4u*)(WT + (size_t)(dstrow0 + n) * K + k0 + 8 * c8) = o; }
    LDS_WAIT(); asm volatile("" ::: "memory");
}
__device__ __forceinline__ void p0_prep(const Params& P, LAS unsigned char* lds, int vcu, int G, int wave, int lane) {
    using namespace cfg;
    LAS float* scr = (LAS float*)(lds + wave * 16384);
    const int gw = vcu * 8 + wave, NGW = G * 8;
    bf16* Wt_in = (bf16*)(P.ws + WS_WIN); bf16* Wt_out = (bf16*)(P.ws + WS_WOUT); bf16* Wt_gu = (bf16*)(P.ws + WS_WGU); bf16* Wt_dn = (bf16*)(P.ws + WS_WDN);
    constexpr int I_IN = 32 * 232, I_OUT = 32 * 64, I_GU = 32 * 352, I_DN = 88 * 64, NITEMS = I_IN + I_OUT + I_GU + I_DN;
    for (int it = gw; it < NITEMS; it += NGW) {
        int r = it;
        if (r < I_IN) { const int kb = r / 232, a = r % 232; int nv; const int src = win_src(a, nv); p0_transpose_item(P.w_in, WIN_N, 2048, Wt_in, 64 * kb, 32 * a, src, nv, P.attn_norm, scr, lane); continue; } r -= I_IN;
        if (r < I_OUT) { const int kb = r / 64, a = r % 64; p0_transpose_item(P.w_out, 2048, 2048, Wt_out, 64 * kb, 32 * a, 32 * a, 32, nullptr, scr, lane); continue; } r -= I_OUT;
        if (r < I_GU) { const int kb = r / 352, a = r % 352, pn = a >> 3, b8 = a & 7; const int src = (b8 < 4) ? 128 * pn + 32 * b8 : DFF + 128 * pn + 32 * (b8 - 4);
            p0_transpose_item(P.w_gu, 2 * DFF, 2048, Wt_gu, 64 * kb, 32 * a, src, 32, P.ffn_norm, scr, lane); continue; } r -= I_GU;
        { const int kb = r / 64, a = r % 64; p0_transpose_item(P.w_dn, 2048, DFF, Wt_dn, 64 * kb, 32 * a, 32 * a, 32, nullptr, scr, lane); }
    }
    bf16* Apad = (bf16*)(P.ws + WS_APAD); float* rstd = (float*)(P.ws + WS_RSTD);
    for (int r = gw; r < MP; r += NGW) {
        GAS unsigned long long* o8 = (GAS unsigned long long*)(Apad + (size_t)r * 2048) + lane;
        const float* src = (r >= 64 && r < LP) ? P.x + (size_t)(r - 64) * 2048 : ((r >= 48 && r < 64) ? P.meta + (size_t)(r - 48) * 2048 : nullptr);
        if (!src) {
#pragma unroll
            for (int j = 0; j < 8; ++j) o8[64 * j] = 0ull;
            if (lane == 0) rstd[r] = 0.f;
        } else {
            const GAS f32x4* xr = (const GAS f32x4*)src + lane; f32x4 v[8]; float s = 0.f;
#pragma unroll
            for (int j = 0; j < 8; ++j) { v[j] = xr[64 * j]; s += (v[j].x * v[j].x + v[j].y * v[j].y) + (v[j].z * v[j].z + v[j].w * v[j].w); }
            const float rs = 1.0f / sqrtf(wave_sum(s) * (1.0f / 2048.0f) + 1e-6f);
#pragma unroll
            for (int j = 0; j < 8; ++j) o8[64 * j] = (unsigned long long)pk2(v[j].x, v[j].y) | ((unsigned long long)pk2(v[j].z, v[j].w) << 32);
            if (lane == 0) rstd[r] = rs;
        }
    }
}

__device__ __forceinline__ int kperm32(int a) { return 8 * ((a >> 2) & 3) + 4 * (a >> 4) + (a & 3); }
__device__ __forceinline__ int kperm(int a) { return (a & ~31) + kperm32(a & 31); }
__device__ __forceinline__ unsigned short f2bf_s(float f) { return (unsigned short)f2bf(f); }
__device__ __forceinline__ f32x4 mfma16(bf16x8 a, bf16x8 b, f32x4 c) { return __builtin_amdgcn_mfma_f32_16x16x32_bf16(a, b, c, 0, 0, 0); }

__device__ __forceinline__ void gdn_prep_item(const Params& P, int h, int n, LAS unsigned char* lds, int tid, int wave, int lane) {
    using namespace cfg;
    LAS bf16_t* qs = (LAS bf16_t*)(lds + 0);
    LAS bf16_t* ks = (LAS bf16_t*)(lds + 17408);
    LAS bf16_t* kb = (LAS bf16_t*)(lds + 34816);
    LAS bf16_t* kbgT = (LAS bf16_t*)(lds + 52224);
    LAS bf16_t* vbT = (LAS bf16_t*)(lds + 70656);
    LAS bf16_t* kdtI = (LAS bf16_t*)(lds + 89088);
    LAS bf16_t* qgI = (LAS bf16_t*)(lds + 105472);
    LAS float* Lm = (LAS float*)(lds + 121856);
    LAS bf16_t* attI = (LAS bf16_t*)(lds + 139264);
    LAS float* gcs = (LAS float*)(lds + 147456);
    LAS bf16_t* Tb = (LAS bf16_t*)(lds + 0);
    LAS float* UTI = (LAS float*)(lds + 17408);
    LAS bf16_t* WI = (LAS bf16_t*)(lds + 89088);
    const bf16_t* graw = (const bf16_t*)(P.ws + WS_GRAW);
    unsigned char* item = P.ws + WS_GDNP + (size_t)(h * NCH + n) * GI_BYTES;

    if (tid < 64) { float g = ((const float*)(P.ws + WS_GDEC))[(size_t)h * LP + 64 * n + tid]; const float b = ((const float*)(P.ws + WS_BETA))[(size_t)h * LP + 64 * n + tid];
#pragma unroll
        for (int o = 1; o < 64; o <<= 1) { const float t = __shfl_up(g, o); if (lane >= o) g += t; }
        gcs[tid] = g; gcs[64 + tid] = b; }
    __syncthreads();
    const float gl = gcs[63];
    {
        const int cg = tid & 15, c0 = 8 * cg;
#pragma unroll 1
        for (int X = 0; X < 3; ++X) {
            const float* cw = P.conv_w + X * 1024 + h * 128 + c0; f32x4 w[4][2];
#pragma unroll
            for (int j = 0; j < 4; ++j) { w[j][0] = *(const f32x4*)(cw + (size_t)j * 3072); w[j][1] = *(const f32x4*)(cw + (size_t)j * 3072 + 4); }
#pragma unroll
            for (int pass = 0; pass < 2; ++pass) {
                const int rl = 32 * pass + (tid >> 4), R = 64 * n + rl;
                float y[8];
#pragma unroll
                for (int i = 0; i < 8; ++i) y[i] = 0.f;
#pragma unroll
                for (int j = 0; j < 4; ++j) { const int Rj = R - 3 + j;
                    if (Rj >= 0) { const u32x4 raw = *(const u32x4*)(graw + (size_t)Rj * 4096 + X * 1024 + h * 128 + c0);
#pragma unroll
                        for (int i = 0; i < 4; ++i) { const unsigned wd = raw[i]; y[2 * i] += __uint_as_float(wd << 16) * w[j][i >> 1][(2 * i) & 3]; y[2 * i + 1] += __uint_as_float(wd & 0xffff0000u) * w[j][i >> 1][(2 * i + 1) & 3]; } } }
                float ss = 0.f;
#pragma unroll
                for (int i = 0; i < 8; ++i) { y[i] = y[i] / (1.0f + __expf(-y[i])); ss += y[i] * y[i]; }
                const float gc = gcs[rl], bt = gcs[64 + rl];
                if (X < 2) { ss += __shfl_xor(ss, 1); ss += __shfl_xor(ss, 2); ss += __shfl_xor(ss, 4); ss += __shfl_xor(ss, 8);
                    const float rn = __builtin_amdgcn_rsqf(ss + 1e-6f) * (X == 0 ? 0.08838834764831845f : 1.0f);
#pragma unroll
                    for (int i = 0; i < 8; ++i) y[i] *= rn; }
                if (X == 0) {
                    u32x4 pk; pk.x = pk2(y[0], y[1]); pk.y = pk2(y[2], y[3]); pk.z = pk2(y[4], y[5]); pk.w = pk2(y[6], y[7]);
                    *(LAS u32x4*)(qs + rl * 136 + c0) = pk;
                    const float e = __expf(gc);
                    u32x2 a, b; a.x = pk2(y[0] * e, y[1] * e); a.y = pk2(y[2] * e, y[3] * e); b.x = pk2(y[4] * e, y[5] * e); b.y = pk2(y[6] * e, y[7] * e);
                    *(LAS u32x2*)(qgI + rl * 128 + kperm(c0)) = a; *(LAS u32x2*)(qgI + rl * 128 + kperm(c0 + 4)) = b;
                } else if (X == 1) {
                    u32x4 pk; pk.x = pk2(y[0], y[1]); pk.y = pk2(y[2], y[3]); pk.z = pk2(y[4], y[5]); pk.w = pk2(y[6], y[7]);
                    *(LAS u32x4*)(ks + rl * 136 + c0) = pk;
                    u32x4 pb; pb.x = pk2(y[0] * bt, y[1] * bt); pb.y = pk2(y[2] * bt, y[3] * bt); pb.z = pk2(y[4] * bt, y[5] * bt); pb.w = pk2(y[6] * bt, y[7] * bt);
                    *(LAS u32x4*)(kb + rl * 136 + c0) = pb;
                    const float eg = bt * __expf(gc), ed = __expf(gl - gc); const int prl = kperm(rl);
#pragma unroll
                    for (int i = 0; i < 8; ++i) { kbgT[(c0 + i) * 72 + rl] = f2bf_s(y[i] * eg); kdtI[(c0 + i) * 64 + prl] = f2bf_s(y[i] * ed); }
                } else {
#pragma unroll
                    for (int i = 0; i < 8; ++i) vbT[(c0 + i) * 72 + rl] = f2bf_s(y[i] * bt);
                }
            }
        }
    }
    __syncthreads();
    {
        const int mt = wave & 3, fr = lane & 15, g = lane >> 4;
        bf16x8 ak[4], aq[4];
#pragma unroll
        for (int s = 0; s < 4; ++s) { ak[s] = *(const LAS bf16x8*)(kb + (16 * mt + fr) * 136 + 32 * s + 8 * g); aq[s] = *(const LAS bf16x8*)(qs + (16 * mt + fr) * 136 + 32 * s + 8 * g); }
#pragma unroll
        for (int t2 = 0; t2 < 2; ++t2) { const int nt = 2 * (wave >> 2) + t2;
            f32x4 ckk = {0.f, 0.f, 0.f, 0.f}, cqk = {0.f, 0.f, 0.f, 0.f};
#pragma unroll
            for (int s = 0; s < 4; ++s) { const bf16x8 b = *(const LAS bf16x8*)(ks + (16 * nt + fr) * 136 + 32 * s + 8 * g); ckk = mfma16(ak[s], b, ckk); cqk = mfma16(aq[s], b, cqk); }
            const int sc = 16 * nt + fr; const float gs = gcs[sc]; const int psc = kperm(sc);
#pragma unroll
            for (int r = 0; r < 4; ++r) { const int c = 16 * mt + 4 * g + r; const float dec = (c >= sc) ? __expf(gcs[c] - gs) : 0.f;
                Lm[c * 68 + sc] = (c > sc) ? ckk[r] * dec : 0.f;
                attI[c * 64 + psc] = f2bf_s((c >= sc) ? cqk[r] * dec : 0.f); }
        }
    }
    __syncthreads();
    if (wave == 0) {
        float t[64];
#pragma unroll
        for (int i = 0; i < 64; ++i) {
            float a = (lane == i) ? 1.0f : 0.0f;
#pragma unroll
            for (int j4 = 0; j4 < (i + 3) / 4; ++j4) { const f32x4 l4 = *(const LAS f32x4*)(Lm + i * 68 + 4 * j4);
#pragma unroll
                for (int jj = 0; jj < 4; ++jj) { const int j = 4 * j4 + jj; if (j < i) a -= l4[jj] * t[j]; } }
            t[i] = a; Tb[i * 72 + lane] = f2bf_s(a);
        }
    } else {
        const int t7 = tid - 64;
        for (int ch = t7; ch < 2560; ch += 448) {
            if (ch < 1024) *(GAS v4u*)(item + GI_KDT + ch * 16) = *(const LAS v4u*)((const LAS unsigned char*)kdtI + ch * 16);
            else if (ch < 2048) *(GAS v4u*)(item + GI_WQ + 16384 + (ch - 1024) * 16) = *(const LAS v4u*)((const LAS unsigned char*)qgI + (ch - 1024) * 16);
            else *(GAS v4u*)(item + GI_ATT + (ch - 2048) * 16) = *(const LAS v4u*)((const LAS unsigned char*)attI + (ch - 2048) * 16);
        }
    }
    __syncthreads();
    {
        const int fr = lane & 15, g = lane >> 4, col = 16 * wave + fr, pcol = kperm(col);
        bf16x8 bu[2], bw[2];
#pragma unroll
        for (int s = 0; s < 2; ++s) { bu[s] = *(const LAS bf16x8*)(vbT + col * 72 + 32 * s + 8 * g); bw[s] = *(const LAS bf16x8*)(kbgT + col * 72 + 32 * s + 8 * g); }
#pragma unroll
        for (int mt = 0; mt < 4; ++mt) { f32x4 cu = {0.f, 0.f, 0.f, 0.f}, cw = {0.f, 0.f, 0.f, 0.f};
#pragma unroll
            for (int s = 0; s < 2; ++s) { const bf16x8 a = *(const LAS bf16x8*)(Tb + (16 * mt + fr) * 72 + 32 * s + 8 * g); cu = mfma16(a, bu[s], cu); cw = mfma16(a, bw[s], cw); }
            *(LAS f32x4*)(UTI + col * 64 + 16 * mt + 4 * g) = cu;
#pragma unroll
            for (int r = 0; r < 4; ++r) WI[(16 * mt + 4 * g + r) * 128 + pcol] = f2bf_s(cw[r]); }
    }
    __syncthreads();
    for (int ch = tid; ch < 3072; ch += 512) {
        if (ch < 2048) *(GAS v4u*)(item + GI_UT + ch * 16) = *(const LAS v4u*)((const LAS unsigned char*)UTI + ch * 16);
        else *(GAS v4u*)(item + GI_WQ + (ch - 2048) * 16) = *(const LAS v4u*)((const LAS unsigned char*)WI + (ch - 2048) * 16);
    }
    if (tid == 0) *(float*)(item + GI_EG) = __expf(gl);
    __syncthreads();
}

__device__ __forceinline__ bf16x8 pack_b(const f32x4 lo, const f32x4 hi) {
    u32x4 w; w.x = pg8::cvt_pk_bf16(lo[0], lo[1]); w.y = pg8::cvt_pk_bf16(lo[2], lo[3]); w.z = pg8::cvt_pk_bf16(hi[0], hi[1]); w.w = pg8::cvt_pk_bf16(hi[2], hi[3]);
    return __builtin_bit_cast(bf16x8, w);
}
__device__ __forceinline__ void gdn_scan(const Params& P, int h, LAS unsigned char* lds, int tid, int wave, int lane) {
    using namespace cfg;
    constexpr int WQ_LD = 272, AT_LD = 144, KD_LD = 144;
    constexpr int OFF_WQ = 0, OFF_AT = 128 * WQ_LD, OFF_KD = OFF_AT + 64 * AT_LD, OFF_O = OFF_KD + 128 * KD_LD;
    LAS unsigned char* Abuf = lds;
    LAS float* Oex = (LAS float*)(lds + OFF_O);
    const unsigned char* items = P.ws + WS_GDNP + (size_t)h * NCH * GI_BYTES;
    const bf16_t* graw = (const bf16_t*)(P.ws + WS_GRAW);
    bf16_t* mix = (bf16_t*)(P.ws + WS_MIX);
    const int fr = lane & 15, g = lane >> 4, dv = 16 * wave + fr;
    v4u st[7];
#define SCAN_LOAD(nn) do { const unsigned char* it_ = items + (size_t)(nn) * GI_BYTES; \
        _Pragma("unroll") for (int i_ = 0; i_ < 4; ++i_) st[i_] = *(const GAS v4u*)(it_ + GI_WQ + (size_t)(tid + 512 * i_) * 16); \
        st[4] = *(const GAS v4u*)(it_ + GI_ATT + (size_t)tid * 16); \
        _Pragma("unroll") for (int i_ = 0; i_ < 2; ++i_) st[5 + i_] = *(const GAS v4u*)(it_ + GI_KDT + (size_t)(tid + 512 * i_) * 16); } while (0)
#define SCAN_STORE() do { \
        _Pragma("unroll") for (int i_ = 0; i_ < 4; ++i_) { const int ch_ = tid + 512 * i_; *(LAS v4u*)(Abuf + OFF_WQ + (ch_ >> 4) * WQ_LD + (ch_ & 15) * 16) = st[i_]; } \
        *(LAS v4u*)(Abuf + OFF_AT + (tid >> 3) * AT_LD + (tid & 7) * 16) = st[4]; \
        _Pragma("unroll") for (int i_ = 0; i_ < 2; ++i_) { const int ch_ = tid + 512 * i_; *(LAS v4u*)(Abuf + OFF_KD + (ch_ >> 3) * KD_LD + (ch_ & 7) * 16) = st[5 + i_]; } } while (0)
    f32x4 S[8];
#pragma unroll
    for (int i = 0; i < 8; ++i) S[i] = (f32x4){0.f, 0.f, 0.f, 0.f};
    SCAN_LOAD(0); SCAN_STORE();
    __syncthreads();
    const int frow = tid >> 3, fseg = tid & 7;
    f32x4 gn[4];
#pragma unroll
    for (int i = 0; i < 4; ++i) gn[i] = *(const f32x4*)(P.gdn_norm + 16 * fseg + 4 * i);
#pragma unroll 1
    for (int n = 0; n < NCH; ++n) {
        const unsigned char* it = items + (size_t)n * GI_BYTES;
        if (n + 1 < NCH) SCAN_LOAD(n + 1);
        f32x4 ut[4];
#pragma unroll
        for (int mt = 0; mt < 4; ++mt) ut[mt] = *(const GAS f32x4*)(it + GI_UT + ((size_t)dv * 64 + 16 * mt + 4 * g) * 4);
        const float eg = *(const float*)(it + GI_EG);
        u32x4 zr[2];
        if (n > 0) { const bf16_t* zp = graw + (size_t)(64 * n + frow) * 4096 + 3072 + h * 128 + 16 * fseg; zr[0] = *(const u32x4*)zp; zr[1] = *(const u32x4*)(zp + 8); }
        bf16x8 bs[4];
#pragma unroll
        for (int s = 0; s < 4; ++s) bs[s] = pack_b(S[2 * s], S[2 * s + 1]);
        f32x4 X[8];
#pragma unroll
        for (int mt = 0; mt < 8; ++mt) { X[mt] = (f32x4){0.f, 0.f, 0.f, 0.f};
#pragma unroll
            for (int s = 0; s < 4; ++s) { const bf16x8 a = *(const LAS bf16x8*)(Abuf + OFF_WQ + (16 * mt + fr) * WQ_LD + 64 * s + 16 * g); X[mt] = mfma16(a, bs[s], X[mt]); } }
        f32x4 vn[4];
#pragma unroll
        for (int mt = 0; mt < 4; ++mt) vn[mt] = ut[mt] - X[mt];
        bf16x8 bv[2];
#pragma unroll
        for (int s = 0; s < 2; ++s) bv[s] = pack_b(vn[2 * s], vn[2 * s + 1]);
#pragma unroll
        for (int mt = 0; mt < 4; ++mt) {
#pragma unroll
            for (int s = 0; s < 2; ++s) { const bf16x8 a = *(const LAS bf16x8*)(Abuf + OFF_AT + (16 * mt + fr) * AT_LD + 64 * s + 16 * g); X[4 + mt] = mfma16(a, bv[s], X[4 + mt]); }
#pragma unroll
            for (int r = 0; r < 4; ++r) Oex[(16 * mt + 4 * g + r) * 132 + dv] = X[4 + mt][r]; }
#pragma unroll
        for (int mt = 0; mt < 8; ++mt) { S[mt] = S[mt] * eg;
#pragma unroll
            for (int s = 0; s < 2; ++s) { const bf16x8 a = *(const LAS bf16x8*)(Abuf + OFF_KD + (16 * mt + fr) * KD_LD + 64 * s + 16 * g); S[mt] = mfma16(a, bv[s], S[mt]); } }
        __syncthreads();
        if (n + 1 < NCH) SCAN_STORE();
        if (n > 0) {
            f32x4 o4[4]; float ss = 0.f;
#pragma unroll
            for (int i = 0; i < 4; ++i) { o4[i] = *(const LAS f32x4*)(Oex + frow * 132 + 16 * fseg + 4 * i); ss += (o4[i][0] * o4[i][0] + o4[i][1] * o4[i][1]) + (o4[i][2] * o4[i][2] + o4[i][3] * o4[i][3]); }
            ss += __shfl_xor(ss, 1); ss += __shfl_xor(ss, 2); ss += __shfl_xor(ss, 4);
            const float rn = __builtin_amdgcn_rsqf(ss * (1.0f / 128.0f) + 1e-6f);
            float ov[16];
#pragma unroll
            for (int i = 0; i < 16; ++i) { const unsigned wd = zr[i >> 3][(i >> 1) & 3]; const float z = (i & 1) ? __uint_as_float(wd & 0xffff0000u) : __uint_as_float(wd << 16);
                ov[i] = o4[i >> 2][i & 3] * rn * gn[i >> 2][i & 3] * pg8::silu_f(z); }
            u32x4 w0, w1; w0.x = pk2(ov[0], ov[1]); w0.y = pk2(ov[2], ov[3]); w0.z = pk2(ov[4], ov[5]); w0.w = pk2(ov[6], ov[7]); w1.x = pk2(ov[8], ov[9]); w1.y = pk2(ov[10], ov[11]); w1.z = pk2(ov[12], ov[13]); w1.w = pk2(ov[14], ov[15]);
            bf16_t* mp = mix + (size_t)(64 * (n - 1) + frow) * 2048 + h * 128 + 16 * fseg;
            *(u32x4*)mp = w0; *(u32x4*)(mp + 8) = w1;
        }
        __syncthreads();
    }
#undef SCAN_LOAD
#undef SCAN_STORE
}

__device__ __forceinline__ int crow(int r, int hh) { return (r & 3) + 8 * (r >> 2) + 4 * hh; }
__device__ __forceinline__ s16x4 vtr(const LAS unsigned char* p) { typedef short v4i16_t __attribute__((ext_vector_type(4))); return __builtin_bit_cast(s16x4, __builtin_amdgcn_ds_read_tr16_b64_v4i16((LAS v4i16_t*)p)); }
__device__ __forceinline__ f32x16 mfma32(bf16x8 a, bf16x8 b, f32x16 c) { return __builtin_amdgcn_mfma_f32_32x32x16_bf16(a, b, c, 0, 0, 0); }
#define ATT_WAIT_V(n) asm volatile("s_waitcnt vmcnt(" #n ")" ::: "memory")

__device__ __forceinline__ void attn_unit(const Params& P, int h, int qb, LAS unsigned char* lds, float lam, float negmb, int tid, int wave, int lane) {
    using namespace cfg;
    constexpr int SLOT = 32768;
    const int r32 = lane & 31, hh = lane >> 5, map = wave >> 2, wq = wave & 3, hm = 2 * h + map;
    const bf16_t* qbuf = (const bf16_t*)(P.ws + WS_Q);
    const unsigned char* k1g = P.ws + WS_K + (size_t)(2 * h) * NCH * 8192;
    const unsigned char* k2g = P.ws + WS_K + (size_t)(2 * h + 1) * NCH * 8192;
    const unsigned char* vg = P.ws + WS_V + (size_t)h * NCH * 16384;
    const int NT = 2 * qb + 3;
#define ATT_DMA(t, slotoff) do { const size_t t_ = (size_t)(t); LAS unsigned char* sb_ = lds + (slotoff); \
        __builtin_amdgcn_global_load_lds((const unsigned*)(k1g + t_ * 8192 + wave * 1024 + lane * 16), (LAS unsigned*)(sb_ + wave * 1024), 16, 0, 0); \
        __builtin_amdgcn_global_load_lds((const unsigned*)(k2g + t_ * 8192 + wave * 1024 + lane * 16), (LAS unsigned*)(sb_ + 8192 + wave * 1024), 16, 0, 0); \
        __builtin_amdgcn_global_load_lds((const unsigned*)(vg + t_ * 16384 + wave * 1024 + lane * 16), (LAS unsigned*)(sb_ + 16384 + wave * 1024), 16, 0, 0); \
        __builtin_amdgcn_global_load_lds((const unsigned*)(vg + t_ * 16384 + (wave + 8) * 1024 + lane * 16), (LAS unsigned*)(sb_ + 16384 + (wave + 8) * 1024), 16, 0, 0); } while (0)
    ATT_DMA(0, 0); ATT_DMA(1, SLOT);
    bf16x8 qr[4];
    { const bf16_t* qp = qbuf + ((size_t)hm * 8192 + 128 * qb + 32 * wq + r32) * 64 + 8 * hh;
#pragma unroll
        for (int d0 = 0; d0 < 4; ++d0) qr[d0] = *(const bf16x8*)(qp + 16 * d0); }
    f32x16 o[4];
#pragma unroll
    for (int d0 = 0; d0 < 4; ++d0)
#pragma unroll
        for (int r = 0; r < 16; ++r) o[d0][r] = 0.f;
    float lsum = 0.f;
    const int qrel = 32 * wq + r32;
    const int vb0 = ((lane >> 4) & 1) * 32 + (lane & 3) * 8 + (4 * hh + ((lane & 15) >> 2)) * 64;
    int slot = 0, slot2 = 2 * SLOT;
#pragma unroll 1
    for (int t = 0; t < NT; ++t) {
        if (t + 1 < NT) ATT_WAIT_V(4); else ATT_WAIT_V(0);
        __builtin_amdgcn_s_barrier();
        asm volatile("" ::: "memory");
        if (t + 2 < NT) ATT_DMA(t + 2, slot2);
        const LAS unsigned char* Ks = lds + slot + map * 8192;
        const LAS unsigned char* Vs = lds + slot + 16384 + vb0;
        f32x16 p0, p1;
#pragma unroll
        for (int r = 0; r < 16; ++r) { p0[r] = negmb; p1[r] = negmb; }
#pragma unroll
        for (int d0 = 0; d0 < 4; ++d0) {
            const bf16x8 ka = *(const LAS bf16x8*)(Ks + (2 * d0 + hh) * 1024 + r32 * 16);
            const bf16x8 kb2 = *(const LAS bf16x8*)(Ks + (2 * d0 + hh) * 1024 + (r32 + 32) * 16);
            p0 = mfma32(ka, qr[d0], p0); p1 = mfma32(kb2, qr[d0], p1); }
#pragma unroll
        for (int r = 0; r < 16; ++r) { p0[r] = __builtin_amdgcn_exp2f(p0[r]); p1[r] = __builtin_amdgcn_exp2f(p1[r]); }
        if (t == 0) {
#pragma unroll
            for (int r = 0; r < 16; ++r) { p0[r] = 0.f; if (r < 8) p1[r] = 0.f; }
        } else if (t >= NT - 2) {
            const int thr = qrel - 64 * (t - (NT - 2));
#pragma unroll
            for (int r = 0; r < 16; ++r) { const int kv = crow(r, hh); if (kv > thr) p0[r] = 0.f; if (kv + 32 > thr) p1[r] = 0.f; }
        }
        float sacc = 0.f;
#pragma unroll
        for (int r = 0; r < 16; ++r) sacc += p0[r] + p1[r];
        lsum += sacc;
        bf16x8 pw[4];
        { u32x4 w;
          w.x = pg8::cvt_pk_bf16(p0[0], p0[1]); w.y = pg8::cvt_pk_bf16(p0[2], p0[3]); w.z = pg8::cvt_pk_bf16(p0[4], p0[5]); w.w = pg8::cvt_pk_bf16(p0[6], p0[7]); pw[0] = __builtin_bit_cast(bf16x8, w);
          w.x = pg8::cvt_pk_bf16(p0[8], p0[9]); w.y = pg8::cvt_pk_bf16(p0[10], p0[11]); w.z = pg8::cvt_pk_bf16(p0[12], p0[13]); w.w = pg8::cvt_pk_bf16(p0[14], p0[15]); pw[1] = __builtin_bit_cast(bf16x8, w);
          w.x = pg8::cvt_pk_bf16(p1[0], p1[1]); w.y = pg8::cvt_pk_bf16(p1[2], p1[3]); w.z = pg8::cvt_pk_bf16(p1[4], p1[5]); w.w = pg8::cvt_pk_bf16(p1[6], p1[7]); pw[2] = __builtin_bit_cast(bf16x8, w);
          w.x = pg8::cvt_pk_bf16(p1[8], p1[9]); w.y = pg8::cvt_pk_bf16(p1[10], p1[11]); w.z = pg8::cvt_pk_bf16(p1[12], p1[13]); w.w = pg8::cvt_pk_bf16(p1[14], p1[15]); pw[3] = __builtin_bit_cast(bf16x8, w); }
#pragma unroll
        for (int d0 = 0; d0 < 4; ++d0)
#pragma unroll
            for (int s = 0; s < 4; ++s) {
                const s16x4 lo = vtr(Vs + d0 * 4096 + s * 1024), hi = vtr(Vs + d0 * 4096 + s * 1024 + 512);
                const bf16x8 vf = (bf16x8){lo[0], lo[1], lo[2], lo[3], hi[0], hi[1], hi[2], hi[3]};
                o[d0] = mfma32(pw[s], vf, o[d0]); }
        slot2 = slot; slot = (slot == 2 * SLOT) ? 0 : slot + SLOT;
    }
    lsum += __shfl_xor(lsum, 32);
    asm volatile("s_waitcnt lgkmcnt(0)" ::: "memory"); __builtin_amdgcn_s_barrier(); asm volatile("" ::: "memory");
    LAS float* wsf = (LAS float*)(lds + 98304) + wave * 32;
    LAS float* Xc = (LAS float*)lds;
    if (hh == 0) wsf[r32] = lsum;
    asm volatile("s_waitcnt lgkmcnt(0)" ::: "memory");
    float rl[16];
#pragma unroll
    for (int r = 0; r < 16; ++r) rl[r] = 1.0f / wsf[crow(r, hh)];
    if (map == 1) {
#pragma unroll
        for (int d0 = 0; d0 < 4; ++d0)
#pragma unroll
            for (int r = 0; r < 16; ++r) Xc[(32 * wq + crow(r, hh)) * 132 + 32 * d0 + r32] = o[d0][r] * rl[r];
    }
    __syncthreads();
    if (map == 0) {
#pragma unroll
        for (int d0 = 0; d0 < 4; ++d0)
#pragma unroll
            for (int r = 0; r < 16; ++r) { LAS float* xp = Xc + (32 * wq + crow(r, hh)) * 132 + 32 * d0 + r32; *xp = o[d0][r] * rl[r] - lam * (*xp); }
    }
    __syncthreads();
    {
        const int row = tid >> 2, seg = tid & 3; float v[32]; float ss = 0.f;
#pragma unroll
        for (int i = 0; i < 8; ++i) { const f32x4 x4 = *(const LAS f32x4*)(Xc + row * 132 + 32 * seg + 4 * i); v[4 * i] = x4[0]; v[4 * i + 1] = x4[1]; v[4 * i + 2] = x4[2]; v[4 * i + 3] = x4[3];
            ss += (x4[0] * x4[0] + x4[1] * x4[1]) + (x4[2] * x4[2] + x4[3] * x4[3]); }
        ss += __shfl_xor(ss, 1); ss += __shfl_xor(ss, 2);
        const float rn = __builtin_amdgcn_rsqf(ss * (1.0f / 128.0f) + 1e-6f) * 0.8f;
        const float* gp = P.diff_norm + 32 * seg;
        bf16_t* mp = (bf16_t*)(P.ws + WS_MIX) + (size_t)(128 * qb + row) * 2048 + 1024 + h * 128 + 32 * seg;
#pragma unroll
        for (int i = 0; i < 4; ++i) { const f32x4 g0 = *(const f32x4*)(gp + 8 * i), g1 = *(const f32x4*)(gp + 8 * i + 4); u32x4 w;
            w.x = pk2(v[8 * i] * rn * g0[0], v[8 * i + 1] * rn * g0[1]); w.y = pk2(v[8 * i + 2] * rn * g0[2], v[8 * i + 3] * rn * g0[3]);
            w.z = pk2(v[8 * i + 4] * rn * g1[0], v[8 * i + 5] * rn * g1[1]); w.w = pk2(v[8 * i + 6] * rn * g1[2], v[8 * i + 7] * rn * g1[3]);
            *(u32x4*)(mp + 8 * i) = w; }
    }
    __syncthreads();
#undef ATT_DMA
}

__device__ __forceinline__ void attn_phase(const Params& P, LAS unsigned char* lds, unsigned* ctl, volatile LAS unsigned* misc, int tid, int wave, int lane) {
    using namespace cfg;
    float d1 = 0.f, d2 = 0.f, gq = 0.f, gk = 0.f;
    for (int i = 0; i < 64; ++i) { d1 += P.lq1[i] * P.lk1[i]; d2 += P.lq2[i] * P.lk2[i]; gq = fmaxf(gq, fabsf(P.q_norm[i])); gk = fmaxf(gk, fabsf(P.k_norm[i])); }
    const float lam = __expf(d1) - __expf(d2) + 0.2f;
    const float negmb = -(0.18033688011112042f * 64.0f * gq * gk * 1.02f);
    for (;;) {
        if (tid == 0) misc[16] = __hip_atomic_fetch_add(ctl + CW_ATTQ, 1u, __ATOMIC_RELAXED, __HIP_MEMORY_SCOPE_AGENT);
        __syncthreads();
        const unsigned u = misc[16];
        __syncthreads();
        if (u >= 512u) break;
        attn_unit(P, (int)(u & 7u), 63 - (int)(u >> 3), lds, lam, negmb, tid, wave, lane);
    }
}

#define PHASE_BEGIN() const CAS Params* pp_ = (const CAS Params*)__builtin_amdgcn_kernarg_segment_ptr(); asm volatile("" : "+s"(pp_)); Params P; P.x = (const float*)(const GAS float*)pp_->x; P.meta = (const float*)(const GAS float*)pp_->meta; P.attn_norm = (const float*)(const GAS float*)pp_->attn_norm; P.w_in = (const float*)(const GAS float*)pp_->w_in; P.conv_w = (const float*)(const GAS float*)pp_->conv_w; P.a_log = (const float*)(const GAS float*)pp_->a_log; P.dt_bias = (const float*)(const GAS float*)pp_->dt_bias; P.gdn_norm = (const float*)(const GAS float*)pp_->gdn_norm; P.q_norm = (const float*)(const GAS float*)pp_->q_norm; P.k_norm = (const float*)(const GAS float*)pp_->k_norm; P.lq1 = (const float*)(const GAS float*)pp_->lq1; P.lk1 = (const float*)(const GAS float*)pp_->lk1; P.lq2 = (const float*)(const GAS float*)pp_->lq2; P.lk2 = (const float*)(const GAS float*)pp_->lk2; P.diff_norm = (const float*)(const GAS float*)pp_->diff_norm; P.w_out = (const float*)(const GAS float*)pp_->w_out; P.ffn_norm = (const float*)(const GAS float*)pp_->ffn_norm; P.w_gu = (const float*)(const GAS float*)pp_->w_gu; P.w_dn = (const float*)(const GAS float*)pp_->w_dn; P.out = (float*)(GAS float*)pp_->out; P.ws = (unsigned char*)(GAS unsigned char*)pp_->ws; \
    int tid = threadIdx.x; asm volatile("" : "+v"(tid)); const int lane = tid & 63, wave = __builtin_amdgcn_readfirstlane(tid >> 6); \
    const int G = gridDim.x, bx = blockIdx.x, vcu = (G % 8 == 0) ? (bx % 8) * (G / 8) + bx / 8 : bx; (void)lane; (void)wave; (void)vcu; (void)bx
__global__ void __launch_bounds__(512, 2) hymba_fwd(Params Pk) {
    using namespace cfg;
    extern __shared__ __attribute__((aligned(16))) unsigned char lds_raw[];
    LAS unsigned char* lds = (LAS unsigned char*)lds_raw;
    volatile LAS unsigned* MISC = (volatile LAS unsigned*)(lds + MISC_OFF);
    XcdBarrier bar;
    {
        PHASE_BEGIN();
        unsigned* ctl = (unsigned*)(P.ws + WS_CTL);
        if (tid < 64) MISC[tid] = 0u;
        __syncthreads();
        bar = xcd_barrier_post(ctl + CW_BAR, MISC + 8);
    }

    { PHASE_BEGIN(); p0_prep(P, lds, vcu, G, wave, lane); }
    xcd_barrier(bar);
    {
        PHASE_BEGIN();
        pg8::Gemm g{(const bf16_t*)(P.ws + WS_APAD), (const bf16_t*)(P.ws + WS_WIN), MP, NPROJ, 2048}; pg8::StaticOrder S; S.init(MP, NPROJ, G, bx);
        pg8::EpiInProj E{(const float*)(P.ws + WS_RSTD), (bf16_t*)(P.ws + WS_GRAW), (bf16_t*)(P.ws + WS_Q), (bf16_t*)(P.ws + WS_K), (bf16_t*)(P.ws + WS_V),
                         (float*)(P.ws + WS_BETA), (float*)(P.ws + WS_GDEC), P.q_norm, P.k_norm, P.a_log, P.dt_bias};
        pg8::gemm_phase<pg8::EpiInProj, pg8::StaticOrder, true, true>(lds, g, S, E);
    }
    xcd_barrier(bar);
    { PHASE_BEGIN(); for (int it = vcu; it < 8 * NCH; it += G) gdn_prep_item(P, it & 7, it >> 3, lds, tid, wave, lane); }
    xcd_barrier(bar);
    if (blockIdx.x < 8) { PHASE_BEGIN(); gdn_scan(P, bx, lds, tid, wave, lane); }
    { PHASE_BEGIN(); attn_phase(P, lds, (unsigned*)(P.ws + WS_CTL), MISC, tid, wave, lane); }
    xcd_barrier(bar);
    {
        PHASE_BEGIN();
        pg8::Gemm g{(const bf16_t*)(P.ws + WS_MIX), (const bf16_t*)(P.ws + WS_WOUT), 8192, 2048, 2048}; pg8::StaticOrder S; S.init(8192, 2048, G, bx);
        pg8::EpiOutProj E{P.x, P.out, (bf16_t*)(P.ws + WS_H1B), (float*)(P.ws + WS_SSQ)};
        pg8::gemm_phase<pg8::EpiOutProj, pg8::StaticOrder, true, true>(lds, g, S, E);
    }
    xcd_barrier(bar);
    {
        PHASE_BEGIN();
        pg8::Gemm g{(const bf16_t*)(P.ws + WS_H1B), (const bf16_t*)(P.ws + WS_WGU), 8192, 2 * DFF, 2048}; pg8::StaticOrder S; S.init(8192, 2 * DFF, G, bx);
        pg8::EpiGateUp E{(const float*)(P.ws + WS_SSQ), (bf16_t*)(P.ws + WS_HID)};
        pg8::gemm_phase<pg8::EpiGateUp, pg8::StaticOrder, true, true>(lds, g, S, E);
    }
    xcd_barrier(bar);
    {
        PHASE_BEGIN();
        pg8::Gemm g{(const bf16_t*)(P.ws + WS_HID), (const bf16_t*)(P.ws + WS_WDN), 8192, 2048, DFF}; pg8::StaticOrder S; S.init(8192, 2048, G, bx);
        pg8::EpiDown E{P.out};
        pg8::gemm_phase<pg8::EpiDown, pg8::StaticOrder, true, true>(lds, g, S, E);
    }
}

extern "C" void kernel_launch(void* const* d_in, const int* in_sizes, int n_in, void* d_out, int out_size, void* d_ws, size_t ws_size, hipStream_t stream) {
    using namespace cfg;
    static int grid = 0;
    if (grid == 0) {
        if (n_in != 19 || in_sizes[0] != SEQ * DMODEL || out_size != SEQ * DMODEL || ws_size < WS_END) {
            fprintf(stderr, "kernel_launch: unexpected shapes (n_in %d, in0 %d, out %d, ws %zu, need %zu); nothing launched\n", n_in, n_in > 0 ? in_sizes[0] : -1, out_size, ws_size, (size_t)WS_END); grid = -1; return; }
        int dev = 0, cus = 0, per_cu = 0;
        if (hipGetDevice(&dev) != hipSuccess || hipDeviceGetAttribute(&cus, hipDeviceAttributeMultiprocessorCount, dev) != hipSuccess) { fprintf(stderr, "kernel_launch: device query failed\n"); grid = -1; return; }
        if (hipFuncSetAttribute((const void*)hymba_fwd, hipFuncAttributeMaxDynamicSharedMemorySize, LDS_BYTES) != hipSuccess) { fprintf(stderr, "kernel_launch: hipFuncSetAttribute failed\n"); grid = -1; return; }
        if (hipOccupancyMaxActiveBlocksPerMultiprocessor(&per_cu, (const void*)hymba_fwd, 512, LDS_BYTES) != hipSuccess || per_cu < 1)
            fprintf(stderr, "kernel_launch: note: occupancy query reports %d workgroups per CU\n", per_cu);
        (void)hipGetLastError();
        grid = cus;
    }
    if (grid < 0) return;
    if (hipMemsetAsync((char*)d_ws + WS_CTL, 0, CTL_ZERO_BYTES, stream) != hipSuccess) { fprintf(stderr, "kernel_launch: memset failed\n"); return; }
    Params p{};
    const float** pp = (const float**)&p;
    for (int i = 0; i < 19; ++i) pp[i] = (const float*)d_in[i];
    p.out = (float*)d_out; p.ws = (unsigned char*)d_ws;
    hipLaunchKernelGGL(hymba_fwd, dim3(grid), dim3(512), LDS_BYTES, stream, p);
    const hipError_t le = hipPeekAtLastError();
    if (le != hipSuccess) fprintf(stderr, "kernel_launch: launch failed: %s\n", hipGetErrorName(le));
}
```

```cpp
#include <hip/hip_runtime.h>
#include <hip/hip_bf16.h>
#include <cstdio>
#include <cstdint>
#include <cmath>
#if defined(PROBE_DUP) && PROBE_DUP == 13
#define PG8_EPI_REP 3
#else
#define PG8_EPI_REP 1
#endif
namespace pg8 {
#define PG8_LAS __attribute__((address_space(3)))
typedef unsigned short bf16_t;
typedef short bf16x8 __attribute__((ext_vector_type(8)));
typedef float f32x4 __attribute__((ext_vector_type(4)));
typedef unsigned u32x4 __attribute__((ext_vector_type(4)));
constexpr int BM = 256, BK = 64, HALF = 128, HTB = HALF * BK * 2  , STAGE_BYTES = 8 * HTB, NXCD = 8, WGM = 8;

__host__ __device__ __forceinline__ int lds_byte(int r, int c) { const int st = (r >> 4) * 2 + (c >> 5), rr = r & 15, cc = c & 31, ob = rr * 64 + cc * 2; return st * 1024 + (ob ^ (((ob >> 9) & 1) << 5)); }
__host__ __device__ __forceinline__ void stage_rc(int b, int& R, int& C) { const int st = b / 1024, sb = b % 1024, swz = sb ^ (((sb >> 9) & 1) << 5); R = (st >> 1) * 16 + swz / 64; C = (st & 1) * 32 + (swz % 64) / 2; }
__host__ __device__ __forceinline__ int perm32(int rho) { const int n = rho >> 4, i = rho & 15; return 8 * (i >> 2) + 4 * n + (i & 3); }

struct Unit { int pm, pn; };
struct Gemm { const bf16_t* A; const bf16_t* Bt; int M, N, K; };

struct StaticOrder {
    int nM, nN, nwg, G, c;
    __host__ __device__ __attribute__((always_inline)) void init(int M, int N, int G_, int c_) { nM = M / BM; nN = N / BM; nwg = nM * nN; G = G_; c = c_; }
    __host__ __device__ __attribute__((always_inline)) bool next(int i, Unit& u) const {
        const long L = (long)i * G + c; if (L >= nwg) return false;
        int wgid = (int)L; { const int q = nwg / NXCD, r = nwg % NXCD, xcd = wgid % NXCD, off = wgid / NXCD; wgid = (xcd < r ? xcd * (q + 1) : r * (q + 1) + (xcd - r) * q) + off; }
        const int nig = WGM * nN, gid = wgid / nig, fm = gid * WGM, gsz = (nM - fm) < WGM ? (nM - fm) : WGM;
        u.pm = fm + ((wgid % nig) % gsz); u.pn = (wgid % nig) / gsz; return true;
    }
    __device__ __forceinline__ void a_ready(const Unit&) const {}
    __device__ __forceinline__ void done(const Unit&) const {}
};


__device__ __forceinline__ unsigned cvt_pk_bf16(float lo, float hi) { unsigned r; asm volatile("v_cvt_pk_bf16_f32 %0, %1, %2" : "=v"(r) : "v"(lo), "v"(hi)); return r; }
__device__ __forceinline__ u32x4 pack8(const f32x4 a, const f32x4 b) { u32x4 w; w.x = cvt_pk_bf16(a[0], a[1]); w.y = cvt_pk_bf16(a[2], a[3]); w.z = cvt_pk_bf16(b[0], b[1]); w.w = cvt_pk_bf16(b[2], b[3]); return w; }
__device__ __forceinline__ float silu_f(float v) { return v * __builtin_amdgcn_rcpf(1.0f + __builtin_amdgcn_exp2f(-1.4426950408889634f * v)); }

__constant__ float REV0[32] = {
    1.591549431e-01f, 1.193493785e-01f, 8.949940276e-02f, 6.711508467e-02f, 5.032921177e-02f, 3.774158578e-02f, 2.830219557e-02f, 2.122365077e-02f, 1.591549455e-02f, 1.193493619e-02f, 8.949940158e-03f, 6.711508704e-03f, 5.032920939e-03f, 3.774158578e-03f, 2.830219617e-03f, 2.122365373e-03f,
    1.591549395e-03f, 1.193493663e-03f, 8.949940158e-04f, 6.711507963e-04f, 5.032921162e-04f, 3.774158282e-04f, 2.830219617e-04f, 2.122365299e-04f, 1.591549507e-04f, 1.193493756e-04f, 8.949939787e-05f, 6.711508519e-05f, 5.032921069e-05f, 3.774158467e-05f, 2.830219570e-05f, 2.122365391e-05f};
__constant__ float REV1[32] = {
    1.859163579e-01f, 6.383602235e-01f, 7.279617768e-01f, 2.953654189e-01f, 2.210695530e-01f, 4.154614901e-01f, 8.113405167e-01f, 3.583136490e-01f, 1.859165097e-02f, 7.638359161e-01f, 5.727961701e-01f, 4.295365571e-01f, 3.221069401e-01f, 2.415461490e-01f, 1.811340555e-01f, 1.358313839e-01f,
    1.018591613e-01f, 7.638359446e-02f, 5.727961701e-02f, 4.295365096e-02f, 3.221069544e-02f, 2.415461300e-02f, 1.811340555e-02f, 1.358313791e-02f, 1.018591684e-02f, 7.638360038e-03f, 5.727961464e-03f, 4.295365452e-03f, 3.221069484e-03f, 2.415461419e-03f, 1.811340525e-03f, 1.358313851e-03f};

struct EpiInProj {
    static constexpr bool PERM = true, AFTER_DRAIN = false, INIT = false;
#if defined(PROBE_DUP) && PROBE_DUP == 14
    static constexpr int REP = 3;
#else
    static constexpr int REP = 1;
#endif
    const float* rstd;
    bf16_t* graw;
    bf16_t* qbuf;
    bf16_t* kimg;
    bf16_t* vimg;
    float* beta; float* gdec;
    const float* qn; const float* kn; const float* a_log; const float* dt_bias;
    __device__ __forceinline__ void operator()(const f32x4 (&acc)[2][2][4][2], const Unit& u, int wr, int wc, int fr, int fq) const {
        asm volatile("" : "+v"(fr), "+v"(fq));
        const int pn = u.pn, row0 = u.pm * BM + wr * 64 + fr;
        float rsv[2][4];
#pragma unroll
        for (int ai = 0; ai < 2; ++ai)
#pragma unroll
            for (int m = 0; m < 4; ++m) rsv[ai][m] = rstd[row0 + ai * HALF + m * 16];
        if (pn < 16) {
#pragma unroll
            for (int ai = 0; ai < 2; ++ai)
#pragma unroll
                for (int m = 0; m < 4; ++m) { const int row = row0 + ai * HALF + m * 16; const float rs = rsv[ai][m];
                    bf16_t* rowp = graw + (size_t)row * 4096 + pn * 256 + wc * 32 + 8 * fq;
#pragma unroll
                    for (int bj = 0; bj < 2; ++bj) *(u32x4*)(rowp + bj * HALF) = pack8(acc[ai][bj][m][0] * rs, acc[ai][bj][m][1] * rs); }
        } else if (pn < 24) {
            const int G = 4 * (pn - 16) + wc; const bool isK = G >= 16; const int hm = G & 15;
            const float* gp = (isK ? kn : qn) + 8 * fq;
            f32x4 gn[2][2];
#pragma unroll
            for (int bj = 0; bj < 2; ++bj)
#pragma unroll
                for (int n = 0; n < 2; ++n) gn[bj][n] = *(const f32x4*)(gp + 32 * bj + 4 * n);
            f32x4 rf0[2], rf1[2];
#pragma unroll
            for (int n = 0; n < 2; ++n) { rf0[n] = *(const f32x4*)(REV0 + 8 * fq + 4 * n); rf1[n] = *(const f32x4*)(REV1 + 8 * fq + 4 * n); }
            const float osc = isK ? 1.0f : 0.18033688011112042f;
#pragma unroll
            for (int ai = 0; ai < 2; ++ai)
#pragma unroll
                for (int m = 0; m < 4; ++m) { const int row = row0 + ai * HALF + m * 16; const float rs = rsv[ai][m];
                    f32x4 x[2][2]; float ss = 0.f;
#pragma unroll
                    for (int bj = 0; bj < 2; ++bj)
#pragma unroll
                        for (int n = 0; n < 2; ++n) { x[bj][n] = acc[ai][bj][m][n] * rs; ss += (x[bj][n][0] * x[bj][n][0] + x[bj][n][1] * x[bj][n][1]) + (x[bj][n][2] * x[bj][n][2] + x[bj][n][3] * x[bj][n][3]); }
                    ss += __shfl_xor(ss, 16); ss += __shfl_xor(ss, 32);
                    const float rn = __builtin_amdgcn_rsqf(ss * (1.0f / 64.0f) + 1e-6f) * osc;
                    const int pos = row < 48 ? 0 : row - 48; const float pa = (float)(pos >> 6), pb = (float)(pos & 63);
                    f32x4 o[2][2];
#pragma unroll
                    for (int n = 0; n < 2; ++n)
#pragma unroll
                        for (int j = 0; j < 4; ++j) {
                            const float fr_ = __builtin_amdgcn_fractf(pa * rf1[n][j] + pb * rf0[n][j]);
                            const float sn = __builtin_amdgcn_sinf(fr_), cs = __builtin_amdgcn_cosf(fr_);
                            const float y1 = x[0][n][j] * rn * gn[0][n][j], y2 = x[1][n][j] * rn * gn[1][n][j];
                            o[0][n][j] = y1 * cs - y2 * sn; o[1][n][j] = y2 * cs + y1 * sn; }
                    if (!isK) {
                        if (row >= 64 && row < 8256) { bf16_t* qp = qbuf + ((size_t)hm * 8192 + (row - 64)) * 64 + 8 * fq;
#pragma unroll
                            for (int bj = 0; bj < 2; ++bj) *(u32x4*)(qp + 32 * bj) = pack8(o[bj][0], o[bj][1]); }
                    } else if (row < 8256) { bf16_t* kp = kimg + ((size_t)(hm * 129 + (row >> 6)) * 8 + fq) * 512 + (row & 63) * 8;
#pragma unroll
                        for (int bj = 0; bj < 2; ++bj) *(u32x4*)(kp + bj * 4 * 512) = pack8(o[bj][0], o[bj][1]); }
                }
        } else if (pn < 28) {
#pragma unroll
            for (int ai = 0; ai < 2; ++ai)
#pragma unroll
                for (int m = 0; m < 4; ++m) { const int row = row0 + ai * HALF + m * 16; const float rs = rsv[ai][m];
                    if (row < 8256) {
#pragma unroll
                        for (int bj = 0; bj < 2; ++bj) { const int head = 2 * (pn - 24) + bj;
                            bf16_t* vp = vimg + ((size_t)(head * 129 + (row >> 6)) * 4 + wc) * 2048 + (row & 63) * 32 + 8 * fq;
                            *(u32x4*)vp = pack8(acc[ai][bj][m][0] * rs, acc[ai][bj][m][1] * rs); } } }
        } else {
            if (wc == 0 && fq < 2) {
                f32x4 dtb[2], ea[2];
#pragma unroll
                for (int n = 0; n < 2; ++n) { dtb[n] = *(const f32x4*)(dt_bias + 4 * n); const f32x4 al = *(const f32x4*)(a_log + 4 * n);
#pragma unroll
                    for (int j = 0; j < 4; ++j) ea[n][j] = __builtin_amdgcn_exp2f(1.4426950408889634f * al[j]); }
#pragma unroll
                for (int ai = 0; ai < 2; ++ai)
#pragma unroll
                    for (int m = 0; m < 4; ++m) { const int row = row0 + ai * HALF + m * 16; const float rs = rsv[ai][m];
                        if (row < 8256) {
#pragma unroll
                            for (int n = 0; n < 2; ++n)
#pragma unroll
                                for (int j = 0; j < 4; ++j) { const int hd = 4 * n + j; const float v = acc[ai][0][m][n][j] * rs; float r;
                                    if (fq == 0) { r = __builtin_amdgcn_rcpf(1.0f + __builtin_amdgcn_exp2f(-1.4426950408889634f * v)); if (row < 48) r = 0.f; beta[(size_t)hd * 8256 + row] = r; }
                                    else { const float y = v + dtb[n][j]; const float ey = __builtin_amdgcn_exp2f(1.4426950408889634f * y);
                                        const float sp = (y > 15.f) ? y : ((ey < 1e-4f) ? ey : 0.6931471805599453f * __builtin_amdgcn_logf(1.0f + ey));
                                        r = -ea[n][j] * sp; if (row < 48) r = 0.f; gdec[(size_t)hd * 8256 + row] = r; } } } }
            }
        }
    }
};

struct EpiOutProj {
    static constexpr bool PERM = true, AFTER_DRAIN = false, INIT = true; static constexpr int REP = 1;
    const float* x; bf16_t* h1b; float* ssq;
    __device__ __forceinline__ void init(f32x4 (&acc)[2][2][4][2], const Unit& u, int wr, int wc, int fr, int fq) const {
        asm volatile("" : "+v"(fr), "+v"(fq));
        const int row0 = u.pm * BM + wr * 64 + fr, col0 = u.pn * BM + wc * 32 + 8 * fq;
#pragma unroll
        for (int ai = 0; ai < 2; ++ai)
#pragma unroll
            for (int m = 0; m < 4; ++m) { const size_t off = (size_t)(row0 + ai * HALF + m * 16) * 2048 + col0;
#pragma unroll
                for (int bj = 0; bj < 2; ++bj)
#pragma unroll
                    for (int n = 0; n < 2; ++n) acc[ai][bj][m][n] = *(const f32x4*)(x + off + bj * HALF + 4 * n); }
    }
    __device__ __forceinline__ void operator()(const f32x4 (&acc)[2][2][4][2], const Unit& u, int wr, int wc, int fr, int fq) const {
        asm volatile("" : "+v"(fr), "+v"(fq));
        const int row0 = u.pm * BM + wr * 64 + fr, col0 = u.pn * BM + wc * 32 + 8 * fq;
#pragma unroll
        for (int ai = 0; ai < 2; ++ai)
#pragma unroll
            for (int m = 0; m < 4; ++m) { const int row = row0 + ai * HALF + m * 16; const size_t off = (size_t)row * 2048 + col0; float ss = 0.f;
#pragma unroll
                for (int bj = 0; bj < 2; ++bj) {
#pragma unroll
                    for (int n = 0; n < 2; ++n) { const f32x4 v = acc[ai][bj][m][n]; ss += (v[0] * v[0] + v[1] * v[1]) + (v[2] * v[2] + v[3] * v[3]); }
                    *(u32x4*)(h1b + off + bj * HALF) = pack8(acc[ai][bj][m][0], acc[ai][bj][m][1]); }
                ss += __shfl_xor(ss, 16); ss += __shfl_xor(ss, 32);
                if (fq == 0) ssq[(size_t)row * 32 + u.pn * 4 + wc] = ss; }
    }
};

struct EpiGateUp {
    static constexpr bool PERM = true, AFTER_DRAIN = false, INIT = false; static constexpr int REP = 1;
    const float* ssq; bf16_t* hid; const PG8_LAS float* rs2; int rs2_pm;
    __device__ __forceinline__ void operator()(const f32x4 (&acc)[2][2][4][2], const Unit& u, int wr, int wc, int fr, int fq) const {
        asm volatile("" : "+v"(fr), "+v"(fq));
        const int row0 = u.pm * BM + wr * 64 + fr, col0 = u.pn * HALF + wc * 32 + 8 * fq;
        float rsv[2][4];
        if (u.pm == rs2_pm) {
#pragma unroll
            for (int ai = 0; ai < 2; ++ai)
#pragma unroll
                for (int m = 0; m < 4; ++m) rsv[ai][m] = rs2[wr * 64 + fr + ai * HALF + m * 16];
        } else {
#pragma unroll
            for (int ai = 0; ai < 2; ++ai)
#pragma unroll
                for (int m = 0; m < 4; ++m) { const f32x4* sp = (const f32x4*)(ssq + (size_t)(row0 + ai * HALF + m * 16) * 32); f32x4 s4 = sp[0];
#pragma unroll
                    for (int i = 1; i < 8; ++i) s4 += sp[i];
                    rsv[ai][m] = __builtin_amdgcn_rsqf(((s4[0] + s4[1]) + (s4[2] + s4[3])) * (1.0f / 2048.0f) + 1e-6f); }
        }
#pragma unroll
        for (int ai = 0; ai < 2; ++ai)
#pragma unroll
            for (int m = 0; m < 4; ++m) { const int row = row0 + ai * HALF + m * 16; const float rs = rsv[ai][m];
                f32x4 hv[2];
#pragma unroll
                for (int n = 0; n < 2; ++n)
#pragma unroll
                    for (int j = 0; j < 4; ++j) { const float g = acc[ai][0][m][n][j] * rs, up = acc[ai][1][m][n][j] * rs; hv[n][j] = silu_f(g) * up; }
                *(u32x4*)(hid + (size_t)row * 5632 + col0) = pack8(hv[0], hv[1]); }
    }
};

struct EpiDown {
    static constexpr bool PERM = true, AFTER_DRAIN = false, INIT = true; static constexpr int REP = 1;
    const bf16_t* h1b; float* out;
    __device__ __forceinline__ void init(f32x4 (&acc)[2][2][4][2], const Unit& u, int wr, int wc, int fr, int fq) const {
        asm volatile("" : "+v"(fr), "+v"(fq));
        const int row0 = u.pm * BM + wr * 64 + fr, col0 = u.pn * BM + wc * 32 + 8 * fq;
#pragma unroll
        for (int ai = 0; ai < 2; ++ai)
#pragma unroll
            for (int m = 0; m < 4; ++m)
#pragma unroll
                for (int bj = 0; bj < 2; ++bj) { const u32x4 h4 = *(const u32x4*)(h1b + (size_t)(row0 + ai * HALF + m * 16) * 2048 + col0 + bj * HALF);
                    f32x4 r0, r1;
                    r0[0] = __uint_as_float(h4.x << 16); r0[1] = __uint_as_float(h4.x & 0xffff0000u); r0[2] = __uint_as_float(h4.y << 16); r0[3] = __uint_as_float(h4.y & 0xffff0000u);
                    r1[0] = __uint_as_float(h4.z << 16); r1[1] = __uint_as_float(h4.z & 0xffff0000u); r1[2] = __uint_as_float(h4.w << 16); r1[3] = __uint_as_float(h4.w & 0xffff0000u);
                    acc[ai][bj][m][0] = r0; acc[ai][bj][m][1] = r1; }
    }
    __device__ __forceinline__ void operator()(const f32x4 (&acc)[2][2][4][2], const Unit& u, int wr, int wc, int fr, int fq) const {
        asm volatile("" : "+v"(fr), "+v"(fq));
        const int row0 = u.pm * BM + wr * 64 + fr, col0 = u.pn * BM + wc * 32 + 8 * fq;
#pragma unroll
        for (int ai = 0; ai < 2; ++ai)
#pragma unroll
            for (int m = 0; m < 4; ++m) { const size_t off = (size_t)(row0 + ai * HALF + m * 16) * 2048 + col0;
#pragma unroll
                for (int bj = 0; bj < 2; ++bj) { *(f32x4*)(out + off + bj * HALF) = acc[ai][bj][m][0]; *(f32x4*)(out + off + bj * HALF + 4) = acc[ai][bj][m][1]; } }
    }
};

template <class Epi, class Sched, bool ALIGN_EPI = false, bool SP2 = false>
__device__ __forceinline__ void gemm_phase(PG8_LAS unsigned char* lds, const Gemm g, const Sched& S, const Epi& E, int tid_in) {
    int tid = tid_in; asm volatile("" : "+v"(tid)); const int wid = __builtin_amdgcn_readfirstlane(tid >> 6), lane = tid & 63, wr = wid >> 2, wc = wid & 3, fr = lane & 15, fq = lane >> 4;
    const int K = g.K, nt = K / BK;
    unsigned voffA[2], voffB[2];
#pragma unroll
    for (int i = 0; i < 2; ++i) { int R, C; stage_rc(tid * 16 + i * 8192, R, C); const int Rb = Epi::PERM ? ((R & ~31) + perm32(R & 31)) : R;
        voffA[i] = (unsigned)(R * K + C) * 2u; voffB[i] = (unsigned)(Rb * K + C) * 2u; }
    const size_t kstep = (size_t)(BK * 2);
    const size_t hstep = (size_t)HALF * K * 2;
    const size_t tstep = 2 * hstep;
    const unsigned ldsw = (unsigned)wid * 1024u;
    const int aoff = lds_byte(wr * 64 + fr, fq * 8), boff = lds_byte(wc * 32 + fr, fq * 8);
#define PG8_SA(b, h) (((b) * 2 + (h)) * HTB)
#define PG8_SB(b, h) ((4 + (b) * 2 + (h)) * HTB)
#define PG8_STAGE(bufoff, gbase, voff) do { _Pragma("unroll") for (int _i = 0; _i < 2; ++_i) \
        __builtin_amdgcn_global_load_lds((const unsigned*)((const char*)(gbase) + (voff)[_i]), (PG8_LAS unsigned*)(lds + (bufoff) + ldsw + _i * 8192), 16, 0, 0); } while (0)
#define PG8_LDA(dst, b, h) do { _Pragma("unroll") for (int m = 0; m < 4; ++m) _Pragma("unroll") for (int k = 0; k < 2; ++k) dst[m][k] = *(const PG8_LAS bf16x8*)(lds + PG8_SA(b, h) + aoff + m * 2048 + k * 1024); } while (0)
#define PG8_LDB(dst, b, h) do { _Pragma("unroll") for (int n = 0; n < 2; ++n) _Pragma("unroll") for (int k = 0; k < 2; ++k) dst[n][k] = *(const PG8_LAS bf16x8*)(lds + PG8_SB(b, h) + boff + n * 2048 + k * 1024); } while (0)
#define PG8_MMA(ai, bj, At, Bt) do { __builtin_amdgcn_s_setprio(1); _Pragma("unroll") for (int m = 0; m < 4; ++m) _Pragma("unroll") for (int n = 0; n < 2; ++n) _Pragma("unroll") for (int k = 0; k < 2; ++k) \
        acc[ai][bj][m][n] = __builtin_amdgcn_mfma_f32_16x16x32_bf16(Bt[n][k], At[m][k], acc[ai][bj][m][n], 0, 0, 0); __builtin_amdgcn_s_setprio(0); } while (0)
#define PG8_WAIT_V(n) asm volatile("s_waitcnt vmcnt(" #n ")" ::: "memory")
#define PG8_WAIT_L(n) asm volatile("s_waitcnt lgkmcnt(" #n ")" ::: "memory")
#define PG8_BAR __builtin_amdgcn_s_barrier()
#define PG8_SCHED __builtin_amdgcn_sched_barrier(0)
    Unit cur, nxt; int ui = 0;
    if (!S.next(0, cur)) return;
    f32x4 acc[2][2][4][2];
    if constexpr (Epi::INIT) E.init(acc, cur, wr, wc, fr, fq);
    else {
#pragma unroll
    for (int a = 0; a < 2; ++a)
#pragma unroll
        for (int b = 0; b < 2; ++b)
#pragma unroll
            for (int m = 0; m < 4; ++m)
#pragma unroll
                for (int n = 0; n < 2; ++n) acc[a][b][m][n] = (f32x4){0.f, 0.f, 0.f, 0.f};
    }
    bf16x8 At[4][2], B0[2][2], B1[2][2];
    const char* cA = (const char*)g.A + (size_t)cur.pm * tstep; const char* cB = (const char*)g.Bt + (size_t)cur.pn * tstep;
    S.a_ready(cur);
    if constexpr (SP2) {
        PG8_STAGE(PG8_SB(0, 0), cB, voffB); PG8_STAGE(PG8_SB(0, 1), cB + hstep, voffB); PG8_STAGE(PG8_SA(0, 0), cA, voffA); PG8_STAGE(PG8_SA(0, 1), cA + hstep, voffA);
        if (wr == 1) PG8_BAR;
        PG8_WAIT_V(2); PG8_BAR;
        PG8_STAGE(PG8_SB(1, 0), cB + kstep, voffB); PG8_STAGE(PG8_SA(1, 0), cA + kstep, voffA); PG8_STAGE(PG8_SB(1, 1), cB + hstep + kstep, voffB);
        PG8_WAIT_V(6); PG8_BAR;
    } else {
        PG8_STAGE(PG8_SB(0, 0), cB, voffB); PG8_STAGE(PG8_SA(0, 0), cA, voffA); PG8_STAGE(PG8_SB(0, 1), cB + hstep, voffB); PG8_STAGE(PG8_SA(0, 1), cA + hstep, voffA);
        if (wr == 1) PG8_BAR;
        PG8_WAIT_V(4); PG8_BAR;
        PG8_STAGE(PG8_SB(1, 0), cB + kstep, voffB); PG8_STAGE(PG8_SA(1, 0), cA + kstep, voffA); PG8_STAGE(PG8_SB(1, 1), cB + hstep + kstep, voffB);
        PG8_WAIT_V(6); PG8_BAR;
    }
    for (;;) {
        const bool has_next = S.next(ui + 1, nxt);
        const char* nA = has_next ? (const char*)g.A + (size_t)nxt.pm * tstep : cA; const char* nB = has_next ? (const char*)g.Bt + (size_t)nxt.pn * tstep : cB;
        for (int t = 0; t < nt; t += 2) {
            const bool last = (t == nt - 2);
            const char* a1 = cA + (size_t)(t + 1) * kstep;
            const char* a2 = last ? nA : cA + (size_t)(t + 2) * kstep; const char* b2 = last ? nB : cB + (size_t)(t + 2) * kstep;
            const char* a3 = a2 + kstep; const char* b3 = b2 + kstep;
            if (last && has_next) S.a_ready(nxt);
            if constexpr (SP2) {
            PG8_LDB(B0, 0, 0); PG8_LDB(B1, 0, 1); PG8_SCHED; PG8_LDA(At, 0, 0); PG8_STAGE(PG8_SA(1, 1), a1 + hstep, voffA);
            PG8_WAIT_V(8); PG8_WAIT_L(0); PG8_BAR; PG8_MMA(0, 0, At, B0); PG8_MMA(0, 1, At, B1); PG8_BAR; PG8_SCHED;
            PG8_LDA(At, 0, 1); PG8_STAGE(PG8_SB(0, 0), b2, voffB); PG8_STAGE(PG8_SB(0, 1), b2 + hstep, voffB); PG8_STAGE(PG8_SA(0, 0), a2, voffA);
            PG8_WAIT_V(8); PG8_WAIT_L(0); PG8_BAR; PG8_MMA(1, 0, At, B0); PG8_MMA(1, 1, At, B1); PG8_BAR; PG8_SCHED;
            PG8_LDB(B0, 1, 0); PG8_LDB(B1, 1, 1); PG8_SCHED; PG8_LDA(At, 1, 0); PG8_STAGE(PG8_SA(0, 1), a2 + hstep, voffA);
            PG8_WAIT_V(8); PG8_WAIT_L(0); PG8_BAR; PG8_MMA(0, 0, At, B0); PG8_MMA(0, 1, At, B1); PG8_BAR; PG8_SCHED;
            PG8_LDA(At, 1, 1); PG8_STAGE(PG8_SB(1, 0), b3, voffB); PG8_STAGE(PG8_SB(1, 1), b3 + hstep, voffB); PG8_STAGE(PG8_SA(1, 0), a3, voffA);
            PG8_WAIT_V(8); PG8_WAIT_L(0); PG8_BAR; PG8_MMA(1, 0, At, B0); PG8_MMA(1, 1, At, B1); PG8_BAR; PG8_SCHED;
            } else {
            PG8_LDB(B0, 0, 0); PG8_SCHED; PG8_LDA(At, 0, 0); PG8_STAGE(PG8_SA(1, 1), a1 + hstep, voffA);
            PG8_WAIT_L(8); PG8_BAR; PG8_WAIT_L(0); PG8_MMA(0, 0, At, B0); PG8_BAR; PG8_SCHED;
            PG8_LDB(B1, 0, 1); PG8_STAGE(PG8_SB(0, 0), b2, voffB);
            PG8_BAR; PG8_WAIT_L(0); PG8_MMA(0, 1, At, B1); PG8_BAR;
            PG8_LDA(At, 0, 1); PG8_STAGE(PG8_SA(0, 0), a2, voffA);
            PG8_BAR; PG8_WAIT_L(0); PG8_MMA(1, 0, At, B0); PG8_BAR; PG8_SCHED;
            PG8_STAGE(PG8_SB(0, 1), b2 + hstep, voffB);
            PG8_WAIT_V(6); PG8_BAR; PG8_MMA(1, 1, At, B1); PG8_BAR;
            PG8_LDB(B0, 1, 0); PG8_SCHED; PG8_LDA(At, 1, 0); PG8_STAGE(PG8_SA(0, 1), a2 + hstep, voffA);
            PG8_WAIT_L(8); PG8_BAR; PG8_WAIT_L(0); PG8_MMA(0, 0, At, B0); PG8_BAR; PG8_SCHED;
            PG8_LDB(B1, 1, 1); PG8_STAGE(PG8_SB(1, 0), b3, voffB);
            PG8_BAR; PG8_WAIT_L(0); PG8_MMA(0, 1, At, B1); PG8_BAR;
            PG8_LDA(At, 1, 1); PG8_STAGE(PG8_SA(1, 0), a3, voffA);
            PG8_BAR; PG8_WAIT_L(0); PG8_MMA(1, 0, At, B0); PG8_BAR; PG8_SCHED;
            PG8_STAGE(PG8_SB(1, 1), b3 + hstep, voffB);
            PG8_WAIT_V(6); PG8_BAR; PG8_MMA(1, 1, At, B1); PG8_BAR;
            }
        }
        if constexpr (ALIGN_EPI) { if (wr == 0) PG8_BAR; }
        if constexpr (!Epi::AFTER_DRAIN) { for (int rp_ = 0; rp_ < PG8_EPI_REP * Epi::REP; ++rp_) E(acc, cur, wr, wc, fr, fq); S.done(cur); }
        if (!has_next) break;
        if constexpr (Epi::INIT) E.init(acc, nxt, wr, wc, fr, fq);
        else {
#pragma unroll
        for (int a = 0; a < 2; ++a)
#pragma unroll
            for (int b = 0; b < 2; ++b)
#pragma unroll
                for (int m = 0; m < 4; ++m)
#pragma unroll
                    for (int n = 0; n < 2; ++n) acc[a][b][m][n] = (f32x4){0.f, 0.f, 0.f, 0.f};
        }
        cur = nxt; cA = nA; cB = nB; ++ui;
        if constexpr (ALIGN_EPI) { if (wr == 1) PG8_BAR; }
    }
    PG8_WAIT_V(0);
    if constexpr (!ALIGN_EPI) { if (wr == 0) PG8_BAR; }
    PG8_BAR;
    if constexpr (Epi::AFTER_DRAIN) { E.fused(acc, cur, wr, wc, fr, fq, lds, wid, lane); S.done(cur); }
#undef PG8_SA
#undef PG8_SB
#undef PG8_STAGE
#undef PG8_LDA
#undef PG8_LDB
#undef PG8_MMA
#undef PG8_WAIT_V
#undef PG8_WAIT_L
#undef PG8_BAR
#undef PG8_SCHED
}
}
#define GAS __attribute__((address_space(1)))
#define LAS __attribute__((address_space(3)))
typedef unsigned short bf16;
typedef unsigned v4u __attribute__((ext_vector_type(4)));
typedef float f32x4 __attribute__((ext_vector_type(4)));
typedef short bf16x8 __attribute__((ext_vector_type(8)));
typedef GAS unsigned gu32;
typedef GAS unsigned long long gu64;
#define RLX_AGENT __ATOMIC_RELAXED, __HIP_MEMORY_SCOPE_AGENT
#define LDS_WAIT() asm volatile("s_waitcnt lgkmcnt(0)" ::: "memory")
#define VM_WAIT() asm volatile("s_waitcnt vmcnt(0)" ::: "memory")
__device__ __forceinline__ unsigned long long rt() { return __builtin_amdgcn_s_memrealtime(); }
__device__ __forceinline__ unsigned f2bf(float f) { unsigned u = __builtin_bit_cast(unsigned, f); return (u + 0x7fffu + ((u >> 16) & 1u)) >> 16; }
typedef float f32x2_cv __attribute__((ext_vector_type(2))); typedef __bf16 bf16x2_cv __attribute__((ext_vector_type(2)));
__device__ __forceinline__ unsigned pk2(float lo, float hi) { const f32x2_cv v = {lo, hi}; return __builtin_bit_cast(unsigned, __builtin_convertvector(v, bf16x2_cv)); }

#define XB_TMO      128
#define XB_XCNT(j)  (256  + 64 * (j))
#define XB_XSUB(j)  (1280 + 64 * (j))
#define XB_XGEN(j)  (2304 + 64 * (j))
#define XB_TOP      3328
#define XB_TOPGEN   3392
#define XCD_BAR_WORDS 3456
#define XB_SPIN_CAP (1u << 18)

__device__ __forceinline__ unsigned xb_ld(unsigned* p)              { return __hip_atomic_load(p, __ATOMIC_RELAXED, __HIP_MEMORY_SCOPE_AGENT); }
__device__ __forceinline__ unsigned xb_add(unsigned* p, unsigned v) { return __hip_atomic_fetch_add(p, v, __ATOMIC_RELAXED, __HIP_MEMORY_SCOPE_AGENT); }
__device__ __forceinline__ unsigned xb_xcc_id() { return (unsigned)__builtin_amdgcn_s_getreg((3 << 11) | 20) & 0xFu; }
#define XB_SPIN(cond, bar) do { unsigned _sp = 0; while (cond) { __builtin_amdgcn_s_sleep(1); \
    if ((++_sp & 255u) == 0u) { if (xb_ld(&(bar)[XB_TMO])) break; if (_sp > XB_SPIN_CAP) { atomicAdd(&(bar)[XB_TMO], 1u); break; } } } } while (0)

struct XcdBarrier {
    unsigned* bar; unsigned x;
    volatile LAS unsigned* st;
};

__device__ __forceinline__ XcdBarrier xcd_barrier_post(unsigned* bar, volatile LAS unsigned* st) {
    XcdBarrier b; b.bar = bar; b.x = xb_xcc_id(); b.st = st;
    if (threadIdx.x == 0) (void)xb_add(&bar[XB_XCNT(b.x)], 1u);
    return b;
}
__device__ __forceinline__ void xcd_barrier_complete(unsigned* bar, unsigned x, unsigned& nloc, unsigned& nx) {
    const unsigned G = gridDim.x * gridDim.y * gridDim.z;
    unsigned sum, cnt, mine, sp = 0u;
    for (;;) {
        sum = 0u; cnt = 0u; mine = 0u;
#pragma unroll
        for (unsigned j = 0; j < 16; ++j) { const unsigned c = xb_ld(&bar[XB_XCNT(j)]); sum += c; cnt += (c > 0u) ? 1u : 0u; mine = (j == x) ? c : mine; }
        if (sum == G) break;
        __builtin_amdgcn_s_sleep(1);
        if ((++sp & 255u) == 0u) { if (xb_ld(&bar[XB_TMO])) break; if (sp > XB_SPIN_CAP) { atomicAdd(&bar[XB_TMO], 1u); break; } }
    }
    nloc = mine > 0u ? mine : 1u; nx = cnt > 0u ? cnt : 1u;
}

__device__ __forceinline__ void xcd_barrier(const XcdBarrier& b) {
    asm volatile("s_waitcnt vmcnt(0)" ::: "memory");
    __syncthreads();
    if (threadIdx.x == 0) {
        unsigned* bar = b.bar;
        __builtin_amdgcn_s_waitcnt(0);
        unsigned nloc = b.st[0], nx = b.st[1];
        if (nloc == 0u) { xcd_barrier_complete(bar, b.x, nloc, nx); b.st[0] = nloc; b.st[1] = nx; }
        const unsigned old = xb_add(&bar[XB_XSUB(b.x)], 1u);
        const unsigned gen = old / nloc;
        if (old + 1u == (gen + 1u) * nloc) {
            __builtin_amdgcn_fence(__ATOMIC_RELEASE, "agent");
            asm volatile("s_waitcnt vmcnt(0)" ::: "memory");
            const unsigned og = xb_add(&bar[XB_TOP], 1u);
            const unsigned tg = og / nx;
            if (og + 1u == (tg + 1u) * nx) xb_add(&bar[XB_TOPGEN], 1u);
            else XB_SPIN(xb_ld(&bar[XB_TOPGEN]) == tg, bar);
            __builtin_amdgcn_fence(__ATOMIC_ACQUIRE, "agent");
            xb_add(&bar[XB_XGEN(b.x)], 1u);
            asm volatile("s_waitcnt vmcnt(0)" ::: "memory");
        } else {
            XB_SPIN(xb_ld(&bar[XB_XGEN(b.x)]) == gen, bar);
            __builtin_amdgcn_fence(__ATOMIC_ACQUIRE, "agent");
            asm volatile("s_waitcnt vmcnt(0)" ::: "memory");
        }
    }
    __syncthreads();
}


namespace cfg {
constexpr int DMODEL = 2048, SEQ = 8192;
constexpr int LP = 8256;
constexpr int MP = 8448;
constexpr int NCH = 129;
constexpr int NPROJ = 7424;
constexpr int WIN_N = 7184;
constexpr int DFF = 5632;
constexpr size_t MiB = 1u << 20;
constexpr size_t WS_CTL = 0, CTL_ZERO_BYTES = 65536;
constexpr size_t WS_WOUT = 1 * MiB;
constexpr size_t WS_WGU = WS_WOUT + (size_t)2048 * 2048 * 2;
constexpr size_t WS_WDN = WS_WGU + (size_t)11264 * 2048 * 2;
constexpr size_t R1 = WS_WDN + (size_t)2048 * 5632 * 2;
constexpr size_t WS_WIN = R1;
constexpr size_t WS_APAD = WS_WIN + (size_t)NPROJ * 2048 * 2;
constexpr size_t WS_MIX = R1;
constexpr size_t WS_H1B = R1 + (size_t)8192 * 2048 * 2;
constexpr size_t WS_MG = WS_H1B;
constexpr size_t WS_CG = WS_MG + (size_t)8 * 15 * 32768;
constexpr size_t WS_SG = WS_CG + (size_t)8 * 15 * 65536;
constexpr size_t R2 = R1 + (size_t)2 * 8192 * 2048 * 2;
static_assert(WS_SG + (size_t)8 * 16 * 65536 <= R2, "group tables fit the H1B region");
static_assert(WS_APAD + (size_t)MP * 2048 * 2 <= R2, "R1");
constexpr size_t WS_GRAW = R2;
constexpr size_t WS_HID = R2;
constexpr size_t R3 = R2 + (size_t)MP * 4096 * 2;
constexpr size_t WS_Q = R3;
constexpr size_t WS_K = WS_Q + (size_t)16 * 8192 * 64 * 2;
constexpr size_t WS_V = WS_K + (size_t)16 * 129 * 4096 * 2;
constexpr size_t WS_RSTD = WS_V + (size_t)8 * 129 * 8192 * 2;
constexpr size_t WS_BETA = WS_RSTD + (size_t)MP * 4;
constexpr size_t WS_GDEC = WS_BETA + (size_t)8 * LP * 4;
constexpr size_t WS_SSQ = WS_GDEC + (size_t)8 * LP * 4;
constexpr size_t R4 = WS_SSQ + (size_t)8192 * 32 * 4;
static_assert(WS_HID + (size_t)8192 * DFF * 2 <= WS_RSTD, "hidden overlay must stay below the small f32 tables");
constexpr size_t GI_WQ = 0, GI_ATT = 32768, GI_KDT = 40960, GI_UT = 57344, GI_EG = 90112, GI_BYTES = 90368;
constexpr size_t WS_GDNP = R4;
constexpr size_t WS_END = WS_GDNP + (size_t)8 * NCH * GI_BYTES;
static_assert(WS_WGU % 256 == 0 && WS_WDN % 256 == 0 && R1 % 256 == 0 && WS_APAD % 256 == 0 && R2 % 256 == 0 && R3 % 256 == 0 && WS_K % 256 == 0 && WS_V % 256 == 0 && WS_RSTD % 256 == 0 && WS_BETA % 256 == 0 && WS_GDEC % 256 == 0 && WS_SSQ % 256 == 0 && R4 % 256 == 0, "alignment");
#ifndef PROBE_DUP
#define PROBE_DUP -1
#endif
constexpr int CW_BAR = 4096;
constexpr int CW_ATTQ = 1024;
constexpr int CW_GFLAG = 2048;
constexpr int CW_P2C = 2560;
constexpr int CW_CMP = 3072;
constexpr int P0_MASK = 1 | 4, P1_IDLE_MASK = 2 | 4, P5_IDLE_MASK = 8, GU_SPLIT = 10;
constexpr int LDS_BYTES = 163840;
constexpr int MISC_OFF = LDS_BYTES - 256;
}
#define CAS __attribute__((address_space(4)))
using pg8::bf16_t; using pg8::bf16x8; using pg8::u32x4;
typedef float f32x16 __attribute__((ext_vector_type(16)));
typedef short s16x4 __attribute__((ext_vector_type(4)));
typedef unsigned u32x2 __attribute__((ext_vector_type(2)));

struct Params {
    const float *x, *meta, *attn_norm, *w_in, *conv_w, *a_log, *dt_bias, *gdn_norm, *q_norm, *k_norm, *lq1, *lk1, *lq2, *lk2, *diff_norm, *w_out, *ffn_norm, *w_gu, *w_dn;
    float* out; unsigned char* ws;
};

__device__ __forceinline__ float wave_sum(float v) {
#pragma unroll
    for (int o = 1; o < 64; o <<= 1) v += __shfl_xor(v, o);
    return v;
}

__device__ __forceinline__ int win_src(int a, int& nvalid) {
    const int pn = a >> 3, b8 = a & 7; nvalid = 32;
    if (pn < 16) return 256 * pn + 32 * b8;
    if (pn < 24) return 4112 + 256 * (pn - 16) + 64 * (b8 & 3) + 32 * (b8 >> 2);
    if (pn < 28) return 6160 + 256 * (pn - 24) + 32 * b8;
    if (b8 == 0) { nvalid = 16; return 4096; }
    nvalid = 0; return 0;
}
__device__ __forceinline__ void p0_transpose_item(const float* W, int Nsrc, int K, bf16* WT, int k0, int dstrow0, int srccol, int nvalid, const float* gain, LAS float* scr, int lane) {
    const int c = lane & 31;
    float vv[32];
#pragma unroll
    for (int i = 0; i < 32; ++i) { const int kk = 2 * i + (lane >> 5); vv[i] = (c < nvalid) ? __builtin_nontemporal_load(W + (size_t)(k0 + kk) * Nsrc + srccol + c) : 0.f; }
    if (gain) {
#pragma unroll
        for (int i = 0; i < 32; ++i) vv[i] *= gain[k0 + 2 * i + (lane >> 5)]; }
#pragma unroll
    for (int i = 0; i < 32; ++i) scr[(2 * i + (lane >> 5)) * 33 + c] = vv[i];
    LDS_WAIT(); asm volatile("" ::: "memory");
    const int c8 = lane & 7;
#pragma unroll
    for (int j = 0; j < 4; ++j) { const int n = (lane >> 3) + 8 * j; const LAS float* s = scr + (8 * c8) * 33 + n;
        v4u o; o.x = pk2(s[0 * 33], s[1 * 33]); o.y = pk2(s[2 * 33], s[3 * 33]); o.z = pk2(s[4 * 33], s[5 * 33]); o.w = pk2(s[6 * 33], s[7 * 33]);
        *(GAS v4u*)(WT + (size_t)(dstrow0 + n) * K + k0 + 8 * c8) = o; }
    LDS_WAIT(); asm volatile("" ::: "memory");
}
__device__ __forceinline__ void p0_convert(const Params& P, LAS unsigned char* lds, int gw, int NGW, int wave, int lane, int mask, int gu_kb0 = 0, int gu_kb1 = 32) {
    using namespace cfg;
    LAS float* scr = (LAS float*)(lds + wave * 16384);
    bf16* Wt_in = (bf16*)(P.ws + WS_WIN); bf16* Wt_out = (bf16*)(P.ws + WS_WOUT); bf16* Wt_gu = (bf16*)(P.ws + WS_WGU); bf16* Wt_dn = (bf16*)(P.ws + WS_WDN);
    const int I_IN = (mask & 1) ? 32 * 232 : 0, I_OUT = (mask & 2) ? 32 * 64 : 0, I_GU = (mask & 4) ? (gu_kb1 - gu_kb0) * 352 : 0, I_DN = (mask & 8) ? 88 * 64 : 0, NITEMS = I_IN + I_OUT + I_GU + I_DN;
    for (int it = gw; it < NITEMS; it += NGW) {
        int r = it;
        if (r < I_IN) { const int kb = r / 232, a = r % 232; int nv; const int src = win_src(a, nv); p0_transpose_item(P.w_in, WIN_N, 2048, Wt_in, 64 * kb, 32 * a, src, nv, P.attn_norm, scr, lane); continue; } r -= I_IN;
        if (r < I_OUT) { const int kb = r / 64, a = r % 64; p0_transpose_item(P.w_out, 2048, 2048, Wt_out, 64 * kb, 32 * a, 32 * a, 32, nullptr, scr, lane); continue; } r -= I_OUT;
        if (r < I_GU) { const int kb = gu_kb0 + r / 352, a = r % 352, pn = a >> 3, b8 = a & 7; const int src = (b8 < 4) ? 128 * pn + 32 * b8 : DFF + 128 * pn + 32 * (b8 - 4);
            p0_transpose_item(P.w_gu, 2 * DFF, 2048, Wt_gu, 64 * kb, 32 * a, src, 32, P.ffn_norm, scr, lane); continue; } r -= I_GU;
        { const int kb = r / 64, a = r % 64; p0_transpose_item(P.w_dn, 2048, DFF, Wt_dn, 64 * kb, 32 * a, 32 * a, 32, nullptr, scr, lane); }
    }
}
__device__ __forceinline__ void p0_prep(const Params& P, LAS unsigned char* lds, int vcu, int G, int wave, int lane) {
    using namespace cfg;
    const int gw = vcu * 8 + wave, NGW = G * 8;
    p0_convert(P, lds, gw, NGW, wave, lane, P0_MASK, 0, GU_SPLIT);
    bf16* Apad = (bf16*)(P.ws + WS_APAD); float* rstd = (float*)(P.ws + WS_RSTD);
    for (int r = gw; r < MP; r += NGW) {
        GAS unsigned long long* o8 = (GAS unsigned long long*)(Apad + (size_t)r * 2048) + lane;
        const float* src = (r >= 64 && r < LP) ? P.x + (size_t)(r - 64) * 2048 : ((r >= 48 && r < 64) ? P.meta + (size_t)(r - 48) * 2048 : nullptr);
        if (!src) {
#pragma unroll
            for (int j = 0; j < 8; ++j) o8[64 * j] = 0ull;
            if (lane == 0) rstd[r] = 0.f;
        } else {
            const GAS f32x4* xr = (const GAS f32x4*)src + lane; f32x4 v[8]; float s = 0.f;
#pragma unroll
            for (int j = 0; j < 8; ++j) { v[j] = __builtin_nontemporal_load(xr + 64 * j); s += (v[j].x * v[j].x + v[j].y * v[j].y) + (v[j].z * v[j].z + v[j].w * v[j].w); }
            const float rs = 1.0f / sqrtf(wave_sum(s) * (1.0f / 2048.0f) + 1e-6f);
#pragma unroll
            for (int j = 0; j < 8; ++j) o8[64 * j] = (unsigned long long)pk2(v[j].x, v[j].y) | ((unsigned long long)pk2(v[j].z, v[j].w) << 32);
            if (lane == 0) rstd[r] = rs;
        }
    }
}

__device__ __forceinline__ int kperm32(int a) { return 8 * ((a >> 2) & 3) + 4 * (a >> 4) + (a & 3); }
__device__ __forceinline__ int kperm(int a) { return (a & ~31) + kperm32(a & 31); }
__device__ __forceinline__ unsigned short f2bf_s(float f) { return (unsigned short)pk2(f, 0.f); }
__device__ __forceinline__ f32x4 mfma16(bf16x8 a, bf16x8 b, f32x4 c) { return __builtin_amdgcn_mfma_f32_16x16x32_bf16(a, b, c, 0, 0, 0); }

#define GDN_LOAD_RAW(raw_, h_, n_, tid_) do { const int c0_ = 8 * ((tid_) & 15); \
        _Pragma("unroll") for (int X_ = 0; X_ < 3; ++X_) _Pragma("unroll") for (int ps_ = 0; ps_ < 2; ++ps_) _Pragma("unroll") for (int j_ = 0; j_ < 4; ++j_) { const int Rj_ = 64 * (n_) + 32 * ps_ + ((tid_) >> 4) - 3 + j_; \
            raw_[X_][ps_][j_] = (Rj_ >= 0) ? __builtin_nontemporal_load((const u32x4*)((const bf16_t*)(P.ws + cfg::WS_GRAW) + (size_t)Rj_ * 4096 + X_ * 1024 + (h_) * 128 + c0_)) : (u32x4){0u, 0u, 0u, 0u}; } } while (0)
#define GDN_LOAD_GB(gb_, h_, n_, tid_) do { const size_t o_ = (size_t)(h_) * cfg::LP + 64 * (n_) + ((tid_) & 63); gb_[0] = ((const float*)(P.ws + cfg::WS_GDEC))[o_]; gb_[1] = ((const float*)(P.ws + cfg::WS_BETA))[o_]; } while (0)
__device__ __forceinline__ void gdn_prep_item(const Params& P, int h, int n, u32x4 (&raw)[3][2][4], float (&gb)[2], int hn, int nn, bool has_next, LAS unsigned char* lds, int tid, int wave, int lane) {
    using namespace cfg;
    asm volatile("" : "+v"(tid)); lane = tid & 63;
    LAS bf16_t* qs = (LAS bf16_t*)(lds + 0);
    LAS bf16_t* ks = (LAS bf16_t*)(lds + 17408);
    LAS bf16_t* kb = (LAS bf16_t*)(lds + 34816);
    LAS bf16_t* kbgT = (LAS bf16_t*)(lds + 52224);
    LAS bf16_t* vbT = (LAS bf16_t*)(lds + 70656);
    LAS bf16_t* kdtI = (LAS bf16_t*)(lds + 89088);
    LAS bf16_t* qgI = (LAS bf16_t*)(lds + 105472);
    LAS float* Lm = (LAS float*)(lds + 121856);
    LAS bf16_t* attI = (LAS bf16_t*)(lds + 139264);
    LAS float* gcs = (LAS float*)(lds + 147456);
    LAS bf16_t* Tb = (LAS bf16_t*)(lds + 0);
    LAS float* UTI = (LAS float*)(lds + 17408);
    LAS bf16_t* WI = (LAS bf16_t*)(lds + 89088);
    const bf16_t* graw = (const bf16_t*)(P.ws + WS_GRAW);
    unsigned char* item = P.ws + WS_GDNP + (size_t)(h * NCH + n) * GI_BYTES;

    if (tid < 64) { float g = gb[0]; const float b = gb[1];
#pragma unroll
        for (int o = 1; o < 64; o <<= 1) { const float t = __shfl_up(g, o); if (lane >= o) g += t; }
        gcs[tid] = g; gcs[64 + tid] = b; }
    __syncthreads();
    const float gl = gcs[63];
    {
        const int cg = tid & 15, c0 = 8 * cg;
#pragma unroll
        for (int X = 0; X < 3; ++X) {
            const float* cw = P.conv_w + X * 1024 + h * 128 + c0; f32x4 w[4][2];
#pragma unroll
            for (int j = 0; j < 4; ++j) { w[j][0] = *(const f32x4*)(cw + (size_t)j * 3072); w[j][1] = *(const f32x4*)(cw + (size_t)j * 3072 + 4); }
#pragma unroll
            for (int pass = 0; pass < 2; ++pass) {
                const int rl = 32 * pass + (tid >> 4);
                float y[8];
#pragma unroll
                for (int i = 0; i < 8; ++i) y[i] = 0.f;
#pragma unroll
                for (int j = 0; j < 4; ++j) {
#pragma unroll
                    for (int i = 0; i < 4; ++i) { const unsigned wd = raw[X][pass][j][i]; y[2 * i] += __uint_as_float(wd << 16) * w[j][i >> 1][(2 * i) & 3]; y[2 * i + 1] += __uint_as_float(wd & 0xffff0000u) * w[j][i >> 1][(2 * i + 1) & 3]; } }
                float ss = 0.f;
#pragma unroll
                for (int i = 0; i < 8; ++i) { y[i] = pg8::silu_f(y[i]); ss += y[i] * y[i]; }
                const float gc = gcs[rl], bt = gcs[64 + rl];
                if (X < 2) { ss += __shfl_xor(ss, 1); ss += __shfl_xor(ss, 2); ss += __shfl_xor(ss, 4); ss += __shfl_xor(ss, 8);
                    const float rn = __builtin_amdgcn_rsqf(ss + 1e-6f) * (X == 0 ? 0.08838834764831845f : 1.0f);
#pragma unroll
                    for (int i = 0; i < 8; ++i) y[i] *= rn; }
                if (X == 0) {
                    u32x4 pk; pk.x = pk2(y[0], y[1]); pk.y = pk2(y[2], y[3]); pk.z = pk2(y[4], y[5]); pk.w = pk2(y[6], y[7]);
                    *(LAS u32x4*)(qs + rl * 136 + c0) = pk;
                    const float e = __expf(gc);
                    u32x2 a, b; a.x = pk2(y[0] * e, y[1] * e); a.y = pk2(y[2] * e, y[3] * e); b.x = pk2(y[4] * e, y[5] * e); b.y = pk2(y[6] * e, y[7] * e);
                    *(LAS u32x2*)(qgI + rl * 128 + kperm(c0)) = a; *(LAS u32x2*)(qgI + rl * 128 + kperm(c0 + 4)) = b;
                } else if (X == 1) {
                    u32x4 pk; pk.x = pk2(y[0], y[1]); pk.y = pk2(y[2], y[3]); pk.z = pk2(y[4], y[5]); pk.w = pk2(y[6], y[7]);
                    *(LAS u32x4*)(ks + rl * 136 + c0) = pk;
                    u32x4 pb; pb.x = pk2(y[0] * bt, y[1] * bt); pb.y = pk2(y[2] * bt, y[3] * bt); pb.z = pk2(y[4] * bt, y[5] * bt); pb.w = pk2(y[6] * bt, y[7] * bt);
                    *(LAS u32x4*)(kb + rl * 136 + c0) = pb;
                    const float eg = bt * __expf(gc), ed = __expf(gl - gc); const int prl = kperm(rl);
                    const int swz_rl = (((rl >> 3) ^ (cg & 7)) << 3) | (rl & 7), swz_prl = (((prl >> 3) ^ (cg & 7)) << 3) | (prl & 7);
#pragma unroll
                    for (int i = 0; i < 8; ++i) { kbgT[(c0 + i) * 72 + swz_rl] = f2bf_s(y[i] * eg); kdtI[(c0 + i) * 64 + swz_prl] = f2bf_s(y[i] * ed); }
                } else {
                    const int swz_rl = (((rl >> 3) ^ (cg & 7)) << 3) | (rl & 7);
#pragma unroll
                    for (int i = 0; i < 8; ++i) vbT[(c0 + i) * 72 + swz_rl] = f2bf_s(y[i] * bt);
                }
            }
        }
    }
    __syncthreads();
    {
        const int mt = wave & 3, fr = lane & 15, g = lane >> 4;
        bf16x8 ak[4], aq[4];
#pragma unroll
        for (int s = 0; s < 4; ++s) { ak[s] = *(const LAS bf16x8*)(kb + (16 * mt + fr) * 136 + 32 * s + 8 * g); aq[s] = *(const LAS bf16x8*)(qs + (16 * mt + fr) * 136 + 32 * s + 8 * g); }
#pragma unroll
        for (int t2 = 0; t2 < 2; ++t2) { const int nt = 2 * (wave >> 2) + t2;
            f32x4 ckk = {0.f, 0.f, 0.f, 0.f}, cqk = {0.f, 0.f, 0.f, 0.f};
#pragma unroll
            for (int s = 0; s < 4; ++s) { const bf16x8 b = *(const LAS bf16x8*)(ks + (16 * nt + fr) * 136 + 32 * s + 8 * g); ckk = mfma16(ak[s], b, ckk); cqk = mfma16(aq[s], b, cqk); }
            const int sc = 16 * nt + fr; const float gs = gcs[sc]; const int psc = kperm(sc);
#pragma unroll
            for (int r = 0; r < 4; ++r) { const int c = 16 * mt + 4 * g + r; const float dec = (c >= sc) ? __expf(gcs[c] - gs) : 0.f;
                Lm[c * 68 + sc] = (c > sc) ? ckk[r] * dec : 0.f;
                attI[c * 64 + psc] = f2bf_s((c >= sc) ? cqk[r] * dec : 0.f); }
        }
    }
    __syncthreads();
    LAS bf16_t* ATb = (LAS bf16_t*)(lds + 9216);
    if (wave < 2) {
        float t[32];
        const LAS float* Lb = Lm + wave * (32 * 68 + 32); asm volatile("" : "+v"(Lb));
        LAS bf16_t* Tq = Tb + wave * (32 * 72 + 32);
        const bool wr_ok = (wave == 0) || (lane < 32);
        f32x4 la[8], lb[8];
#define INV_LOAD(dst, i_) do { _Pragma("unroll") for (int j4_ = 0; j4_ < ((i_) + 3) / 4; ++j4_) dst[j4_] = *(const LAS f32x4*)(Lb + (i_) * 68 + 4 * j4_); } while (0)
#define INV_ROW(src, i_) do { float a4_[4] = {(lane == (i_)) ? 1.0f : 0.0f, 0.f, 0.f, 0.f}; \
            _Pragma("unroll") for (int j4_ = 0; j4_ < ((i_) + 3) / 4; ++j4_) _Pragma("unroll") for (int jj_ = 0; jj_ < 4; ++jj_) { if (4 * j4_ + jj_ < (i_)) a4_[jj_] -= src[j4_][jj_] * t[4 * j4_ + jj_]; } \
            const float a_ = (a4_[0] + a4_[1]) + (a4_[2] + a4_[3]); t[(i_)] = a_; if (wr_ok) Tq[(i_) * 72 + lane] = f2bf_s(a_); } while (0)
        t[0] = (lane == 0) ? 1.0f : 0.0f; if (wr_ok) Tq[lane] = f2bf_s(t[0]);
        INV_LOAD(lb, 1);
#pragma unroll
        for (int i = 1; i < 32; i += 2) {
            if (i + 1 < 32) INV_LOAD(la, i + 1);
            __builtin_amdgcn_sched_barrier(0);
            INV_ROW(lb, i);
            __builtin_amdgcn_sched_barrier(0);
            if (i + 1 < 32) {
                if (i + 2 < 32) INV_LOAD(lb, i + 2);
                __builtin_amdgcn_sched_barrier(0);
                INV_ROW(la, i + 1);
                __builtin_amdgcn_sched_barrier(0);
            }
        }
#undef INV_LOAD
#undef INV_ROW
        if (wave == 0 && lane < 32) {
#pragma unroll
            for (int q = 0; q < 4; ++q) { u32x4 w; w.x = pk2(t[8 * q], t[8 * q + 1]); w.y = pk2(t[8 * q + 2], t[8 * q + 3]); w.z = pk2(t[8 * q + 4], t[8 * q + 5]); w.w = pk2(t[8 * q + 6], t[8 * q + 7]);
                *(LAS u32x4*)(ATb + lane * 40 + 8 * q) = w; } }
    } else {
        const int t7 = tid - 128;
        for (int ch = t7; ch < 2560; ch += 384) {
            if (ch < 1024) *(GAS v4u*)(item + GI_KDT + ch * 16) = *(const LAS v4u*)((const LAS unsigned char*)kdtI + (ch >> 3) * 128 + (((ch & 7) ^ ((ch >> 6) & 7)) << 4));
            else if (ch < 2048) *(GAS v4u*)(item + GI_WQ + 16384 + (ch - 1024) * 16) = *(const LAS v4u*)((const LAS unsigned char*)qgI + (ch - 1024) * 16);
            else *(GAS v4u*)(item + GI_ATT + (ch - 2048) * 16) = *(const LAS v4u*)((const LAS unsigned char*)attI + (ch - 2048) * 16);
        }
    }
    if (has_next) GDN_LOAD_GB(gb, hn, nn, tid);
    if (has_next) GDN_LOAD_RAW(raw, hn, nn, tid);
    else {
#pragma unroll
        for (int X_ = 0; X_ < 3; ++X_)
#pragma unroll
            for (int ps_ = 0; ps_ < 2; ++ps_)
#pragma unroll
                for (int j_ = 0; j_ < 4; ++j_) raw[X_][ps_][j_] = (u32x4){0u, 0u, 0u, 0u}; }
    asm volatile("s_waitcnt lgkmcnt(0)" ::: "memory"); __builtin_amdgcn_s_barrier(); asm volatile("" ::: "memory");
    if (wave < 2) {
        const int fr = lane & 15, g = lane >> 4;
        const bf16x8 bfrag = *(const LAS bf16x8*)(ATb + (16 * wave + fr) * 40 + 8 * g);
        f32x4 Y[2];
#pragma unroll
        for (int mt = 0; mt < 2; ++mt) { const LAS float* cp = Lm + (32 + 16 * mt + fr) * 68 + 8 * g; const f32x4 c0 = *(const LAS f32x4*)cp, c1 = *(const LAS f32x4*)(cp + 4);
            u32x4 w; w.x = pk2(c0[0], c0[1]); w.y = pk2(c0[2], c0[3]); w.z = pk2(c1[0], c1[1]); w.w = pk2(c1[2], c1[3]);
            Y[mt] = mfma16(__builtin_bit_cast(bf16x8, w), bfrag, (f32x4){0.f, 0.f, 0.f, 0.f}); }
        u32x4 yb; yb.x = pk2(Y[0][0], Y[0][1]); yb.y = pk2(Y[0][2], Y[0][3]); yb.z = pk2(Y[1][0], Y[1][1]); yb.w = pk2(Y[1][2], Y[1][3]);
#pragma unroll
        for (int mt = 0; mt < 2; ++mt) { const LAS bf16_t* dp = Tb + (32 + 16 * mt + fr) * 72 + 32 + 4 * g; const u32x2 lo = *(const LAS u32x2*)dp, hi = *(const LAS u32x2*)(dp + 16);
            u32x4 a; a.x = lo.x; a.y = lo.y; a.z = hi.x; a.w = hi.y;
            const f32x4 X = mfma16(__builtin_bit_cast(bf16x8, a), __builtin_bit_cast(bf16x8, yb), (f32x4){0.f, 0.f, 0.f, 0.f});
#pragma unroll
            for (int r = 0; r < 4; ++r) Tb[(32 + 16 * mt + 4 * g + r) * 72 + 16 * wave + fr] = f2bf_s(-X[r]); }
    }
    asm volatile("s_waitcnt lgkmcnt(0)" ::: "memory"); __builtin_amdgcn_s_barrier(); asm volatile("" ::: "memory");
    {
        const int fr = lane & 15, g = lane >> 4, col = 16 * wave + fr, pcol = kperm(col);
        bf16x8 bu[2], bw[2];
#pragma unroll
        for (int s = 0; s < 2; ++s) { const int sl = ((4 * s + g) ^ ((col >> 3) & 7)) * 8; bu[s] = *(const LAS bf16x8*)(vbT + col * 72 + sl); bw[s] = *(const LAS bf16x8*)(kbgT + col * 72 + sl); }
#pragma unroll
        for (int mt = 0; mt < 4; ++mt) { f32x4 cu = {0.f, 0.f, 0.f, 0.f}, cw = {0.f, 0.f, 0.f, 0.f};
#pragma unroll
            for (int s = 0; s < 2; ++s) { const bf16x8 a = *(const LAS bf16x8*)(Tb + (16 * mt + fr) * 72 + 32 * s + 8 * g); cu = mfma16(a, bu[s], cu); cw = mfma16(a, bw[s], cw); }
            *(LAS f32x4*)(UTI + col * 64 + 16 * mt + 4 * g) = cu;
#pragma unroll
            for (int r = 0; r < 4; ++r) WI[(16 * mt + 4 * g + r) * 128 + pcol] = f2bf_s(cw[r]); }
    }
    asm volatile("s_waitcnt lgkmcnt(0)" ::: "memory"); __builtin_amdgcn_s_barrier(); asm volatile("" ::: "memory");
    for (int ch = tid; ch < 3072; ch += 512) {
        if (ch < 2048) *(GAS v4u*)(item + GI_UT + ch * 16) = *(const LAS v4u*)((const LAS unsigned char*)UTI + ch * 16);
        else *(GAS v4u*)(item + GI_WQ + (ch - 2048) * 16) = *(const LAS v4u*)((const LAS unsigned char*)WI + (ch - 2048) * 16);
    }
    if (tid == 0) *(float*)(item + GI_EG) = __expf(gl);
    asm volatile("s_waitcnt lgkmcnt(0)" ::: "memory"); __builtin_amdgcn_s_barrier(); asm volatile("" ::: "memory");
}

__device__ __forceinline__ bf16x8 pack_b(const f32x4 lo, const f32x4 hi) {
    u32x4 w; w.x = pg8::cvt_pk_bf16(lo[0], lo[1]); w.y = pg8::cvt_pk_bf16(lo[2], lo[3]); w.z = pg8::cvt_pk_bf16(hi[0], hi[1]); w.w = pg8::cvt_pk_bf16(hi[2], hi[3]);
    return __builtin_bit_cast(bf16x8, w);
}
__device__ __forceinline__ void gdn_scan(const Params& P, int h, int n0, int n1, const float* Sinit, f32x4* Sout, LAS unsigned char* lds, int tid, int wave, int lane) {
    using namespace cfg;
    asm volatile("v_mbcnt_lo_u32_b32 %0, -1, 0\n\tv_mbcnt_hi_u32_b32 %0, -1, %0" : "=v"(lane)); tid = wave * 64 + lane;
    constexpr int WQ_LD = 272, AT_LD = 144, KD_LD = 144;
    constexpr int OFF_WQ = 0, OFF_AT = 128 * WQ_LD, OFF_KD = OFF_AT + 64 * AT_LD, OFF_O = OFF_KD + 128 * KD_LD;
    LAS unsigned char* Abuf = lds;
    LAS float* Oex = (LAS float*)(lds + OFF_O);
    const unsigned char* items = P.ws + WS_GDNP + (size_t)h * NCH * GI_BYTES;
    const bf16_t* graw = (const bf16_t*)(P.ws + WS_GRAW);
    bf16_t* mix = (bf16_t*)(P.ws + WS_MIX);
    const int fr = lane & 15, g = lane >> 4, dv = 16 * wave + fr;
    v4u st[7];
#define SCAN_LOAD(nn) do { const unsigned char* it_ = items + (size_t)(nn) * GI_BYTES; \
        _Pragma("unroll") for (int i_ = 0; i_ < 4; ++i_) st[i_] = __builtin_nontemporal_load((const GAS v4u*)(it_ + GI_WQ + (size_t)(tid + 512 * i_) * 16)); \
        st[4] = __builtin_nontemporal_load((const GAS v4u*)(it_ + GI_ATT + (size_t)tid * 16)); \
        _Pragma("unroll") for (int i_ = 0; i_ < 2; ++i_) st[5 + i_] = __builtin_nontemporal_load((const GAS v4u*)(it_ + GI_KDT + (size_t)(tid + 512 * i_) * 16)); } while (0)
#define SCAN_STORE() do { \
        _Pragma("unroll") for (int i_ = 0; i_ < 4; ++i_) { const int ch_ = tid + 512 * i_; *(LAS v4u*)(Abuf + OFF_WQ + (ch_ >> 4) * WQ_LD + (ch_ & 15) * 16) = st[i_]; } \
        *(LAS v4u*)(Abuf + OFF_AT + (tid >> 3) * AT_LD + (tid & 7) * 16) = st[4]; \
        _Pragma("unroll") for (int i_ = 0; i_ < 2; ++i_) { const int ch_ = tid + 512 * i_; *(LAS v4u*)(Abuf + OFF_KD + (ch_ >> 3) * KD_LD + (ch_ & 7) * 16) = st[5 + i_]; } } while (0)
    f32x4 S[8];
#pragma unroll
    for (int i = 0; i < 8; ++i) S[i] = Sinit ? *(const GAS f32x4*)(Sinit + (size_t)dv * 128 + 16 * i + 4 * g) : (f32x4){0.f, 0.f, 0.f, 0.f};
    SCAN_LOAD(n0); SCAN_STORE();
    const int frow = tid >> 3, fseg = tid & 7;
    LAS float* gnl = (LAS float*)(lds + OFF_O + 64 * 132 * 4);
    if (tid < 128) gnl[tid] = P.gdn_norm[tid];
    __syncthreads();
#pragma unroll 1
    for (int n = n0; n < n1; ++n) {
        const unsigned char* it = items + (size_t)n * GI_BYTES;
        if (n + 1 < n1) SCAN_LOAD(n + 1);
        f32x4 ut[4];
#pragma unroll
        for (int mt = 0; mt < 4; ++mt) ut[mt] = __builtin_nontemporal_load((const GAS f32x4*)(it + GI_UT + ((size_t)dv * 64 + 16 * mt + 4 * g) * 4));
        const float eg = *(const float*)(it + GI_EG);
        u32x4 zr[2];
        if (n > 0) { const bf16_t* zp = graw + (size_t)(64 * n + frow) * 4096 + 3072 + h * 128 + 16 * fseg; zr[0] = *(const u32x4*)zp; zr[1] = *(const u32x4*)(zp + 8); }
#define SB_() __builtin_amdgcn_sched_barrier(0)
#define LD_WQ(dst, mt0) do { _Pragma("unroll") for (int m_ = 0; m_ < 2; ++m_) _Pragma("unroll") for (int s_ = 0; s_ < 4; ++s_) \
            dst[4 * m_ + s_] = *(const LAS bf16x8*)(Abuf + OFF_WQ + (16 * ((mt0) + m_) + fr) * WQ_LD + 64 * s_ + 16 * g); } while (0)
#define LD_AT(dst) do { _Pragma("unroll") for (int m_ = 0; m_ < 4; ++m_) _Pragma("unroll") for (int s_ = 0; s_ < 2; ++s_) \
            dst[2 * m_ + s_] = *(const LAS bf16x8*)(Abuf + OFF_AT + (16 * m_ + fr) * AT_LD + 64 * s_ + 16 * g); } while (0)
#define LD_KD(dst, mt0) do { _Pragma("unroll") for (int m_ = 0; m_ < 4; ++m_) _Pragma("unroll") for (int s_ = 0; s_ < 2; ++s_) \
            dst[2 * m_ + s_] = *(const LAS bf16x8*)(Abuf + OFF_KD + (16 * ((mt0) + m_) + fr) * KD_LD + 64 * s_ + 16 * g); } while (0)
#define MM_WQ(src, mt0) do { _Pragma("unroll") for (int m_ = 0; m_ < 2; ++m_) _Pragma("unroll") for (int s_ = 0; s_ < 4; ++s_) X[(mt0) + m_] = mfma16(src[4 * m_ + s_], bs[s_], X[(mt0) + m_]); } while (0)
        bf16x8 bs[4];
#pragma unroll
        for (int s = 0; s < 4; ++s) bs[s] = pack_b(S[2 * s], S[2 * s + 1]);
        f32x4 X[8];
#pragma unroll
        for (int mt = 0; mt < 8; ++mt) X[mt] = (f32x4){0.f, 0.f, 0.f, 0.f};
        bf16x8 fa[8], fb[8];
        LD_WQ(fa, 0); SB_();
        LD_WQ(fb, 2); SB_(); MM_WQ(fa, 0); SB_();
        LD_WQ(fa, 4); SB_(); MM_WQ(fb, 2); SB_();
        LD_WQ(fb, 6); SB_(); MM_WQ(fa, 4); SB_();
        LD_AT(fa); SB_(); MM_WQ(fb, 6); SB_();
        f32x4 vn[4];
#pragma unroll
        for (int mt = 0; mt < 4; ++mt) vn[mt] = ut[mt] - X[mt];
        bf16x8 bv[2];
#pragma unroll
        for (int s = 0; s < 2; ++s) bv[s] = pack_b(vn[2 * s], vn[2 * s + 1]);
        SB_();
        LD_KD(fb, 0); SB_();
#pragma unroll
        for (int mt = 0; mt < 4; ++mt)
#pragma unroll
            for (int s = 0; s < 2; ++s) X[4 + mt] = mfma16(fa[2 * mt + s], bv[s], X[4 + mt]);
        SB_();
        LD_KD(fa, 4); SB_();
#pragma unroll
        for (int mt = 0; mt < 4; ++mt) { S[mt] = S[mt] * eg;
#pragma unroll
            for (int s = 0; s < 2; ++s) S[mt] = mfma16(fb[2 * mt + s], bv[s], S[mt]); }
        SB_();
#pragma unroll
        for (int mt = 0; mt < 4; ++mt)
#pragma unroll
            for (int r = 0; r < 4; ++r) Oex[(16 * mt + 4 * g + r) * 132 + dv] = X[4 + mt][r];
#pragma unroll
        for (int mt = 4; mt < 8; ++mt) { S[mt] = S[mt] * eg;
#pragma unroll
            for (int s = 0; s < 2; ++s) S[mt] = mfma16(fa[2 * (mt - 4) + s], bv[s], S[mt]); }
#undef SB_
#undef LD_WQ
#undef LD_AT
#undef LD_KD
#undef MM_WQ
        asm volatile("s_waitcnt lgkmcnt(0)" ::: "memory"); __builtin_amdgcn_s_barrier(); asm volatile("" ::: "memory");
        if (n + 1 < n1) SCAN_STORE();
        if (n > 0) {
            f32x4 o4[4]; float ss = 0.f;
#pragma unroll
            for (int i = 0; i < 4; ++i) { o4[i] = *(const LAS f32x4*)(Oex + frow * 132 + 16 * fseg + 4 * i); ss += (o4[i][0] * o4[i][0] + o4[i][1] * o4[i][1]) + (o4[i][2] * o4[i][2] + o4[i][3] * o4[i][3]); }
            ss += __shfl_xor(ss, 1); ss += __shfl_xor(ss, 2); ss += __shfl_xor(ss, 4);
            const float rn = __builtin_amdgcn_rsqf(ss * (1.0f / 128.0f) + 1e-6f);
            float ov[16];
#pragma unroll
            for (int i = 0; i < 16; ++i) { const unsigned wd = zr[i >> 3][(i >> 1) & 3]; const float z = (i & 1) ? __uint_as_float(wd & 0xffff0000u) : __uint_as_float(wd << 16);
                ov[i] = o4[i >> 2][i & 3] * rn * gnl[16 * fseg + i] * pg8::silu_f(z); }
            u32x4 w0, w1; w0.x = pk2(ov[0], ov[1]); w0.y = pk2(ov[2], ov[3]); w0.z = pk2(ov[4], ov[5]); w0.w = pk2(ov[6], ov[7]); w1.x = pk2(ov[8], ov[9]); w1.y = pk2(ov[10], ov[11]); w1.z = pk2(ov[12], ov[13]); w1.w = pk2(ov[14], ov[15]);
            bf16_t* mp = mix + (size_t)(64 * (n - 1) + frow) * 2048 + h * 128 + 16 * fseg;
            *(u32x4*)mp = w0; *(u32x4*)(mp + 8) = w1;
        }
        asm volatile("s_waitcnt lgkmcnt(0)" ::: "memory"); __builtin_amdgcn_s_barrier(); asm volatile("" ::: "memory");
    }
#undef SCAN_LOAD
#undef SCAN_STORE
    if (Sout) {
#pragma unroll
        for (int i = 0; i < 8; ++i) Sout[i] = S[i]; }
}


__device__ __forceinline__ int grp_start(int g) { return 8 * g + 1; }
__device__ __forceinline__ void dep_wait(unsigned* flag, unsigned want, int wave) {
    int l_; asm volatile("v_mbcnt_lo_u32_b32 %0, -1, 0\n\tv_mbcnt_hi_u32_b32 %0, -1, %0" : "=v"(l_));
    if (wave == 0 && l_ == 0) { unsigned sp = 0; while (__hip_atomic_load(flag, __ATOMIC_RELAXED, __HIP_MEMORY_SCOPE_AGENT) < want) { __builtin_amdgcn_s_sleep(8); if (++sp > (1u << 22)) break; }
        __builtin_amdgcn_fence(__ATOMIC_ACQUIRE, "agent"); asm volatile("s_waitcnt vmcnt(0)" ::: "memory"); }
    __syncthreads();
}
#define DEP_PUBLISH_BEGIN() asm volatile("s_waitcnt vmcnt(0)" ::: "memory"); __syncthreads(); if (threadIdx.x == 0) { __builtin_amdgcn_fence(__ATOMIC_RELEASE, "agent"); asm volatile("s_waitcnt vmcnt(0)" ::: "memory");
#define DEP_PUBLISH_END() }
__device__ __forceinline__ void gdn_compose(const Params& P, int h, int gi, int part, LAS unsigned char* lds, unsigned* ctl, int tid, int wave, int lane) {
    using namespace cfg;
    dep_wait(ctl + CW_P2C + 4 * (16 * h + gi), 8u, wave);
    constexpr int WQ_LD = 272, KD_LD = 144, OFF_WQ = 0, OFF_KD = 128 * WQ_LD + 64 * 144;
    LAS unsigned char* Abuf = lds;
    const unsigned char* items = P.ws + WS_GDNP + (size_t)h * NCH * GI_BYTES;
    const int fr = lane & 15, g = lane >> 4, col = 16 * wave + fr;
    const int n0 = grp_start(gi), n1 = 8 * gi + 9;
    v4u stx[4], sty[4];
#define CMP_LOAD(st, nn) do { const unsigned char* it_ = items + (size_t)(nn) * GI_BYTES; \
        _Pragma("unroll") for (int i_ = 0; i_ < 2; ++i_) st[i_] = *(const GAS v4u*)(it_ + GI_WQ + (size_t)(tid + 512 * i_) * 16); \
        _Pragma("unroll") for (int i_ = 0; i_ < 2; ++i_) st[2 + i_] = *(const GAS v4u*)(it_ + GI_KDT + (size_t)(tid + 512 * i_) * 16); } while (0)
#define CMP_STORE(st) do { \
        _Pragma("unroll") for (int i_ = 0; i_ < 2; ++i_) { const int ch_ = tid + 512 * i_; *(LAS v4u*)(Abuf + OFF_WQ + (ch_ >> 4) * WQ_LD + (ch_ & 15) * 16) = st[i_]; } \
        _Pragma("unroll") for (int i_ = 0; i_ < 2; ++i_) { const int ch_ = tid + 512 * i_; *(LAS v4u*)(Abuf + OFF_KD + (ch_ >> 3) * KD_LD + (ch_ & 7) * 16) = st[2 + i_]; } } while (0)
    f32x4 X[8];
#pragma unroll
    for (int mt = 0; mt < 8; ++mt)
#pragma unroll
        for (int r = 0; r < 4; ++r) X[mt][r] = (part == 0 && 16 * mt + 4 * g + r == col) ? 1.0f : 0.0f;
    CMP_LOAD(stx, n0); CMP_STORE(stx);
    if (n0 + 1 < n1) CMP_LOAD(stx, n0 + 1);
    if (n0 + 2 < n1) CMP_LOAD(sty, n0 + 2);
    __syncthreads();
#pragma unroll 1
    for (int nb = n0; nb < n1; nb += 2) {
        { const int n = nb;
#define STCUR stx
        const unsigned char* it = items + (size_t)n * GI_BYTES;
        f32x4 ut[4];
#pragma unroll
        for (int mt = 0; mt < 4; ++mt) ut[mt] = part ? *(const GAS f32x4*)(it + GI_UT + ((size_t)col * 64 + 16 * mt + 4 * g) * 4) : (f32x4){0.f, 0.f, 0.f, 0.f};
        const float eg = *(const float*)(it + GI_EG);
        bf16x8 bs[4];
#pragma unroll
        for (int s = 0; s < 4; ++s) bs[s] = pack_b(X[2 * s], X[2 * s + 1]);
        bf16x8 fa[8], fb[8];
        f32x4 Y[4];
#pragma unroll
        for (int mt = 0; mt < 4; ++mt) Y[mt] = (f32x4){0.f, 0.f, 0.f, 0.f};
#define SB_() __builtin_amdgcn_sched_barrier(0)
#define LD_W(dst, mt0) do { _Pragma("unroll") for (int m_ = 0; m_ < 2; ++m_) _Pragma("unroll") for (int s_ = 0; s_ < 4; ++s_) \
            dst[4 * m_ + s_] = *(const LAS bf16x8*)(Abuf + OFF_WQ + (16 * ((mt0) + m_) + fr) * WQ_LD + 64 * s_ + 16 * g); } while (0)
#define LD_KD(dst, mt0) do { _Pragma("unroll") for (int m_ = 0; m_ < 4; ++m_) _Pragma("unroll") for (int s_ = 0; s_ < 2; ++s_) \
            dst[2 * m_ + s_] = *(const LAS bf16x8*)(Abuf + OFF_KD + (16 * ((mt0) + m_) + fr) * KD_LD + 64 * s_ + 16 * g); } while (0)
#define MM_W(src, mt0) do { _Pragma("unroll") for (int m_ = 0; m_ < 2; ++m_) _Pragma("unroll") for (int s_ = 0; s_ < 4; ++s_) Y[(mt0) + m_] = mfma16(src[4 * m_ + s_], bs[s_], Y[(mt0) + m_]); } while (0)
        LD_W(fa, 0); SB_();
        LD_W(fb, 2); SB_(); MM_W(fa, 0); SB_();
        LD_KD(fa, 0); SB_(); MM_W(fb, 2); SB_();
        f32x4 vn[4];
#pragma unroll
        for (int mt = 0; mt < 4; ++mt) vn[mt] = ut[mt] - Y[mt];
        bf16x8 bv[2];
#pragma unroll
        for (int s = 0; s < 2; ++s) bv[s] = pack_b(vn[2 * s], vn[2 * s + 1]);
        SB_();
        LD_KD(fb, 4); SB_();
#pragma unroll
        for (int mt = 0; mt < 4; ++mt) { X[mt] = X[mt] * eg;
#pragma unroll
            for (int s = 0; s < 2; ++s) X[mt] = mfma16(fa[2 * mt + s], bv[s], X[mt]); }
        SB_();
#pragma unroll
        for (int mt = 4; mt < 8; ++mt) { X[mt] = X[mt] * eg;
#pragma unroll
            for (int s = 0; s < 2; ++s) X[mt] = mfma16(fb[2 * (mt - 4) + s], bv[s], X[mt]); }
#undef SB_
#undef LD_W
#undef LD_KD
#undef MM_W
        asm volatile("s_waitcnt lgkmcnt(0)" ::: "memory"); __builtin_amdgcn_s_barrier(); asm volatile("" ::: "memory");
        if (n + 1 < n1) CMP_STORE(STCUR);
        asm volatile("s_waitcnt lgkmcnt(0)" ::: "memory"); __builtin_amdgcn_s_barrier(); asm volatile("" ::: "memory");
        if (n + 3 < n1) CMP_LOAD(STCUR, n + 3);
#undef STCUR
        }
        if (nb + 1 < n1) { const int n = nb + 1;
#define STCUR sty
        const unsigned char* it = items + (size_t)n * GI_BYTES;
        f32x4 ut[4];
#pragma unroll
        for (int mt = 0; mt < 4; ++mt) ut[mt] = part ? *(const GAS f32x4*)(it + GI_UT + ((size_t)col * 64 + 16 * mt + 4 * g) * 4) : (f32x4){0.f, 0.f, 0.f, 0.f};
        const float eg = *(const float*)(it + GI_EG);
        bf16x8 bs[4];
#pragma unroll
        for (int s = 0; s < 4; ++s) bs[s] = pack_b(X[2 * s], X[2 * s + 1]);
        bf16x8 fa[8], fb[8];
        f32x4 Y[4];
#pragma unroll
        for (int mt = 0; mt < 4; ++mt) Y[mt] = (f32x4){0.f, 0.f, 0.f, 0.f};
#define SB_() __builtin_amdgcn_sched_barrier(0)
#define LD_W(dst, mt0) do { _Pragma("unroll") for (int m_ = 0; m_ < 2; ++m_) _Pragma("unroll") for (int s_ = 0; s_ < 4; ++s_) \
            dst[4 * m_ + s_] = *(const LAS bf16x8*)(Abuf + OFF_WQ + (16 * ((mt0) + m_) + fr) * WQ_LD + 64 * s_ + 16 * g); } while (0)
#define LD_KD(dst, mt0) do { _Pragma("unroll") for (int m_ = 0; m_ < 4; ++m_) _Pragma("unroll") for (int s_ = 0; s_ < 2; ++s_) \
            dst[2 * m_ + s_] = *(const LAS bf16x8*)(Abuf + OFF_KD + (16 * ((mt0) + m_) + fr) * KD_LD + 64 * s_ + 16 * g); } while (0)
#define MM_W(src, mt0) do { _Pragma("unroll") for (int m_ = 0; m_ < 2; ++m_) _Pragma("unroll") for (int s_ = 0; s_ < 4; ++s_) Y[(mt0) + m_] = mfma16(src[4 * m_ + s_], bs[s_], Y[(mt0) + m_]); } while (0)
        LD_W(fa, 0); SB_();
        LD_W(fb, 2); SB_(); MM_W(fa, 0); SB_();
        LD_KD(fa, 0); SB_(); MM_W(fb, 2); SB_();
        f32x4 vn[4];
#pragma unroll
        for (int mt = 0; mt < 4; ++mt) vn[mt] = ut[mt] - Y[mt];
        bf16x8 bv[2];
#pragma unroll
        for (int s = 0; s < 2; ++s) bv[s] = pack_b(vn[2 * s], vn[2 * s + 1]);
        SB_();
        LD_KD(fb, 4); SB_();
#pragma unroll
        for (int mt = 0; mt < 4; ++mt) { X[mt] = X[mt] * eg;
#pragma unroll
            for (int s = 0; s < 2; ++s) X[mt] = mfma16(fa[2 * mt + s], bv[s], X[mt]); }
        SB_();
#pragma unroll
        for (int mt = 4; mt < 8; ++mt) { X[mt] = X[mt] * eg;
#pragma unroll
            for (int s = 0; s < 2; ++s) X[mt] = mfma16(fb[2 * (mt - 4) + s], bv[s], X[mt]); }
#undef SB_
#undef LD_W
#undef LD_KD
#undef MM_W
        asm volatile("s_waitcnt lgkmcnt(0)" ::: "memory"); __builtin_amdgcn_s_barrier(); asm volatile("" ::: "memory");
        if (n + 1 < n1) CMP_STORE(STCUR);
        asm volatile("s_waitcnt lgkmcnt(0)" ::: "memory"); __builtin_amdgcn_s_barrier(); asm volatile("" ::: "memory");
        if (n + 3 < n1) CMP_LOAD(STCUR, n + 3);
#undef STCUR
        }
    }
#undef CMP_LOAD
#undef CMP_STORE
    if (part == 0) {
        LAS bf16_t* img = (LAS bf16_t*)lds; const int pc = kperm(col);
#pragma unroll
        for (int mt = 0; mt < 8; ++mt)
#pragma unroll
            for (int r = 0; r < 4; ++r) img[(16 * mt + 4 * g + r) * 128 + pc] = f2bf_s(X[mt][r]);
        __syncthreads();
        unsigned char* dst = P.ws + WS_MG + (size_t)(h * 15 + gi) * 32768;
        for (int ch = tid; ch < 2048; ch += 512) *(GAS v4u*)(dst + ch * 16) = *(const LAS v4u*)((const LAS unsigned char*)img + ch * 16);
        __syncthreads();
    } else {
        float* dst = (float*)(P.ws + WS_CG + (size_t)(h * 15 + gi) * 65536) + (size_t)col * 128 + 4 * g;
#pragma unroll
        for (int mt = 0; mt < 8; ++mt) *(GAS f32x4*)(dst + 16 * mt) = X[mt];
    }
    DEP_PUBLISH_BEGIN() __hip_atomic_fetch_add(ctl + CW_CMP + 4 * (16 * h + gi), 1u, __ATOMIC_RELAXED, __HIP_MEMORY_SCOPE_AGENT); DEP_PUBLISH_END()
}
__device__ __forceinline__ void gdn_carry(const Params& P, int h, LAS unsigned char* lds, unsigned* ctl, int tid, int wave, int lane) {
    using namespace cfg;
    constexpr int WQ_LD = 272;
    const int fr = lane & 15, g = lane >> 4, dv = 16 * wave + fr;
    f32x4 S[8];
    { u32x4 raw[3][2][4]; float gb[2]; GDN_LOAD_GB(gb, h, 0, tid); GDN_LOAD_RAW(raw, h, 0, tid);
      gdn_prep_item(P, h, 0, raw, gb, 0, 0, false, lds, tid, wave, lane);
      asm volatile("s_waitcnt vmcnt(0)" ::: "memory");
      __syncthreads();
      if (tid == 0) { __builtin_amdgcn_fence(__ATOMIC_ACQ_REL, "agent"); asm volatile("s_waitcnt vmcnt(0)" ::: "memory"); }
      __syncthreads();
      gdn_scan(P, h, 0, 1, nullptr, S, lds, tid, wave, lane); }
#pragma unroll 1
    for (int gi = 0; gi < 16; ++gi) {
        float* sp = (float*)(P.ws + WS_SG + (size_t)(h * 16 + gi) * 65536) + (size_t)dv * 128 + 4 * g;
#pragma unroll
        for (int mt = 0; mt < 8; ++mt) *(GAS f32x4*)(sp + 16 * mt) = S[mt];
        v4u st[4];
        if (gi < 15) { dep_wait(ctl + CW_CMP + 4 * (16 * h + gi), 2u, wave);
            const unsigned char* mg = P.ws + WS_MG + (size_t)(h * 15 + gi) * 32768;
#pragma unroll
            for (int i = 0; i < 4; ++i) st[i] = *(const GAS v4u*)(mg + (size_t)(tid + 512 * i) * 16); }
        asm volatile("s_waitcnt vmcnt(0)" ::: "memory");
        __syncthreads();
        if (tid == 0) { __builtin_amdgcn_fence(__ATOMIC_RELEASE, "agent"); asm volatile("s_waitcnt vmcnt(0)" ::: "memory");
            __hip_atomic_store(ctl + CW_GFLAG + 64 * h, (unsigned)(gi + 1), __ATOMIC_RELAXED, __HIP_MEMORY_SCOPE_AGENT); }
        if (gi == 15) break;
#pragma unroll
        for (int i = 0; i < 4; ++i) { const int ch = tid + 512 * i; *(LAS v4u*)(lds + (ch >> 4) * WQ_LD + (ch & 15) * 16) = st[i]; }
        f32x4 ct[8];
        { const float* cp = (const float*)(P.ws + WS_CG + (size_t)(h * 15 + gi) * 65536) + (size_t)dv * 128 + 4 * g;
#pragma unroll
          for (int mt = 0; mt < 8; ++mt) ct[mt] = *(const GAS f32x4*)(cp + 16 * mt); }
        __syncthreads();
        bf16x8 bs[4];
#pragma unroll
        for (int s = 0; s < 4; ++s) bs[s] = pack_b(S[2 * s], S[2 * s + 1]);
#pragma unroll
        for (int mt = 0; mt < 8; ++mt) { f32x4 x = ct[mt];
#pragma unroll
            for (int s = 0; s < 4; ++s) { const bf16x8 a = *(const LAS bf16x8*)(lds + (16 * mt + fr) * WQ_LD + 64 * s + 16 * g); x = mfma16(a, bs[s], x); }
            S[mt] = x; }
        __syncthreads();
    }
}

__device__ __forceinline__ int crow(int r, int hh) { return (r & 3) + 8 * (r >> 2) + 4 * hh; }
__device__ __forceinline__ s16x4 vtr(const LAS unsigned char* p) { typedef short v4i16_t __attribute__((ext_vector_type(4))); return __builtin_bit_cast(s16x4, __builtin_amdgcn_ds_read_tr16_b64_v4i16((LAS v4i16_t*)p)); }
__device__ __forceinline__ f32x16 mfma32(bf16x8 a, bf16x8 b, f32x16 c) { return __builtin_amdgcn_mfma_f32_32x32x16_bf16(a, b, c, 0, 0, 0); }
#ifndef ATT_STAGGER
#define ATT_STAGGER 0
#endif
#define ATT_WAIT_V(n) asm volatile("s_waitcnt vmcnt(" #n ")" ::: "memory")
__device__ __forceinline__ volatile LAS unsigned* fresh_misc(LAS unsigned char* lds) { const unsigned a = (unsigned)(uintptr_t)(lds + cfg::MISC_OFF); unsigned v; asm volatile("v_mov_b32 %0, %1" : "=v"(v) : "s"(a)); return (volatile LAS unsigned*)(uintptr_t)v; }

__device__ __forceinline__ void attn_unit(const Params& P, int h, int qb, LAS unsigned char* lds, int tid, int wave, int lane) {
    using namespace cfg;
    asm volatile("v_mbcnt_lo_u32_b32 %0, -1, 0\n\tv_mbcnt_hi_u32_b32 %0, -1, %0" : "=v"(lane)); tid = wave * 64 + lane;
    constexpr int SLOT = 32768;
    const float negmb = __uint_as_float(fresh_misc(lds)[18]);
    const int r32 = lane & 31, hh = lane >> 5, map = wave >> 2, wq = wave & 3, hm = 2 * h + map;
    const bf16_t* qbuf = (const bf16_t*)(P.ws + WS_Q);
    const unsigned char* k1g = P.ws + WS_K + (size_t)(2 * h) * NCH * 8192;
    const unsigned char* k2g = P.ws + WS_K + (size_t)(2 * h + 1) * NCH * 8192;
    const unsigned char* vg = P.ws + WS_V + (size_t)h * NCH * 16384;
    const int NT = 2 * qb + 3;
    const unsigned lds0 = (unsigned)(uintptr_t)lds;
#define ATT_GLDS(gsrc, ldsoff) do { unsigned keep_; const unsigned dst_ = (unsigned)__builtin_amdgcn_readfirstlane((int)(lds0 + (unsigned)(ldsoff))); \
        asm volatile("s_mov_b32 %0, m0\n\ts_mov_b32 m0, %2\n\ts_nop 0\n\tglobal_load_lds_dwordx4 %1, off\n\ts_mov_b32 m0, %0" : "=&s"(keep_) : "v"(gsrc), "s"(dst_) : "memory"); } while (0)
#define ATT_DMA(t, slotoff) do { const size_t t_ = (size_t)(t); \
        ATT_GLDS(k1g + t_ * 8192 + wave * 1024 + lane * 16, (slotoff) + wave * 1024); \
        ATT_GLDS(k2g + t_ * 8192 + wave * 1024 + lane * 16, (slotoff) + 8192 + wave * 1024); \
        ATT_GLDS(vg + t_ * 16384 + wave * 1024 + lane * 16, (slotoff) + 16384 + wave * 1024); \
        ATT_GLDS(vg + t_ * 16384 + (wave + 8) * 1024 + lane * 16, (slotoff) + 16384 + (wave + 8) * 1024); } while (0)
    ATT_DMA(0, 0); ATT_DMA(1, SLOT); ATT_DMA(2, 2 * SLOT);
    bf16x8 qr[4];
    { const bf16_t* qp = qbuf + ((size_t)hm * 8192 + 128 * qb + 32 * wq + r32) * 64 + 8 * hh;
#pragma unroll
        for (int d0 = 0; d0 < 4; ++d0) qr[d0] = *(const bf16x8*)(qp + 16 * d0); }
    f32x16 o[4];
#pragma unroll
    for (int d0 = 0; d0 < 4; ++d0)
#pragma unroll
        for (int r = 0; r < 16; ++r) o[d0][r] = 0.f;
    float lsum = 0.f;
    const int qrel = 32 * wq + r32;
    const int vb0 = ((lane >> 4) & 1) * 32 + (lane & 3) * 8 + (4 * hh + ((lane & 15) >> 2)) * 64;
    const int kb0 = map * 8192 + hh * 1024 + r32 * 16;
#define ATT_QK(P0, P1, slotoff) do { const LAS unsigned char* Ks_ = lds + (slotoff) + kb0; \
        _Pragma("unroll") for (int r_ = 0; r_ < 16; ++r_) { P0[r_] = negmb; P1[r_] = negmb; } \
        _Pragma("unroll") for (int d0_ = 0; d0_ < 4; ++d0_) { \
            const bf16x8 ka_ = *(const LAS bf16x8*)(Ks_ + d0_ * 2048); const bf16x8 kb_ = *(const LAS bf16x8*)(Ks_ + d0_ * 2048 + 512); \
            P0 = mfma32(ka_, qr[d0_], P0); P1 = mfma32(kb_, qr[d0_], P1); } } while (0)
    f32x16 p0, p1;
    ATT_WAIT_V(8);
    __builtin_amdgcn_s_barrier();
    asm volatile("" ::: "memory");
    ATT_QK(p0, p1, 0);
    int slot = 0;
#define SB_() __builtin_amdgcn_sched_barrier(0)
#define LD_V(dst, d0_) do { _Pragma("unroll") for (int s_ = 0; s_ < 4; ++s_) { const s16x4 lo_ = vtr(Vs + (d0_) * 4096 + s_ * 1024), hi_ = vtr(Vs + (d0_) * 4096 + s_ * 1024 + 512); \
            dst[s_] = (bf16x8){lo_[0], lo_[1], lo_[2], lo_[3], hi_[0], hi_[1], hi_[2], hi_[3]}; } } while (0)
#define ATT_STEP(t_, MODE, HAS_NEXT) do { const int t = (t_); \
        if (t + 2 < NT) ATT_WAIT_V(4); else ATT_WAIT_V(0);                       \
        __builtin_amdgcn_s_barrier(); \
        asm volatile("" ::: "memory"); \
        const int slot_n = (slot + SLOT) & (4 * SLOT - 1), slot_p = (slot + 3 * SLOT) & (4 * SLOT - 1); \
        if (t + 3 < NT) ATT_DMA(t + 3, slot_p);                                  \
        const LAS unsigned char* Vs = lds + slot + 16384 + vb0; \
        const LAS unsigned char* Kn = lds + slot_n + kb0; \
        bf16x8 kf[8], va[4], vb[4]; \
        if (HAS_NEXT) { \
            _Pragma("unroll") for (int d0 = 0; d0 < 4; ++d0) { kf[2 * d0] = *(const LAS bf16x8*)(Kn + d0 * 2048); kf[2 * d0 + 1] = *(const LAS bf16x8*)(Kn + d0 * 2048 + 512); } } \
        LD_V(va, 0); \
        SB_(); \
          \
        if ((MODE) == 0) { \
            _Pragma("unroll") for (int r = 0; r < 16; ++r) { p0[r] = 0.f; p1[r] = (r < 8) ? 0.f : __builtin_amdgcn_exp2f(p1[r]); } \
        } else { \
            _Pragma("unroll") for (int r = 0; r < 16; ++r) { p0[r] = __builtin_amdgcn_exp2f(p0[r]); p1[r] = __builtin_amdgcn_exp2f(p1[r]); } \
            if ((MODE) == 2) { const int thr = qrel - 64 * (t - (NT - 2)); \
                _Pragma("unroll") for (int r = 0; r < 16; ++r) { const int kv = crow(r, hh); if (kv > thr) p0[r] = 0.f; if (kv + 32 > thr) p1[r] = 0.f; } } \
        } \
        float sacc = 0.f; \
        _Pragma("unroll") for (int r = 0; r < 16; ++r) sacc += p0[r] + p1[r]; \
        lsum += sacc; \
        bf16x8 pw[4]; \
        { u32x4 w; \
          w.x = pg8::cvt_pk_bf16(p0[0], p0[1]); w.y = pg8::cvt_pk_bf16(p0[2], p0[3]); w.z = pg8::cvt_pk_bf16(p0[4], p0[5]); w.w = pg8::cvt_pk_bf16(p0[6], p0[7]); pw[0] = __builtin_bit_cast(bf16x8, w); \
          w.x = pg8::cvt_pk_bf16(p0[8], p0[9]); w.y = pg8::cvt_pk_bf16(p0[10], p0[11]); w.z = pg8::cvt_pk_bf16(p0[12], p0[13]); w.w = pg8::cvt_pk_bf16(p0[14], p0[15]); pw[1] = __builtin_bit_cast(bf16x8, w); \
          w.x = pg8::cvt_pk_bf16(p1[0], p1[1]); w.y = pg8::cvt_pk_bf16(p1[2], p1[3]); w.z = pg8::cvt_pk_bf16(p1[4], p1[5]); w.w = pg8::cvt_pk_bf16(p1[6], p1[7]); pw[2] = __builtin_bit_cast(bf16x8, w); \
          w.x = pg8::cvt_pk_bf16(p1[8], p1[9]); w.y = pg8::cvt_pk_bf16(p1[10], p1[11]); w.z = pg8::cvt_pk_bf16(p1[12], p1[13]); w.w = pg8::cvt_pk_bf16(p1[14], p1[15]); pw[3] = __builtin_bit_cast(bf16x8, w); } \
        SB_(); \
          \
        if (HAS_NEXT) { \
            _Pragma("unroll") for (int r = 0; r < 16; ++r) { p0[r] = negmb; p1[r] = negmb; } \
            _Pragma("unroll") for (int d0 = 0; d0 < 4; ++d0) { p0 = mfma32(kf[2 * d0], qr[d0], p0); p1 = mfma32(kf[2 * d0 + 1], qr[d0], p1); } } \
        SB_(); \
          \
        LD_V(vb, 1); SB_(); \
        _Pragma("unroll") for (int s2 = 0; s2 < 4; ++s2) o[0] = mfma32(pw[s2], va[s2], o[0]); \
        SB_(); LD_V(va, 2); SB_(); \
        _Pragma("unroll") for (int s2 = 0; s2 < 4; ++s2) o[1] = mfma32(pw[s2], vb[s2], o[1]); \
        SB_(); LD_V(vb, 3); SB_(); \
        _Pragma("unroll") for (int s2 = 0; s2 < 4; ++s2) o[2] = mfma32(pw[s2], va[s2], o[2]); \
        SB_(); \
        _Pragma("unroll") for (int s2 = 0; s2 < 4; ++s2) o[3] = mfma32(pw[s2], vb[s2], o[3]); \
        slot = slot_n; } while (0)
    ATT_STEP(0, 0, true);
#pragma unroll 1
    for (int ti = 1; ti < NT - 2; ++ti) ATT_STEP(ti, 1, true);
    ATT_STEP(NT - 2, 2, true);
    ATT_STEP(NT - 1, 2, false);
#undef ATT_STEP
#undef SB_
#undef LD_V
#undef ATT_QK
    lsum += __shfl_xor(lsum, 32);
    asm volatile("s_waitcnt lgkmcnt(0)" ::: "memory"); __builtin_amdgcn_s_barrier(); asm volatile("" ::: "memory");
    LAS float* wsf = (LAS float*)(lds + 131072) + wave * 32;
    LAS float* Xc = (LAS float*)lds;
    if (hh == 0) wsf[r32] = lsum;
    asm volatile("s_waitcnt lgkmcnt(0)" ::: "memory");
    float rl[16];
#pragma unroll
    for (int r = 0; r < 16; ++r) rl[r] = 1.0f / wsf[crow(r, hh)];
    if (map == 1) {
#pragma unroll
        for (int d0 = 0; d0 < 4; ++d0)
#pragma unroll
            for (int r = 0; r < 16; ++r) Xc[(32 * wq + crow(r, hh)) * 132 + 32 * d0 + r32] = o[d0][r] * rl[r];
    }
    __syncthreads();
    if (map == 0) { const float lam = __uint_as_float(fresh_misc(lds)[17]);
#pragma unroll
        for (int d0 = 0; d0 < 4; ++d0)
#pragma unroll
            for (int r = 0; r < 16; ++r) { LAS float* xp = Xc + (32 * wq + crow(r, hh)) * 132 + 32 * d0 + r32; *xp = o[d0][r] * rl[r] - lam * (*xp); }
    }
    __syncthreads();
    {
        const int row = tid >> 2, seg = tid & 3; float v[32]; float ss = 0.f;
#pragma unroll
        for (int i = 0; i < 8; ++i) { const f32x4 x4 = *(const LAS f32x4*)(Xc + row * 132 + 32 * seg + 4 * i); v[4 * i] = x4[0]; v[4 * i + 1] = x4[1]; v[4 * i + 2] = x4[2]; v[4 * i + 3] = x4[3];
            ss += (x4[0] * x4[0] + x4[1] * x4[1]) + (x4[2] * x4[2] + x4[3] * x4[3]); }
        ss += __shfl_xor(ss, 1); ss += __shfl_xor(ss, 2);
        const float rn = __builtin_amdgcn_rsqf(ss * (1.0f / 128.0f) + 1e-6f) * 0.8f;
        const float* gp = P.diff_norm + 32 * seg;
        bf16_t* mp = (bf16_t*)(P.ws + WS_MIX) + (size_t)(128 * qb + row) * 2048 + 1024 + h * 128 + 32 * seg;
#pragma unroll
        for (int i = 0; i < 4; ++i) { const f32x4 g0 = *(const f32x4*)(gp + 8 * i), g1 = *(const f32x4*)(gp + 8 * i + 4); u32x4 w;
            w.x = pk2(v[8 * i] * rn * g0[0], v[8 * i + 1] * rn * g0[1]); w.y = pk2(v[8 * i + 2] * rn * g0[2], v[8 * i + 3] * rn * g0[3]);
            w.z = pk2(v[8 * i + 4] * rn * g1[0], v[8 * i + 5] * rn * g1[1]); w.w = pk2(v[8 * i + 6] * rn * g1[2], v[8 * i + 7] * rn * g1[3]);
            *(u32x4*)(mp + 8 * i) = w; }
    }
    __syncthreads();
#undef ATT_DMA
#undef ATT_GLDS
}

__device__ __forceinline__ void attn_phase(const Params& P, LAS unsigned char* lds, unsigned* ctl, unsigned* qhead, unsigned xcc, volatile LAS unsigned* misc, int tid, int wave, int lane) {
    using namespace cfg;
    { const float a1 = P.lq1[lane] * P.lk1[lane], a2 = P.lq2[lane] * P.lk2[lane]; float gq = fabsf(P.q_norm[lane]), gk = fabsf(P.k_norm[lane]);
      const float d1 = wave_sum(a1), d2 = wave_sum(a2);
#pragma unroll
      for (int o = 1; o < 64; o <<= 1) { gq = fmaxf(gq, __shfl_xor(gq, o)); gk = fmaxf(gk, __shfl_xor(gk, o)); }
      volatile LAS unsigned* m_ = fresh_misc(lds); m_[17] = __float_as_uint(__expf(d1) - __expf(d2) + 0.2f);
      m_[18] = __float_as_uint(-(0.18033688011112042f * 64.0f * gq * gk * 1.02f)); }
    int q = (int)(xcc & 7u);
    for (;;) {
        { int l_; asm volatile("v_mbcnt_lo_u32_b32 %0, -1, 0\n\tv_mbcnt_hi_u32_b32 %0, -1, %0" : "=v"(l_));
          if (wave == 0 && l_ == 0) { unsigned item = 0xffffffffu; int qq = q;
              for (int k = 0; k < 8; ++k) { const unsigned v = __hip_atomic_fetch_add(qhead + 64 * qq, 1u, __ATOMIC_RELAXED, __HIP_MEMORY_SCOPE_AGENT); if (v < 80u) { item = v | ((unsigned)qq << 8); break; } qq = (qq + 1) & 7; }
              fresh_misc(lds)[16] = item; } }
        __syncthreads();
        const unsigned it_ = (unsigned)__builtin_amdgcn_readfirstlane((int)fresh_misc(lds)[16]);
        __syncthreads();
        if (it_ == 0xffffffffu) break;
        const unsigned u = it_ & 0xffu; q = (int)(it_ >> 8);
        const int h = q;
        if (u >= 32u && u < 48u) {
            const int gi = (int)u - 32;
            const float* sinit = nullptr;
            {
                int l_; asm volatile("v_mbcnt_lo_u32_b32 %0, -1, 0\n\tv_mbcnt_hi_u32_b32 %0, -1, %0" : "=v"(l_));
                if (wave == 0 && l_ == 0) { unsigned sp = 0; while (__hip_atomic_load(ctl + CW_GFLAG + 64 * h, __ATOMIC_RELAXED, __HIP_MEMORY_SCOPE_AGENT) < (unsigned)(gi + 1)) { __builtin_amdgcn_s_sleep(8); if (++sp > (1u << 22)) break; }
                    sp = 0; while (__hip_atomic_load(ctl + CW_P2C + 4 * (16 * h + gi), __ATOMIC_RELAXED, __HIP_MEMORY_SCOPE_AGENT) < 8u) { __builtin_amdgcn_s_sleep(8); if (++sp > (1u << 22)) break; }
                    __builtin_amdgcn_fence(__ATOMIC_ACQUIRE, "agent"); asm volatile("s_waitcnt vmcnt(0)" ::: "memory"); }
                __syncthreads();
                sinit = (const float*)(P.ws + WS_SG + (size_t)(h * 16 + gi) * 65536);
            }
            gdn_scan(P, h, grp_start(gi), 8 * gi + 9, sinit, nullptr, lds, tid, wave, lane);
        } else {
            const int qb = (u < 32u) ? 63 - (int)u : 79 - (int)u;
            attn_unit(P, h, qb, lds, tid, wave, lane);
        }
    }
}

#ifndef PROBE_DUP
#define PROBE_DUP -1
#endif
#define PHASE_BEGIN() const CAS Params* pp_ = (const CAS Params*)__builtin_amdgcn_kernarg_segment_ptr(); asm volatile("" : "+s"(pp_)); Params P; P.x = (const float*)(const GAS float*)pp_->x; P.meta = (const float*)(const GAS float*)pp_->meta; P.attn_norm = (const float*)(const GAS float*)pp_->attn_norm; P.w_in = (const float*)(const GAS float*)pp_->w_in; P.conv_w = (const float*)(const GAS float*)pp_->conv_w; P.a_log = (const float*)(const GAS float*)pp_->a_log; P.dt_bias = (const float*)(const GAS float*)pp_->dt_bias; P.gdn_norm = (const float*)(const GAS float*)pp_->gdn_norm; P.q_norm = (const float*)(const GAS float*)pp_->q_norm; P.k_norm = (const float*)(const GAS float*)pp_->k_norm; P.lq1 = (const float*)(const GAS float*)pp_->lq1; P.lk1 = (const float*)(const GAS float*)pp_->lk1; P.lq2 = (const float*)(const GAS float*)pp_->lq2; P.lk2 = (const float*)(const GAS float*)pp_->lk2; P.diff_norm = (const float*)(const GAS float*)pp_->diff_norm; P.w_out = (const float*)(const GAS float*)pp_->w_out; P.ffn_norm = (const float*)(const GAS float*)pp_->ffn_norm; P.w_gu = (const float*)(const GAS float*)pp_->w_gu; P.w_dn = (const float*)(const GAS float*)pp_->w_dn; P.out = (float*)(GAS float*)pp_->out; P.ws = (unsigned char*)(GAS unsigned char*)pp_->ws; \
    int tid; asm volatile("v_mbcnt_lo_u32_b32 %0, -1, 0\n\tv_mbcnt_hi_u32_b32 %0, -1, %0" : "=v"(tid)); tid += wave0_ * 64; const int lane = tid & 63, wave = __builtin_amdgcn_readfirstlane(tid >> 6); \
    const int G = gridDim.x, bx = blockIdx.x, vcu = (G % 8 == 0) ? (bx % 8) * (G / 8) + bx / 8 : bx; (void)lane; (void)wave; (void)vcu; (void)bx
__global__ void __launch_bounds__(512, 2) hymba_fwd(Params Pk) {
    using namespace cfg;
    extern __shared__ __attribute__((aligned(16))) unsigned char lds_raw[];
    LAS unsigned char* lds = (LAS unsigned char*)lds_raw;
    volatile LAS unsigned* MISC = (volatile LAS unsigned*)(lds + MISC_OFF);
    const int wave0_ = __builtin_amdgcn_readfirstlane((int)threadIdx.x >> 6);
    XcdBarrier bar;
    {
        PHASE_BEGIN();
        unsigned* ctl = (unsigned*)(P.ws + WS_CTL);
        if (tid < 64) MISC[tid] = 0u;
        __syncthreads();
        bar = xcd_barrier_post(ctl + CW_BAR, MISC + 8);
    }

    for (int rep_ = 0; rep_ < (PROBE_DUP == 0 ? 2 : 1); ++rep_) {
    { PHASE_BEGIN(); p0_prep(P, lds, vcu, G, wave, lane); }
    xcd_barrier(bar); }
    if (PROBE_DUP == 10) { for (int i_ = 0; i_ < 8; ++i_) xcd_barrier(bar); }
    for (int rep_ = 0; rep_ < (PROBE_DUP == 1 ? 2 : 1); ++rep_) {
        PHASE_BEGIN();
        pg8::Gemm g{(const bf16_t*)(P.ws + WS_APAD), (const bf16_t*)(P.ws + WS_WIN), MP, NPROJ, 2048}; pg8::StaticOrder S; S.init(MP, NPROJ, G, bx);
        pg8::EpiInProj E{(const float*)(P.ws + WS_RSTD), (bf16_t*)(P.ws + WS_GRAW), (bf16_t*)(P.ws + WS_Q), (bf16_t*)(P.ws + WS_K), (bf16_t*)(P.ws + WS_V),
                         (float*)(P.ws + WS_BETA), (float*)(P.ws + WS_GDEC), P.q_norm, P.k_norm, P.a_log, P.dt_bias};
        pg8::gemm_phase<pg8::EpiInProj, pg8::StaticOrder, true, true>(lds, g, S, E, tid);
        { constexpr int NU = (MP / 256) * (NPROJ / 256), FIRST_IDLE = NU - (NU / 256) * 256;
          if (G == 256 && bx >= FIRST_IDLE && P1_IDLE_MASK && rep_ == 0) p0_convert(P, lds, (bx - FIRST_IDLE) * 8 + wave, (256 - FIRST_IDLE) * 8, wave, lane, P1_IDLE_MASK, GU_SPLIT, 32);
          else if (G != 256 && P1_IDLE_MASK && rep_ == 0) p0_convert(P, lds, vcu * 8 + wave, G * 8, wave, lane, P1_IDLE_MASK, GU_SPLIT, 32); }
        xcd_barrier(bar);
    }
    for (int rep_ = 0; rep_ < (PROBE_DUP == 2 ? 2 : 1); ++rep_) {
    { PHASE_BEGIN(); u32x4 raw[3][2][4]; float gb[2] = {0.f, 0.f};
      if (vcu < 1024) { GDN_LOAD_GB(gb, vcu & 7, (vcu >> 3) + 1, tid); GDN_LOAD_RAW(raw, vcu & 7, (vcu >> 3) + 1, tid); }
      for (int it = vcu; it < 1024; it += G) { const int nx = it + G; gdn_prep_item(P, it & 7, (it >> 3) + 1, raw, gb, nx & 7, (nx >> 3) + 1, nx < 1024, lds, tid, wave, lane); }
      DEP_PUBLISH_BEGIN() for (int it = vcu; it < 1024; it += G) __hip_atomic_fetch_add((unsigned*)(P.ws + WS_CTL) + CW_P2C + 4 * (16 * (it & 7) + (it >> 6)), 1u, __ATOMIC_RELAXED, __HIP_MEMORY_SCOPE_AGENT); DEP_PUBLISH_END() } }
    for (int rep_ = 0; rep_ < (PROBE_DUP == 7 ? 2 : 1); ++rep_) {
    { PHASE_BEGIN(); for (int it = bx; it < 240; it += G) { const int r_ = it >> 3; gdn_compose(P, it & 7, r_ >> 1, r_ & 1, lds, (unsigned*)(P.ws + WS_CTL), tid, wave, lane); } } }
    for (int rep_ = 0; rep_ < (PROBE_DUP == 3 ? 2 : 1); ++rep_) {
    if (blockIdx.x < 8) { PHASE_BEGIN(); gdn_carry(P, bx, lds, (unsigned*)(P.ws + WS_CTL) + 8192 * rep_, tid, wave, lane); }
    { PHASE_BEGIN(); attn_phase(P, lds, (unsigned*)(P.ws + WS_CTL) + 8192 * rep_, (unsigned*)(P.ws + WS_CTL) + 8192 * rep_ + CW_ATTQ, bar.x, MISC, tid, wave, lane); }
    xcd_barrier(bar); }
    for (int rep_ = 0; rep_ < (PROBE_DUP == 8 ? 2 : 1); ++rep_) {
        PHASE_BEGIN();
        pg8::Gemm g{(const bf16_t*)(P.ws + WS_MIX), (const bf16_t*)(P.ws + WS_WOUT), 8192, 2048, 2048}; pg8::StaticOrder S; S.init(8192, 2048, G, bx);
        pg8::EpiOutProj E{P.x, (bf16_t*)(P.ws + WS_H1B), (float*)(P.ws + WS_SSQ)};
        pg8::gemm_phase<pg8::EpiOutProj, pg8::StaticOrder, true, true>(lds, g, S, E, tid);
        xcd_barrier(bar);
    }
    for (int rep_ = 0; rep_ < (PROBE_DUP == 5 ? 2 : 1); ++rep_) {
        PHASE_BEGIN();
        pg8::Gemm g{(const bf16_t*)(P.ws + WS_H1B), (const bf16_t*)(P.ws + WS_WGU), 8192, 2 * DFF, 2048}; pg8::StaticOrder S; S.init(8192, 2 * DFF, G, bx);
        LAS float* rs2 = (LAS float*)(lds + 131072); int rs2_pm = -1;
        { pg8::Unit u0; if (S.next(0, u0)) { rs2_pm = u0.pm;
            if (tid < 256) { const pg8::f32x4* sp = (const pg8::f32x4*)((const float*)(P.ws + WS_SSQ) + (size_t)(256 * u0.pm + tid) * 32); pg8::f32x4 s4 = sp[0];
#pragma unroll
                for (int i = 1; i < 8; ++i) s4 += sp[i];
                rs2[tid] = __builtin_amdgcn_rsqf(((s4[0] + s4[1]) + (s4[2] + s4[3])) * (1.0f / 2048.0f) + 1e-6f); } }
          __syncthreads(); }
        pg8::EpiGateUp E{(const float*)(P.ws + WS_SSQ), (bf16_t*)(P.ws + WS_HID), rs2, rs2_pm};
        pg8::gemm_phase<pg8::EpiGateUp, pg8::StaticOrder, true, true>(lds, g, S, E, tid);
        { constexpr int NU = 32 * 44, FIRST_IDLE = NU - (NU / 256) * 256;
          if (G == 256 && bx >= FIRST_IDLE && P5_IDLE_MASK && rep_ == 0) p0_convert(P, lds, (bx - FIRST_IDLE) * 8 + wave, (256 - FIRST_IDLE) * 8, wave, lane, P5_IDLE_MASK);
          else if (G != 256 && P5_IDLE_MASK && rep_ == 0) p0_convert(P, lds, vcu * 8 + wave, G * 8, wave, lane, P5_IDLE_MASK); }
        xcd_barrier(bar);
    }
    for (int rep_ = (PROBE_DUP == 9 ? 0 : 1); rep_ < 2; ++rep_) {
        PHASE_BEGIN();
        pg8::Gemm g{(const bf16_t*)(P.ws + WS_HID), (const bf16_t*)(P.ws + WS_WDN), 8192, 2048, DFF}; pg8::StaticOrder S; S.init(8192, 2048, G, bx);
        pg8::EpiDown E{(const bf16_t*)(P.ws + WS_H1B), rep_ == 1 ? P.out : (float*)(P.ws + WS_GDNP)};
        pg8::gemm_phase<pg8::EpiDown, pg8::StaticOrder, true, true>(lds, g, S, E, tid);
        if (rep_ == 0) xcd_barrier(bar);
    }
}

extern "C" void kernel_launch(void* const* d_in, const int* in_sizes, int n_in, void* d_out, int out_size, void* d_ws, size_t ws_size, hipStream_t stream) {
    using namespace cfg;
    static int grid = 0;
    if (grid == 0) {
        if (n_in != 19 || in_sizes[0] != SEQ * DMODEL || out_size != SEQ * DMODEL || ws_size < WS_END) {
            fprintf(stderr, "kernel_launch: unexpected shapes (n_in %d, in0 %d, out %d, ws %zu, need %zu); nothing launched\n", n_in, n_in > 0 ? in_sizes[0] : -1, out_size, ws_size, (size_t)WS_END); grid = -1; return; }
        int dev = 0, cus = 0, per_cu = 0;
        if (hipGetDevice(&dev) != hipSuccess || hipDeviceGetAttribute(&cus, hipDeviceAttributeMultiprocessorCount, dev) != hipSuccess) { fprintf(stderr, "kernel_launch: device query failed\n"); grid = -1; return; }
        if (hipFuncSetAttribute((const void*)hymba_fwd, hipFuncAttributeMaxDynamicSharedMemorySize, LDS_BYTES) != hipSuccess) { fprintf(stderr, "kernel_launch: hipFuncSetAttribute failed\n"); grid = -1; return; }
        if (hipOccupancyMaxActiveBlocksPerMultiprocessor(&per_cu, (const void*)hymba_fwd, 512, LDS_BYTES) != hipSuccess || per_cu < 1)
            fprintf(stderr, "kernel_launch: note: occupancy query reports %d workgroups per CU\n", per_cu);
        (void)hipGetLastError();
        grid = cus;
    }
    if (grid < 0) return;
    if (hipMemsetAsync((char*)d_ws + WS_CTL, 0, CTL_ZERO_BYTES, stream) != hipSuccess) { fprintf(stderr, "kernel_launch: memset failed\n"); return; }
    Params p{};
    const float** pp = (const float**)&p;
    for (int i = 0; i < 19; ++i) pp[i] = (const float*)d_in[i];
    p.out = (float*)d_out; p.ws = (unsigned char*)d_ws;
    hipLaunchKernelGGL(hymba_fwd, dim3(grid), dim3(512), LDS_BYTES, stream, p);
    const hipError_t le = hipPeekAtLastError();
    if (le != hipSuccess) fprintf(stderr, "kernel_launch: launch failed: %s\n", hipGetErrorName(le));
}
```

```cpp
#include <hip/hip_runtime.h>
#include <hip/hip_bf16.h>
#include <cstdio>
#include <cstdint>
#include <cmath>
#if defined(PROBE_DUP) && PROBE_DUP == 13
#define PG8_EPI_REP 3
#else
#define PG8_EPI_REP 1
#endif
namespace pg8 {
#define PG8_LAS __attribute__((address_space(3)))
typedef unsigned short bf16_t;
typedef short bf16x8 __attribute__((ext_vector_type(8)));
typedef float f32x4 __attribute__((ext_vector_type(4)));
typedef unsigned u32x4 __attribute__((ext_vector_type(4)));
constexpr int BM = 256, BK = 64, HALF = 128, HTB = HALF * BK * 2  , STAGE_BYTES = 8 * HTB, NXCD = 8, WGM = 8;

__host__ __device__ __forceinline__ int lds_byte(int r, int c) { const int st = (r >> 4) * 2 + (c >> 5), rr = r & 15, cc = c & 31, ob = rr * 64 + cc * 2; return st * 1024 + (ob ^ (((ob >> 9) & 1) << 5)); }
__host__ __device__ __forceinline__ void stage_rc(int b, int& R, int& C) { const int st = b / 1024, sb = b % 1024, swz = sb ^ (((sb >> 9) & 1) << 5); R = (st >> 1) * 16 + swz / 64; C = (st & 1) * 32 + (swz % 64) / 2; }
__host__ __device__ __forceinline__ int perm32(int rho) { const int n = rho >> 4, i = rho & 15; return 8 * (i >> 2) + 4 * n + (i & 3); }

struct Unit { int pm, pn; };
struct Gemm { const bf16_t* A; const bf16_t* Bt; int M, N, K; };

struct StaticOrder {
    int nM, nN, nwg, G, c;
    __host__ __device__ __attribute__((always_inline)) void init(int M, int N, int G_, int c_) { nM = M / BM; nN = N / BM; nwg = nM * nN; G = G_; c = c_; }
    __host__ __device__ __attribute__((always_inline)) bool next(int i, Unit& u) const {
        const long L = (long)i * G + c; if (L >= nwg) return false;
        int wgid = (int)L; { const int q = nwg / NXCD, r = nwg % NXCD, xcd = wgid % NXCD, off = wgid / NXCD; wgid = (xcd < r ? xcd * (q + 1) : r * (q + 1) + (xcd - r) * q) + off; }
        const int nig = WGM * nN, gid = wgid / nig, fm = gid * WGM, gsz = (nM - fm) < WGM ? (nM - fm) : WGM;
        u.pm = fm + ((wgid % nig) % gsz); u.pn = (wgid % nig) / gsz; return true;
    }
    __device__ __forceinline__ void a_ready(const Unit&) const {}
    __device__ __forceinline__ void done(const Unit&) const {}
};


__device__ __forceinline__ unsigned cvt_pk_bf16(float lo, float hi) { unsigned r; asm volatile("v_cvt_pk_bf16_f32 %0, %1, %2" : "=v"(r) : "v"(lo), "v"(hi)); return r; }
__device__ __forceinline__ u32x4 pack8(const f32x4 a, const f32x4 b) { u32x4 w; w.x = cvt_pk_bf16(a[0], a[1]); w.y = cvt_pk_bf16(a[2], a[3]); w.z = cvt_pk_bf16(b[0], b[1]); w.w = cvt_pk_bf16(b[2], b[3]); return w; }
__device__ __forceinline__ float silu_f(float v) { return v * __builtin_amdgcn_rcpf(1.0f + __builtin_amdgcn_exp2f(-1.4426950408889634f * v)); }

__constant__ float REV0[32] = {
    1.591549431e-01f, 1.193493785e-01f, 8.949940276e-02f, 6.711508467e-02f, 5.032921177e-02f, 3.774158578e-02f, 2.830219557e-02f, 2.122365077e-02f, 1.591549455e-02f, 1.193493619e-02f, 8.949940158e-03f, 6.711508704e-03f, 5.032920939e-03f, 3.774158578e-03f, 2.830219617e-03f, 2.122365373e-03f,
    1.591549395e-03f, 1.193493663e-03f, 8.949940158e-04f, 6.711507963e-04f, 5.032921162e-04f, 3.774158282e-04f, 2.830219617e-04f, 2.122365299e-04f, 1.591549507e-04f, 1.193493756e-04f, 8.949939787e-05f, 6.711508519e-05f, 5.032921069e-05f, 3.774158467e-05f, 2.830219570e-05f, 2.122365391e-05f};
__constant__ float REV1[32] = {
    1.859163579e-01f, 6.383602235e-01f, 7.279617768e-01f, 2.953654189e-01f, 2.210695530e-01f, 4.154614901e-01f, 8.113405167e-01f, 3.583136490e-01f, 1.859165097e-02f, 7.638359161e-01f, 5.727961701e-01f, 4.295365571e-01f, 3.221069401e-01f, 2.415461490e-01f, 1.811340555e-01f, 1.358313839e-01f,
    1.018591613e-01f, 7.638359446e-02f, 5.727961701e-02f, 4.295365096e-02f, 3.221069544e-02f, 2.415461300e-02f, 1.811340555e-02f, 1.358313791e-02f, 1.018591684e-02f, 7.638360038e-03f, 5.727961464e-03f, 4.295365452e-03f, 3.221069484e-03f, 2.415461419e-03f, 1.811340525e-03f, 1.358313851e-03f};

struct EpiInProj {
    static constexpr bool PERM = true, AFTER_DRAIN = false, INIT = false;
#if defined(PROBE_DUP) && PROBE_DUP == 14
    static constexpr int REP = 3;
#else
    static constexpr int REP = 1;
#endif
    const float* rstd;
    bf16_t* graw;
    bf16_t* qbuf;
    bf16_t* kimg;
    bf16_t* vimg;
    float* beta; float* gdec;
    const float* qn; const float* kn; const float* a_log; const float* dt_bias;
    __device__ __forceinline__ void operator()(const f32x4 (&acc)[2][2][4][2], const Unit& u, int wr, int wc, int fr, int fq) const {
        asm volatile("" : "+v"(fr), "+v"(fq));
        const int pn = u.pn, row0 = u.pm * BM + wr * 64 + fr;
        float rsv[2][4];
#pragma unroll
        for (int ai = 0; ai < 2; ++ai)
#pragma unroll
            for (int m = 0; m < 4; ++m) rsv[ai][m] = rstd[row0 + ai * HALF + m * 16];
        if (pn < 16) {
#pragma unroll
            for (int ai = 0; ai < 2; ++ai)
#pragma unroll
                for (int m = 0; m < 4; ++m) { const int row = row0 + ai * HALF + m * 16; const float rs = rsv[ai][m];
                    bf16_t* rowp = graw + (size_t)row * 4096 + pn * 256 + wc * 32 + 8 * fq;
#pragma unroll
                    for (int bj = 0; bj < 2; ++bj) *(u32x4*)(rowp + bj * HALF) = pack8(acc[ai][bj][m][0] * rs, acc[ai][bj][m][1] * rs); }
        } else if (pn < 24) {
            const int G = 4 * (pn - 16) + wc; const bool isK = G >= 16; const int hm = G & 15;
            const float* gp = (isK ? kn : qn) + 8 * fq;
            f32x4 gn[2][2];
#pragma unroll
            for (int bj = 0; bj < 2; ++bj)
#pragma unroll
                for (int n = 0; n < 2; ++n) gn[bj][n] = *(const f32x4*)(gp + 32 * bj + 4 * n);
            f32x4 rf0[2], rf1[2];
#pragma unroll
            for (int n = 0; n < 2; ++n) { rf0[n] = *(const f32x4*)(REV0 + 8 * fq + 4 * n); rf1[n] = *(const f32x4*)(REV1 + 8 * fq + 4 * n); }
            const float osc = isK ? 1.0f : 0.18033688011112042f;
#pragma unroll
            for (int ai = 0; ai < 2; ++ai)
#pragma unroll
                for (int m = 0; m < 4; ++m) { const int row = row0 + ai * HALF + m * 16; const float rs = rsv[ai][m];
                    f32x4 x[2][2]; float ss = 0.f;
#pragma unroll
                    for (int bj = 0; bj < 2; ++bj)
#pragma unroll
                        for (int n = 0; n < 2; ++n) { x[bj][n] = acc[ai][bj][m][n] * rs; ss += (x[bj][n][0] * x[bj][n][0] + x[bj][n][1] * x[bj][n][1]) + (x[bj][n][2] * x[bj][n][2] + x[bj][n][3] * x[bj][n][3]); }
                    ss += __shfl_xor(ss, 16); ss += __shfl_xor(ss, 32);
                    const float rn = __builtin_amdgcn_rsqf(ss * (1.0f / 64.0f) + 1e-6f) * osc;
                    const int pos = row < 48 ? 0 : row - 48; const float pa = (float)(pos >> 6), pb = (float)(pos & 63);
                    f32x4 o[2][2];
#pragma unroll
                    for (int n = 0; n < 2; ++n)
#pragma unroll
                        for (int j = 0; j < 4; ++j) {
                            const float fr_ = __builtin_amdgcn_fractf(pa * rf1[n][j] + pb * rf0[n][j]);
                            const float sn = __builtin_amdgcn_sinf(fr_), cs = __builtin_amdgcn_cosf(fr_);
                            const float y1 = x[0][n][j] * rn * gn[0][n][j], y2 = x[1][n][j] * rn * gn[1][n][j];
                            o[0][n][j] = y1 * cs - y2 * sn; o[1][n][j] = y2 * cs + y1 * sn; }
                    if (!isK) {
                        if (row >= 64 && row < 8256) { bf16_t* qp = qbuf + ((size_t)hm * 8192 + (row - 64)) * 64 + 8 * fq;
#pragma unroll
                            for (int bj = 0; bj < 2; ++bj) *(u32x4*)(qp + 32 * bj) = pack8(o[bj][0], o[bj][1]); }
                    } else if (row < 8256) { bf16_t* kp = kimg + ((size_t)(hm * 129 + (row >> 6)) * 8 + fq) * 512 + (row & 63) * 8;
#pragma unroll
                        for (int bj = 0; bj < 2; ++bj) *(u32x4*)(kp + bj * 4 * 512) = pack8(o[bj][0], o[bj][1]); }
                }
        } else if (pn < 28) {
#pragma unroll
            for (int ai = 0; ai < 2; ++ai)
#pragma unroll
                for (int m = 0; m < 4; ++m) { const int row = row0 + ai * HALF + m * 16; const float rs = rsv[ai][m];
                    if (row < 8256) {
#pragma unroll
                        for (int bj = 0; bj < 2; ++bj) { const int head = 2 * (pn - 24) + bj;
                            bf16_t* vp = vimg + ((size_t)(head * 129 + (row >> 6)) * 4 + wc) * 2048 + (row & 63) * 32 + 8 * fq;
                            *(u32x4*)vp = pack8(acc[ai][bj][m][0] * rs, acc[ai][bj][m][1] * rs); } } }
        } else {
            if (wc == 0 && fq < 2) {
                f32x4 dtb[2], ea[2];
#pragma unroll
                for (int n = 0; n < 2; ++n) { dtb[n] = *(const f32x4*)(dt_bias + 4 * n); const f32x4 al = *(const f32x4*)(a_log + 4 * n);
#pragma unroll
                    for (int j = 0; j < 4; ++j) ea[n][j] = __builtin_amdgcn_exp2f(1.4426950408889634f * al[j]); }
#pragma unroll
                for (int ai = 0; ai < 2; ++ai)
#pragma unroll
                    for (int m = 0; m < 4; ++m) { const int row = row0 + ai * HALF + m * 16; const float rs = rsv[ai][m];
                        if (row < 8256) {
#pragma unroll
                            for (int n = 0; n < 2; ++n)
#pragma unroll
                                for (int j = 0; j < 4; ++j) { const int hd = 4 * n + j; const float v = acc[ai][0][m][n][j] * rs; float r;
                                    if (fq == 0) { r = __builtin_amdgcn_rcpf(1.0f + __builtin_amdgcn_exp2f(-1.4426950408889634f * v)); if (row < 48) r = 0.f; beta[(size_t)hd * 8256 + row] = r; }
                                    else { const float y = v + dtb[n][j]; const float ey = __builtin_amdgcn_exp2f(1.4426950408889634f * y);
                                        const float sp = (y > 15.f) ? y : ((ey < 1e-4f) ? ey : 0.6931471805599453f * __builtin_amdgcn_logf(1.0f + ey));
                                        r = -ea[n][j] * sp; if (row < 48) r = 0.f; gdec[(size_t)hd * 8256 + row] = r; } } } }
            }
        }
    }
};

struct EpiOutProj {
    static constexpr bool PERM = true, AFTER_DRAIN = false, INIT = true; static constexpr int REP = 1;
    const float* x; bf16_t* h1b; float* ssq;
    __device__ __forceinline__ void init(f32x4 (&acc)[2][2][4][2], const Unit& u, int wr, int wc, int fr, int fq) const {
        asm volatile("" : "+v"(fr), "+v"(fq));
        const int row0 = u.pm * BM + wr * 64 + fr, col0 = u.pn * BM + wc * 32 + 8 * fq;
#pragma unroll
        for (int ai = 0; ai < 2; ++ai)
#pragma unroll
            for (int m = 0; m < 4; ++m) { const size_t off = (size_t)(row0 + ai * HALF + m * 16) * 2048 + col0;
#pragma unroll
                for (int bj = 0; bj < 2; ++bj)
#pragma unroll
                    for (int n = 0; n < 2; ++n) acc[ai][bj][m][n] = *(const f32x4*)(x + off + bj * HALF + 4 * n); }
    }
    __device__ __forceinline__ void operator()(const f32x4 (&acc)[2][2][4][2], const Unit& u, int wr, int wc, int fr, int fq) const {
        asm volatile("" : "+v"(fr), "+v"(fq));
        const int row0 = u.pm * BM + wr * 64 + fr, col0 = u.pn * BM + wc * 32 + 8 * fq;
        int l_; asm volatile("v_mbcnt_lo_u32_b32 %0, -1, 0\n\tv_mbcnt_hi_u32_b32 %0, -1, %0" : "=v"(l_));
        const int ix16 = (l_ ^ 16) << 2, ix32 = (l_ ^ 32) << 2;
#pragma unroll
        for (int ai = 0; ai < 2; ++ai)
#pragma unroll
            for (int m = 0; m < 4; ++m) { const int row = row0 + ai * HALF + m * 16; const size_t off = (size_t)row * 2048 + col0; float ss = 0.f;
#pragma unroll
                for (int bj = 0; bj < 2; ++bj) {
#pragma unroll
                    for (int n = 0; n < 2; ++n) { const f32x4 v = acc[ai][bj][m][n]; ss += (v[0] * v[0] + v[1] * v[1]) + (v[2] * v[2] + v[3] * v[3]); }
                    *(u32x4*)(h1b + off + bj * HALF) = pack8(acc[ai][bj][m][0], acc[ai][bj][m][1]); }
                ss += __builtin_bit_cast(float, __builtin_amdgcn_ds_bpermute(ix16, __builtin_bit_cast(int, ss))); ss += __builtin_bit_cast(float, __builtin_amdgcn_ds_bpermute(ix32, __builtin_bit_cast(int, ss)));
                if (fq == 0) ssq[(size_t)row * 32 + u.pn * 4 + wc] = ss; }
    }
};

struct EpiGateUp {
    static constexpr bool PERM = true, AFTER_DRAIN = false, INIT = false; static constexpr int REP = 1;
    const float* ssq; bf16_t* hid; const PG8_LAS float* rs2; int rs2_pm;
    __device__ __forceinline__ void operator()(const f32x4 (&acc)[2][2][4][2], const Unit& u, int wr, int wc, int fr, int fq) const {
        asm volatile("" : "+v"(fr), "+v"(fq));
        const int row0 = u.pm * BM + wr * 64 + fr, col0 = u.pn * HALF + wc * 32 + 8 * fq;
        float rsv[2][4];
        if (u.pm == rs2_pm) {
#pragma unroll
            for (int ai = 0; ai < 2; ++ai)
#pragma unroll
                for (int m = 0; m < 4; ++m) rsv[ai][m] = rs2[wr * 64 + fr + ai * HALF + m * 16];
        } else {
#pragma unroll
            for (int ai = 0; ai < 2; ++ai)
#pragma unroll
                for (int m = 0; m < 4; ++m) { const f32x4* sp = (const f32x4*)(ssq + (size_t)(row0 + ai * HALF + m * 16) * 32); f32x4 s4 = sp[0];
#pragma unroll
                    for (int i = 1; i < 8; ++i) s4 += sp[i];
                    rsv[ai][m] = __builtin_amdgcn_rsqf(((s4[0] + s4[1]) + (s4[2] + s4[3])) * (1.0f / 2048.0f) + 1e-6f); }
        }
#pragma unroll
        for (int ai = 0; ai < 2; ++ai)
#pragma unroll
            for (int m = 0; m < 4; ++m) { const int row = row0 + ai * HALF + m * 16; const float rs = rsv[ai][m];
                f32x4 hv[2];
#pragma unroll
                for (int n = 0; n < 2; ++n)
#pragma unroll
                    for (int j = 0; j < 4; ++j) { const float g = acc[ai][0][m][n][j] * rs, up = acc[ai][1][m][n][j] * rs; hv[n][j] = silu_f(g) * up; }
                *(u32x4*)(hid + (size_t)row * 5632 + col0) = pack8(hv[0], hv[1]); }
    }
};

struct EpiDown {
    static constexpr bool PERM = true, AFTER_DRAIN = false, INIT = true; static constexpr int REP = 1;
    const bf16_t* h1b; float* out;
    __device__ __forceinline__ void init(f32x4 (&acc)[2][2][4][2], const Unit& u, int wr, int wc, int fr, int fq) const {
        asm volatile("" : "+v"(fr), "+v"(fq));
        const int row0 = u.pm * BM + wr * 64 + fr, col0 = u.pn * BM + wc * 32 + 8 * fq;
#pragma unroll
        for (int ai = 0; ai < 2; ++ai)
#pragma unroll
            for (int m = 0; m < 4; ++m)
#pragma unroll
                for (int bj = 0; bj < 2; ++bj) { const u32x4 h4 = *(const u32x4*)(h1b + (size_t)(row0 + ai * HALF + m * 16) * 2048 + col0 + bj * HALF);
                    f32x4 r0, r1;
                    r0[0] = __uint_as_float(h4.x << 16); r0[1] = __uint_as_float(h4.x & 0xffff0000u); r0[2] = __uint_as_float(h4.y << 16); r0[3] = __uint_as_float(h4.y & 0xffff0000u);
                    r1[0] = __uint_as_float(h4.z << 16); r1[1] = __uint_as_float(h4.z & 0xffff0000u); r1[2] = __uint_as_float(h4.w << 16); r1[3] = __uint_as_float(h4.w & 0xffff0000u);
                    acc[ai][bj][m][0] = r0; acc[ai][bj][m][1] = r1; }
    }
    __device__ __forceinline__ void operator()(const f32x4 (&acc)[2][2][4][2], const Unit& u, int wr, int wc, int fr, int fq) const {
        asm volatile("" : "+v"(fr), "+v"(fq));
        const int row0 = u.pm * BM + wr * 64 + fr, col0 = u.pn * BM + wc * 32 + 8 * fq;
#pragma unroll
        for (int ai = 0; ai < 2; ++ai)
#pragma unroll
            for (int m = 0; m < 4; ++m) { const size_t off = (size_t)(row0 + ai * HALF + m * 16) * 2048 + col0;
#pragma unroll
                for (int bj = 0; bj < 2; ++bj) { *(f32x4*)(out + off + bj * HALF) = acc[ai][bj][m][0]; *(f32x4*)(out + off + bj * HALF + 4) = acc[ai][bj][m][1]; } }
    }
};

template <class Epi, class Sched, bool ALIGN_EPI = false, bool SP2 = false>
__device__ __forceinline__ void gemm_phase(PG8_LAS unsigned char* lds, const Gemm g, const Sched& S, const Epi& E, int tid_in) {
    int tid = tid_in; asm volatile("" : "+v"(tid)); const int wid = __builtin_amdgcn_readfirstlane(tid >> 6), lane = tid & 63, wr = wid >> 2, wc = wid & 3, fr = lane & 15, fq = lane >> 4;
    const int K = g.K, nt = K / BK;
    unsigned voffA[2], voffB[2];
#pragma unroll
    for (int i = 0; i < 2; ++i) { int R, C; stage_rc(tid * 16 + i * 8192, R, C); const int Rb = Epi::PERM ? ((R & ~31) + perm32(R & 31)) : R;
        voffA[i] = (unsigned)(R * K + C) * 2u; voffB[i] = (unsigned)(Rb * K + C) * 2u; }
    const size_t kstep = (size_t)(BK * 2);
    const size_t hstep = (size_t)HALF * K * 2;
    const size_t tstep = 2 * hstep;
    const unsigned ldsw = (unsigned)wid * 1024u;
    const int aoff = lds_byte(wr * 64 + fr, fq * 8), boff = lds_byte(wc * 32 + fr, fq * 8);
#define PG8_SA(b, h) (((b) * 2 + (h)) * HTB)
#define PG8_SB(b, h) ((4 + (b) * 2 + (h)) * HTB)
#define PG8_STAGE(bufoff, gbase, voff) do { _Pragma("unroll") for (int _i = 0; _i < 2; ++_i) \
        __builtin_amdgcn_global_load_lds((const unsigned*)((const char*)(gbase) + (voff)[_i]), (PG8_LAS unsigned*)(lds + (bufoff) + ldsw + _i * 8192), 16, 0, 0); } while (0)
#define PG8_LDA(dst, b, h) do { _Pragma("unroll") for (int m = 0; m < 4; ++m) _Pragma("unroll") for (int k = 0; k < 2; ++k) dst[m][k] = *(const PG8_LAS bf16x8*)(lds + PG8_SA(b, h) + aoff + m * 2048 + k * 1024); } while (0)
#define PG8_LDB(dst, b, h) do { _Pragma("unroll") for (int n = 0; n < 2; ++n) _Pragma("unroll") for (int k = 0; k < 2; ++k) dst[n][k] = *(const PG8_LAS bf16x8*)(lds + PG8_SB(b, h) + boff + n * 2048 + k * 1024); } while (0)
#define PG8_MMA(ai, bj, At, Bt) do { __builtin_amdgcn_s_setprio(1); _Pragma("unroll") for (int m = 0; m < 4; ++m) _Pragma("unroll") for (int n = 0; n < 2; ++n) _Pragma("unroll") for (int k = 0; k < 2; ++k) \
        acc[ai][bj][m][n] = __builtin_amdgcn_mfma_f32_16x16x32_bf16(Bt[n][k], At[m][k], acc[ai][bj][m][n], 0, 0, 0); __builtin_amdgcn_s_setprio(0); } while (0)
#define PG8_WAIT_V(n) asm volatile("s_waitcnt vmcnt(" #n ")" ::: "memory")
#define PG8_WAIT_L(n) asm volatile("s_waitcnt lgkmcnt(" #n ")" ::: "memory")
#define PG8_BAR __builtin_amdgcn_s_barrier()
#define PG8_SCHED __builtin_amdgcn_sched_barrier(0)
    Unit cur, nxt; int ui = 0;
    if (!S.next(0, cur)) return;
    f32x4 acc[2][2][4][2];
    if constexpr (Epi::INIT) E.init(acc, cur, wr, wc, fr, fq);
    else {
#pragma unroll
    for (int a = 0; a < 2; ++a)
#pragma unroll
        for (int b = 0; b < 2; ++b)
#pragma unroll
            for (int m = 0; m < 4; ++m)
#pragma unroll
                for (int n = 0; n < 2; ++n) acc[a][b][m][n] = (f32x4){0.f, 0.f, 0.f, 0.f};
    }
    bf16x8 At[4][2], B0[2][2], B1[2][2];
    const char* cA = (const char*)g.A + (size_t)cur.pm * tstep; const char* cB = (const char*)g.Bt + (size_t)cur.pn * tstep;
    S.a_ready(cur);
    if constexpr (SP2) {
        PG8_STAGE(PG8_SB(0, 0), cB, voffB); PG8_STAGE(PG8_SB(0, 1), cB + hstep, voffB); PG8_STAGE(PG8_SA(0, 0), cA, voffA); PG8_STAGE(PG8_SA(0, 1), cA + hstep, voffA);
        if (wr == 1) PG8_BAR;
        PG8_WAIT_V(2); PG8_BAR;
        PG8_STAGE(PG8_SB(1, 0), cB + kstep, voffB); PG8_STAGE(PG8_SA(1, 0), cA + kstep, voffA); PG8_STAGE(PG8_SB(1, 1), cB + hstep + kstep, voffB);
        PG8_WAIT_V(6); PG8_BAR;
    } else {
        PG8_STAGE(PG8_SB(0, 0), cB, voffB); PG8_STAGE(PG8_SA(0, 0), cA, voffA); PG8_STAGE(PG8_SB(0, 1), cB + hstep, voffB); PG8_STAGE(PG8_SA(0, 1), cA + hstep, voffA);
        if (wr == 1) PG8_BAR;
        PG8_WAIT_V(4); PG8_BAR;
        PG8_STAGE(PG8_SB(1, 0), cB + kstep, voffB); PG8_STAGE(PG8_SA(1, 0), cA + kstep, voffA); PG8_STAGE(PG8_SB(1, 1), cB + hstep + kstep, voffB);
        PG8_WAIT_V(6); PG8_BAR;
    }
    for (;;) {
        const bool has_next = S.next(ui + 1, nxt);
        const char* nA = has_next ? (const char*)g.A + (size_t)nxt.pm * tstep : cA; const char* nB = has_next ? (const char*)g.Bt + (size_t)nxt.pn * tstep : cB;
        for (int t = 0; t < nt; t += 2) {
            const bool last = (t == nt - 2);
            const char* a1 = cA + (size_t)(t + 1) * kstep;
            const char* a2 = last ? nA : cA + (size_t)(t + 2) * kstep; const char* b2 = last ? nB : cB + (size_t)(t + 2) * kstep;
            const char* a3 = a2 + kstep; const char* b3 = b2 + kstep;
            if (last && has_next) S.a_ready(nxt);
            if constexpr (SP2) {
            PG8_LDB(B0, 0, 0); PG8_LDB(B1, 0, 1); PG8_SCHED; PG8_LDA(At, 0, 0); PG8_STAGE(PG8_SA(1, 1), a1 + hstep, voffA);
            PG8_WAIT_V(8); PG8_WAIT_L(0); PG8_BAR; PG8_MMA(0, 0, At, B0); PG8_MMA(0, 1, At, B1); PG8_BAR; PG8_SCHED;
            PG8_LDA(At, 0, 1); PG8_STAGE(PG8_SB(0, 0), b2, voffB); PG8_STAGE(PG8_SB(0, 1), b2 + hstep, voffB); PG8_STAGE(PG8_SA(0, 0), a2, voffA);
            PG8_WAIT_V(8); PG8_WAIT_L(0); PG8_BAR; PG8_MMA(1, 0, At, B0); PG8_MMA(1, 1, At, B1); PG8_BAR; PG8_SCHED;
            PG8_LDB(B0, 1, 0); PG8_LDB(B1, 1, 1); PG8_SCHED; PG8_LDA(At, 1, 0); PG8_STAGE(PG8_SA(0, 1), a2 + hstep, voffA);
            PG8_WAIT_V(8); PG8_WAIT_L(0); PG8_BAR; PG8_MMA(0, 0, At, B0); PG8_MMA(0, 1, At, B1); PG8_BAR; PG8_SCHED;
            PG8_LDA(At, 1, 1); PG8_STAGE(PG8_SB(1, 0), b3, voffB); PG8_STAGE(PG8_SB(1, 1), b3 + hstep, voffB); PG8_STAGE(PG8_SA(1, 0), a3, voffA);
            PG8_WAIT_V(8); PG8_WAIT_L(0); PG8_BAR; PG8_MMA(1, 0, At, B0); PG8_MMA(1, 1, At, B1); PG8_BAR; PG8_SCHED;
            } else {
            PG8_LDB(B0, 0, 0); PG8_SCHED; PG8_LDA(At, 0, 0); PG8_STAGE(PG8_SA(1, 1), a1 + hstep, voffA);
            PG8_WAIT_L(8); PG8_BAR; PG8_WAIT_L(0); PG8_MMA(0, 0, At, B0); PG8_BAR; PG8_SCHED;
            PG8_LDB(B1, 0, 1); PG8_STAGE(PG8_SB(0, 0), b2, voffB);
            PG8_BAR; PG8_WAIT_L(0); PG8_MMA(0, 1, At, B1); PG8_BAR;
            PG8_LDA(At, 0, 1); PG8_STAGE(PG8_SA(0, 0), a2, voffA);
            PG8_BAR; PG8_WAIT_L(0); PG8_MMA(1, 0, At, B0); PG8_BAR; PG8_SCHED;
            PG8_STAGE(PG8_SB(0, 1), b2 + hstep, voffB);
            PG8_WAIT_V(6); PG8_BAR; PG8_MMA(1, 1, At, B1); PG8_BAR;
            PG8_LDB(B0, 1, 0); PG8_SCHED; PG8_LDA(At, 1, 0); PG8_STAGE(PG8_SA(0, 1), a2 + hstep, voffA);
            PG8_WAIT_L(8); PG8_BAR; PG8_WAIT_L(0); PG8_MMA(0, 0, At, B0); PG8_BAR; PG8_SCHED;
            PG8_LDB(B1, 1, 1); PG8_STAGE(PG8_SB(1, 0), b3, voffB);
            PG8_BAR; PG8_WAIT_L(0); PG8_MMA(0, 1, At, B1); PG8_BAR;
            PG8_LDA(At, 1, 1); PG8_STAGE(PG8_SA(1, 0), a3, voffA);
            PG8_BAR; PG8_WAIT_L(0); PG8_MMA(1, 0, At, B0); PG8_BAR; PG8_SCHED;
            PG8_STAGE(PG8_SB(1, 1), b3 + hstep, voffB);
            PG8_WAIT_V(6); PG8_BAR; PG8_MMA(1, 1, At, B1); PG8_BAR;
            }
        }
        if constexpr (ALIGN_EPI) { if (wr == 0) PG8_BAR; }
        if constexpr (!Epi::AFTER_DRAIN) { for (int rp_ = 0; rp_ < PG8_EPI_REP * Epi::REP; ++rp_) E(acc, cur, wr, wc, fr, fq); S.done(cur); }
        if (!has_next) break;
        if constexpr (Epi::INIT) E.init(acc, nxt, wr, wc, fr, fq);
        else {
#pragma unroll
        for (int a = 0; a < 2; ++a)
#pragma unroll
            for (int b = 0; b < 2; ++b)
#pragma unroll
                for (int m = 0; m < 4; ++m)
#pragma unroll
                    for (int n = 0; n < 2; ++n) acc[a][b][m][n] = (f32x4){0.f, 0.f, 0.f, 0.f};
        }
        cur = nxt; cA = nA; cB = nB; ++ui;
        if constexpr (ALIGN_EPI) { if (wr == 1) PG8_BAR; }
    }
    PG8_WAIT_V(0);
    if constexpr (!ALIGN_EPI) { if (wr == 0) PG8_BAR; }
    PG8_BAR;
    if constexpr (Epi::AFTER_DRAIN) { E.fused(acc, cur, wr, wc, fr, fq, lds, wid, lane); S.done(cur); }
#undef PG8_SA
#undef PG8_SB
#undef PG8_STAGE
#undef PG8_LDA
#undef PG8_LDB
#undef PG8_MMA
#undef PG8_WAIT_V
#undef PG8_WAIT_L
#undef PG8_BAR
#undef PG8_SCHED
}
}
#define GAS __attribute__((address_space(1)))
#define LAS __attribute__((address_space(3)))
typedef unsigned short bf16;
typedef unsigned v4u __attribute__((ext_vector_type(4)));
typedef float f32x4 __attribute__((ext_vector_type(4)));
typedef short bf16x8 __attribute__((ext_vector_type(8)));
typedef GAS unsigned gu32;
typedef GAS unsigned long long gu64;
#define RLX_AGENT __ATOMIC_RELAXED, __HIP_MEMORY_SCOPE_AGENT
#define LDS_WAIT() asm volatile("s_waitcnt lgkmcnt(0)" ::: "memory")
#define VM_WAIT() asm volatile("s_waitcnt vmcnt(0)" ::: "memory")
__device__ __forceinline__ unsigned long long rt() { return __builtin_amdgcn_s_memrealtime(); }
__device__ __forceinline__ unsigned f2bf(float f) { unsigned u = __builtin_bit_cast(unsigned, f); return (u + 0x7fffu + ((u >> 16) & 1u)) >> 16; }
typedef float f32x2_cv __attribute__((ext_vector_type(2))); typedef __bf16 bf16x2_cv __attribute__((ext_vector_type(2)));
__device__ __forceinline__ unsigned pk2(float lo, float hi) { const f32x2_cv v = {lo, hi}; return __builtin_bit_cast(unsigned, __builtin_convertvector(v, bf16x2_cv)); }

#define XB_TMO      128
#define XB_XCNT(j)  (256  + 64 * (j))
#define XB_XSUB(j)  (1280 + 64 * (j))
#define XB_XGEN(j)  (2304 + 64 * (j))
#define XB_TOP      3328
#define XB_TOPGEN   3392
#define XCD_BAR_WORDS 3456
#define XB_SPIN_CAP (1u << 18)

__device__ __forceinline__ unsigned xb_ld(unsigned* p)              { return __hip_atomic_load(p, __ATOMIC_RELAXED, __HIP_MEMORY_SCOPE_AGENT); }
__device__ __forceinline__ unsigned xb_add(unsigned* p, unsigned v) { return __hip_atomic_fetch_add(p, v, __ATOMIC_RELAXED, __HIP_MEMORY_SCOPE_AGENT); }
__device__ __forceinline__ unsigned xb_xcc_id() { return (unsigned)__builtin_amdgcn_s_getreg((3 << 11) | 20) & 0xFu; }
#define XB_SPIN(cond, bar) do { unsigned _sp = 0; while (cond) { __builtin_amdgcn_s_sleep(1); \
    if ((++_sp & 255u) == 0u) { if (xb_ld(&(bar)[XB_TMO])) break; if (_sp > XB_SPIN_CAP) { atomicAdd(&(bar)[XB_TMO], 1u); break; } } } } while (0)

struct XcdBarrier {
    unsigned* bar; unsigned x;
    volatile LAS unsigned* st;
};

__device__ __forceinline__ XcdBarrier xcd_barrier_post(unsigned* bar, volatile LAS unsigned* st) {
    XcdBarrier b; b.bar = bar; b.x = xb_xcc_id(); b.st = st;
    if (threadIdx.x == 0) (void)xb_add(&bar[XB_XCNT(b.x)], 1u);
    return b;
}
__device__ __forceinline__ void xcd_barrier_complete(unsigned* bar, unsigned x, unsigned& nloc, unsigned& nx) {
    const unsigned G = gridDim.x * gridDim.y * gridDim.z;
    unsigned sum, cnt, mine, sp = 0u;
    for (;;) {
        sum = 0u; cnt = 0u; mine = 0u;
#pragma unroll
        for (unsigned j = 0; j < 16; ++j) { const unsigned c = xb_ld(&bar[XB_XCNT(j)]); sum += c; cnt += (c > 0u) ? 1u : 0u; mine = (j == x) ? c : mine; }
        if (sum == G) break;
        __builtin_amdgcn_s_sleep(1);
        if ((++sp & 255u) == 0u) { if (xb_ld(&bar[XB_TMO])) break; if (sp > XB_SPIN_CAP) { atomicAdd(&bar[XB_TMO], 1u); break; } }
    }
    nloc = mine > 0u ? mine : 1u; nx = cnt > 0u ? cnt : 1u;
}

__device__ __forceinline__ void xcd_barrier(const XcdBarrier& b) {
    asm volatile("s_waitcnt vmcnt(0)" ::: "memory");
    __syncthreads();
    if (threadIdx.x == 0) {
        unsigned* bar = b.bar;
        __builtin_amdgcn_s_waitcnt(0);
        unsigned nloc = b.st[0], nx = b.st[1];
        if (nloc == 0u) { xcd_barrier_complete(bar, b.x, nloc, nx); b.st[0] = nloc; b.st[1] = nx; }
        const unsigned old = xb_add(&bar[XB_XSUB(b.x)], 1u);
        const unsigned gen = old / nloc;
        if (old + 1u == (gen + 1u) * nloc) {
            __builtin_amdgcn_fence(__ATOMIC_RELEASE, "agent");
            asm volatile("s_waitcnt vmcnt(0)" ::: "memory");
            const unsigned og = xb_add(&bar[XB_TOP], 1u);
            const unsigned tg = og / nx;
            if (og + 1u == (tg + 1u) * nx) xb_add(&bar[XB_TOPGEN], 1u);
            else XB_SPIN(xb_ld(&bar[XB_TOPGEN]) == tg, bar);
            __builtin_amdgcn_fence(__ATOMIC_ACQUIRE, "agent");
            xb_add(&bar[XB_XGEN(b.x)], 1u);
            asm volatile("s_waitcnt vmcnt(0)" ::: "memory");
        } else {
            XB_SPIN(xb_ld(&bar[XB_XGEN(b.x)]) == gen, bar);
            __builtin_amdgcn_fence(__ATOMIC_ACQUIRE, "agent");
            asm volatile("s_waitcnt vmcnt(0)" ::: "memory");
        }
    }
    __syncthreads();
}


namespace cfg {
constexpr int DMODEL = 2048, SEQ = 8192;
constexpr int LP = 8256;
constexpr int MP = 8448;
constexpr int NCH = 129;
constexpr int NPROJ = 7424;
constexpr int WIN_N = 7184;
constexpr int DFF = 5632;
constexpr size_t MiB = 1u << 20;
constexpr size_t WS_CTL = 0, CTL_ZERO_BYTES = 65536;
constexpr size_t WS_WOUT = 1 * MiB;
constexpr size_t WS_WGU = WS_WOUT + (size_t)2048 * 2048 * 2;
constexpr size_t WS_WDN = WS_WGU + (size_t)11264 * 2048 * 2;
constexpr size_t R1 = WS_WDN + (size_t)2048 * 5632 * 2;
constexpr size_t WS_WIN = R1;
constexpr size_t WS_APAD = WS_WIN + (size_t)NPROJ * 2048 * 2;
constexpr size_t WS_MIX = R1;
constexpr size_t WS_H1B = R1 + (size_t)8192 * 2048 * 2;
constexpr size_t WS_MG = WS_H1B;
constexpr size_t WS_CG = WS_MG + (size_t)8 * 15 * 32768;
constexpr size_t WS_SG = WS_CG + (size_t)8 * 15 * 65536;
constexpr size_t R2 = R1 + (size_t)2 * 8192 * 2048 * 2;
static_assert(WS_SG + (size_t)8 * 16 * 65536 <= R2, "group tables fit the H1B region");
static_assert(WS_APAD + (size_t)MP * 2048 * 2 <= R2, "R1");
constexpr size_t WS_GRAW = R2;
constexpr size_t WS_HID = R2;
constexpr size_t R3 = R2 + (size_t)MP * 4096 * 2;
constexpr size_t WS_Q = R3;
constexpr size_t WS_K = WS_Q + (size_t)16 * 8192 * 64 * 2;
constexpr size_t WS_V = WS_K + (size_t)16 * 129 * 4096 * 2;
constexpr size_t WS_RSTD = WS_V + (size_t)8 * 129 * 8192 * 2;
constexpr size_t WS_BETA = WS_RSTD + (size_t)MP * 4;
constexpr size_t WS_GDEC = WS_BETA + (size_t)8 * LP * 4;
constexpr size_t WS_SSQ = WS_GDEC + (size_t)8 * LP * 4;
constexpr size_t R4 = WS_SSQ + (size_t)8192 * 32 * 4;
static_assert(WS_HID + (size_t)8192 * DFF * 2 <= WS_RSTD, "hidden overlay must stay below the small f32 tables");
constexpr size_t GI_WQ = 0, GI_ATT = 32768, GI_KDT = 40960, GI_UT = 57344, GI_EG = 90112, GI_BYTES = 90368;
constexpr size_t WS_GDNP = R4;
constexpr size_t WS_END = WS_GDNP + (size_t)8 * NCH * GI_BYTES;
static_assert(WS_WGU % 256 == 0 && WS_WDN % 256 == 0 && R1 % 256 == 0 && WS_APAD % 256 == 0 && R2 % 256 == 0 && R3 % 256 == 0 && WS_K % 256 == 0 && WS_V % 256 == 0 && WS_RSTD % 256 == 0 && WS_BETA % 256 == 0 && WS_GDEC % 256 == 0 && WS_SSQ % 256 == 0 && R4 % 256 == 0, "alignment");
#ifndef PROBE_DUP
#define PROBE_DUP -1
#endif
constexpr int CW_BAR = 4096;
constexpr int CW_ATTQ = 1024;
constexpr int CW_GFLAG = 2048;
constexpr int CW_P2C = 2560;
constexpr int CW_CMP = 3072;
constexpr int P0_MASK = 1 | 4, P1_IDLE_MASK = 2 | 4, P5_IDLE_MASK = 8, GU_SPLIT = 10;
constexpr int LDS_BYTES = 163840;
constexpr int MISC_OFF = LDS_BYTES - 256;
}
#define CAS __attribute__((address_space(4)))
using pg8::bf16_t; using pg8::bf16x8; using pg8::u32x4;
typedef float f32x16 __attribute__((ext_vector_type(16)));
typedef short s16x4 __attribute__((ext_vector_type(4)));
typedef unsigned u32x2 __attribute__((ext_vector_type(2)));

struct Params {
    const float *x, *meta, *attn_norm, *w_in, *conv_w, *a_log, *dt_bias, *gdn_norm, *q_norm, *k_norm, *lq1, *lk1, *lq2, *lk2, *diff_norm, *w_out, *ffn_norm, *w_gu, *w_dn;
    float* out; unsigned char* ws;
};

__device__ __forceinline__ float wave_sum(float v) {
#pragma unroll
    for (int o = 1; o < 64; o <<= 1) v += __shfl_xor(v, o);
    return v;
}

__device__ __forceinline__ int win_src(int a, int& nvalid) {
    const int pn = a >> 3, b8 = a & 7; nvalid = 32;
    if (pn < 16) return 256 * pn + 32 * b8;
    if (pn < 24) return 4112 + 256 * (pn - 16) + 64 * (b8 & 3) + 32 * (b8 >> 2);
    if (pn < 28) return 6160 + 256 * (pn - 24) + 32 * b8;
    if (b8 == 0) { nvalid = 16; return 4096; }
    nvalid = 0; return 0;
}
__device__ __forceinline__ void p0_transpose_item(const float* W, int Nsrc, int K, bf16* WT, int k0, int dstrow0, int srccol, int nvalid, const float* gain, LAS float* scr, int lane) {
    const int c = lane & 31;
    float vv[32];
#pragma unroll
    for (int i = 0; i < 32; ++i) { const int kk = 2 * i + (lane >> 5); vv[i] = (c < nvalid) ? __builtin_nontemporal_load(W + (size_t)(k0 + kk) * Nsrc + srccol + c) : 0.f; }
    if (gain) {
#pragma unroll
        for (int i = 0; i < 32; ++i) vv[i] *= gain[k0 + 2 * i + (lane >> 5)]; }
#pragma unroll
    for (int i = 0; i < 32; ++i) scr[(2 * i + (lane >> 5)) * 33 + c] = vv[i];
    LDS_WAIT(); asm volatile("" ::: "memory");
    const int c8 = lane & 7;
#pragma unroll
    for (int j = 0; j < 4; ++j) { const int n = (lane >> 3) + 8 * j; const LAS float* s = scr + (8 * c8) * 33 + n;
        v4u o; o.x = pk2(s[0 * 33], s[1 * 33]); o.y = pk2(s[2 * 33], s[3 * 33]); o.z = pk2(s[4 * 33], s[5 * 33]); o.w = pk2(s[6 * 33], s[7 * 33]);
        *(GAS v4u*)(WT + (size_t)(dstrow0 + n) * K + k0 + 8 * c8) = o; }
    LDS_WAIT(); asm volatile("" ::: "memory");
}
__device__ __forceinline__ void p0_convert(const Params& P, LAS unsigned char* lds, int gw, int NGW, int wave, int lane, int mask, int gu_kb0 = 0, int gu_kb1 = 32) {
    using namespace cfg;
    LAS float* scr = (LAS float*)(lds + wave * 16384);
    bf16* Wt_in = (bf16*)(P.ws + WS_WIN); bf16* Wt_out = (bf16*)(P.ws + WS_WOUT); bf16* Wt_gu = (bf16*)(P.ws + WS_WGU); bf16* Wt_dn = (bf16*)(P.ws + WS_WDN);
    const int I_IN = (mask & 1) ? 32 * 232 : 0, I_OUT = (mask & 2) ? 32 * 64 : 0, I_GU = (mask & 4) ? (gu_kb1 - gu_kb0) * 352 : 0, I_DN = (mask & 8) ? 88 * 64 : 0, NITEMS = I_IN + I_OUT + I_GU + I_DN;
    for (int it = gw; it < NITEMS; it += NGW) {
        int r = it;
        if (r < I_IN) { const int kb = r / 232, a = r % 232; int nv; const int src = win_src(a, nv); p0_transpose_item(P.w_in, WIN_N, 2048, Wt_in, 64 * kb, 32 * a, src, nv, P.attn_norm, scr, lane); continue; } r -= I_IN;
        if (r < I_OUT) { const int kb = r / 64, a = r % 64; p0_transpose_item(P.w_out, 2048, 2048, Wt_out, 64 * kb, 32 * a, 32 * a, 32, nullptr, scr, lane); continue; } r -= I_OUT;
        if (r < I_GU) { const int kb = gu_kb0 + r / 352, a = r % 352, pn = a >> 3, b8 = a & 7; const int src = (b8 < 4) ? 128 * pn + 32 * b8 : DFF + 128 * pn + 32 * (b8 - 4);
            p0_transpose_item(P.w_gu, 2 * DFF, 2048, Wt_gu, 64 * kb, 32 * a, src, 32, P.ffn_norm, scr, lane); continue; } r -= I_GU;
        { const int kb = r / 64, a = r % 64; p0_transpose_item(P.w_dn, 2048, DFF, Wt_dn, 64 * kb, 32 * a, 32 * a, 32, nullptr, scr, lane); }
    }
}
__device__ __forceinline__ void p0_prep(const Params& P, LAS unsigned char* lds, int vcu, int G, int wave, int lane) {
    using namespace cfg;
    const int gw = vcu * 8 + wave, NGW = G * 8;
    p0_convert(P, lds, gw, NGW, wave, lane, P0_MASK, 0, GU_SPLIT);
    bf16* Apad = (bf16*)(P.ws + WS_APAD); float* rstd = (float*)(P.ws + WS_RSTD);
    for (int r = gw; r < MP; r += NGW) {
        GAS unsigned long long* o8 = (GAS unsigned long long*)(Apad + (size_t)r * 2048) + lane;
        const float* src = (r >= 64 && r < LP) ? P.x + (size_t)(r - 64) * 2048 : ((r >= 48 && r < 64) ? P.meta + (size_t)(r - 48) * 2048 : nullptr);
        if (!src) {
#pragma unroll
            for (int j = 0; j < 8; ++j) o8[64 * j] = 0ull;
            if (lane == 0) rstd[r] = 0.f;
        } else {
            const GAS f32x4* xr = (const GAS f32x4*)src + lane; f32x4 v[8]; float s = 0.f;
#pragma unroll
            for (int j = 0; j < 8; ++j) { v[j] = __builtin_nontemporal_load(xr + 64 * j); s += (v[j].x * v[j].x + v[j].y * v[j].y) + (v[j].z * v[j].z + v[j].w * v[j].w); }
            const float rs = 1.0f / sqrtf(wave_sum(s) * (1.0f / 2048.0f) + 1e-6f);
#pragma unroll
            for (int j = 0; j < 8; ++j) o8[64 * j] = (unsigned long long)pk2(v[j].x, v[j].y) | ((unsigned long long)pk2(v[j].z, v[j].w) << 32);
            if (lane == 0) rstd[r] = rs;
        }
    }
}

__device__ __forceinline__ int kperm32(int a) { return 8 * ((a >> 2) & 3) + 4 * (a >> 4) + (a & 3); }
__device__ __forceinline__ int kperm(int a) { return (a & ~31) + kperm32(a & 31); }
__device__ __forceinline__ unsigned short f2bf_s(float f) { return (unsigned short)pk2(f, 0.f); }
__device__ __forceinline__ f32x4 mfma16(bf16x8 a, bf16x8 b, f32x4 c) { return __builtin_amdgcn_mfma_f32_16x16x32_bf16(a, b, c, 0, 0, 0); }

#define GDN_LOAD_RAW(raw_, h_, n_, tid_) do { const int c0_ = 8 * ((tid_) & 15); \
        _Pragma("unroll") for (int X_ = 0; X_ < 3; ++X_) _Pragma("unroll") for (int ps_ = 0; ps_ < 2; ++ps_) _Pragma("unroll") for (int j_ = 0; j_ < 4; ++j_) { const int Rj_ = 64 * (n_) + 32 * ps_ + ((tid_) >> 4) - 3 + j_; \
            raw_[X_][ps_][j_] = (Rj_ >= 0) ? __builtin_nontemporal_load((const u32x4*)((const bf16_t*)(P.ws + cfg::WS_GRAW) + (size_t)Rj_ * 4096 + X_ * 1024 + (h_) * 128 + c0_)) : (u32x4){0u, 0u, 0u, 0u}; } } while (0)
#define GDN_LOAD_GB(gb_, h_, n_, tid_) do { const size_t o_ = (size_t)(h_) * cfg::LP + 64 * (n_) + ((tid_) & 63); gb_[0] = ((const float*)(P.ws + cfg::WS_GDEC))[o_]; gb_[1] = ((const float*)(P.ws + cfg::WS_BETA))[o_]; } while (0)
__device__ __forceinline__ void gdn_prep_item(const Params& P, int h, int n, u32x4 (&raw)[3][2][4], float (&gb)[2], int hn, int nn, bool has_next, LAS unsigned char* lds, int tid, int wave, int lane) {
    using namespace cfg;
    asm volatile("" : "+v"(tid)); lane = tid & 63;
    LAS bf16_t* qs = (LAS bf16_t*)(lds + 0);
    LAS bf16_t* ks = (LAS bf16_t*)(lds + 17408);
    LAS bf16_t* kb = (LAS bf16_t*)(lds + 34816);
    LAS bf16_t* kbgT = (LAS bf16_t*)(lds + 52224);
    LAS bf16_t* vbT = (LAS bf16_t*)(lds + 70656);
    LAS bf16_t* kdtI = (LAS bf16_t*)(lds + 89088);
    LAS bf16_t* qgI = (LAS bf16_t*)(lds + 105472);
    LAS float* Lm = (LAS float*)(lds + 121856);
    LAS bf16_t* attI = (LAS bf16_t*)(lds + 139264);
    LAS float* gcs = (LAS float*)(lds + 147456);
    LAS bf16_t* Tb = (LAS bf16_t*)(lds + 0);
    LAS float* UTI = (LAS float*)(lds + 17408);
    LAS bf16_t* WI = (LAS bf16_t*)(lds + 89088);
    const bf16_t* graw = (const bf16_t*)(P.ws + WS_GRAW);
    unsigned char* item = P.ws + WS_GDNP + (size_t)(h * NCH + n) * GI_BYTES;

    if (tid < 64) { float g = gb[0]; const float b = gb[1];
#pragma unroll
        for (int o = 1; o < 64; o <<= 1) { const float t = __shfl_up(g, o); if (lane >= o) g += t; }
        gcs[tid] = g; gcs[64 + tid] = b; }
    __syncthreads();
    const float gl = gcs[63];
    {
        const int cg = tid & 15, c0 = 8 * cg;
#pragma unroll
        for (int X = 0; X < 3; ++X) {
            const float* cw = P.conv_w + X * 1024 + h * 128 + c0; f32x4 w[4][2];
#pragma unroll
            for (int j = 0; j < 4; ++j) { w[j][0] = *(const f32x4*)(cw + (size_t)j * 3072); w[j][1] = *(const f32x4*)(cw + (size_t)j * 3072 + 4); }
#pragma unroll
            for (int pass = 0; pass < 2; ++pass) {
                const int rl = 32 * pass + (tid >> 4);
                float y[8];
#pragma unroll
                for (int i = 0; i < 8; ++i) y[i] = 0.f;
#pragma unroll
                for (int j = 0; j < 4; ++j) {
#pragma unroll
                    for (int i = 0; i < 4; ++i) { const unsigned wd = raw[X][pass][j][i]; y[2 * i] += __uint_as_float(wd << 16) * w[j][i >> 1][(2 * i) & 3]; y[2 * i + 1] += __uint_as_float(wd & 0xffff0000u) * w[j][i >> 1][(2 * i + 1) & 3]; } }
                float ss = 0.f;
#pragma unroll
                for (int i = 0; i < 8; ++i) { y[i] = pg8::silu_f(y[i]); ss += y[i] * y[i]; }
                const float gc = gcs[rl], bt = gcs[64 + rl];
                if (X < 2) { ss += __shfl_xor(ss, 1); ss += __shfl_xor(ss, 2); ss += __shfl_xor(ss, 4); ss += __shfl_xor(ss, 8);
                    const float rn = __builtin_amdgcn_rsqf(ss + 1e-6f) * (X == 0 ? 0.08838834764831845f : 1.0f);
#pragma unroll
                    for (int i = 0; i < 8; ++i) y[i] *= rn; }
                if (X == 0) {
                    u32x4 pk; pk.x = pk2(y[0], y[1]); pk.y = pk2(y[2], y[3]); pk.z = pk2(y[4], y[5]); pk.w = pk2(y[6], y[7]);
                    *(LAS u32x4*)(qs + rl * 136 + c0) = pk;
                    const float e = __expf(gc);
                    u32x2 a, b; a.x = pk2(y[0] * e, y[1] * e); a.y = pk2(y[2] * e, y[3] * e); b.x = pk2(y[4] * e, y[5] * e); b.y = pk2(y[6] * e, y[7] * e);
                    *(LAS u32x2*)(qgI + rl * 128 + kperm(c0)) = a; *(LAS u32x2*)(qgI + rl * 128 + kperm(c0 + 4)) = b;
                } else if (X == 1) {
                    u32x4 pk; pk.x = pk2(y[0], y[1]); pk.y = pk2(y[2], y[3]); pk.z = pk2(y[4], y[5]); pk.w = pk2(y[6], y[7]);
                    *(LAS u32x4*)(ks + rl * 136 + c0) = pk;
                    u32x4 pb; pb.x = pk2(y[0] * bt, y[1] * bt); pb.y = pk2(y[2] * bt, y[3] * bt); pb.z = pk2(y[4] * bt, y[5] * bt); pb.w = pk2(y[6] * bt, y[7] * bt);
                    *(LAS u32x4*)(kb + rl * 136 + c0) = pb;
                    const float eg = bt * __expf(gc), ed = __expf(gl - gc); const int prl = kperm(rl);
                    const int swz_rl = (((rl >> 3) ^ (cg & 7)) << 3) | (rl & 7), swz_prl = (((prl >> 3) ^ (cg & 7)) << 3) | (prl & 7);
#pragma unroll
                    for (int i = 0; i < 8; ++i) { kbgT[(c0 + i) * 72 + swz_rl] = f2bf_s(y[i] * eg); kdtI[(c0 + i) * 64 + swz_prl] = f2bf_s(y[i] * ed); }
                } else {
                    const int swz_rl = (((rl >> 3) ^ (cg & 7)) << 3) | (rl & 7);
#pragma unroll
                    for (int i = 0; i < 8; ++i) vbT[(c0 + i) * 72 + swz_rl] = f2bf_s(y[i] * bt);
                }
            }
        }
    }
    __syncthreads();
    {
        const int mt = wave & 3, fr = lane & 15, g = lane >> 4;
        bf16x8 ak[4], aq[4];
#pragma unroll
        for (int s = 0; s < 4; ++s) { ak[s] = *(const LAS bf16x8*)(kb + (16 * mt + fr) * 136 + 32 * s + 8 * g); aq[s] = *(const LAS bf16x8*)(qs + (16 * mt + fr) * 136 + 32 * s + 8 * g); }
#pragma unroll
        for (int t2 = 0; t2 < 2; ++t2) { const int nt = 2 * (wave >> 2) + t2;
            f32x4 ckk = {0.f, 0.f, 0.f, 0.f}, cqk = {0.f, 0.f, 0.f, 0.f};
#pragma unroll
            for (int s = 0; s < 4; ++s) { const bf16x8 b = *(const LAS bf16x8*)(ks + (16 * nt + fr) * 136 + 32 * s + 8 * g); ckk = mfma16(ak[s], b, ckk); cqk = mfma16(aq[s], b, cqk); }
            const int sc = 16 * nt + fr; const float gs = gcs[sc]; const int psc = kperm(sc);
#pragma unroll
            for (int r = 0; r < 4; ++r) { const int c = 16 * mt + 4 * g + r; const float dec = (c >= sc) ? __expf(gcs[c] - gs) : 0.f;
                Lm[c * 68 + sc] = (c > sc) ? ckk[r] * dec : 0.f;
                attI[c * 64 + psc] = f2bf_s((c >= sc) ? cqk[r] * dec : 0.f); }
        }
    }
    __syncthreads();
    LAS bf16_t* ATb = (LAS bf16_t*)(lds + 9216);
    if (wave < 2) {
        float t[32];
        const LAS float* Lb = Lm + wave * (32 * 68 + 32); asm volatile("" : "+v"(Lb));
        LAS bf16_t* Tq = Tb + wave * (32 * 72 + 32);
        const bool wr_ok = (wave == 0) || (lane < 32);
        f32x4 la[8], lb[8];
#define INV_LOAD(dst, i_) do { _Pragma("unroll") for (int j4_ = 0; j4_ < ((i_) + 3) / 4; ++j4_) dst[j4_] = *(const LAS f32x4*)(Lb + (i_) * 68 + 4 * j4_); } while (0)
#define INV_ROW(src, i_) do { float a4_[4] = {(lane == (i_)) ? 1.0f : 0.0f, 0.f, 0.f, 0.f}; \
            _Pragma("unroll") for (int j4_ = 0; j4_ < ((i_) + 3) / 4; ++j4_) _Pragma("unroll") for (int jj_ = 0; jj_ < 4; ++jj_) { if (4 * j4_ + jj_ < (i_)) a4_[jj_] -= src[j4_][jj_] * t[4 * j4_ + jj_]; } \
            const float a_ = (a4_[0] + a4_[1]) + (a4_[2] + a4_[3]); t[(i_)] = a_; if (wr_ok) Tq[(i_) * 72 + lane] = f2bf_s(a_); } while (0)
        t[0] = (lane == 0) ? 1.0f : 0.0f; if (wr_ok) Tq[lane] = f2bf_s(t[0]);
        INV_LOAD(lb, 1);
#pragma unroll
        for (int i = 1; i < 32; i += 2) {
            if (i + 1 < 32) INV_LOAD(la, i + 1);
            __builtin_amdgcn_sched_barrier(0);
            INV_ROW(lb, i);
            __builtin_amdgcn_sched_barrier(0);
            if (i + 1 < 32) {
                if (i + 2 < 32) INV_LOAD(lb, i + 2);
                __builtin_amdgcn_sched_barrier(0);
                INV_ROW(la, i + 1);
                __builtin_amdgcn_sched_barrier(0);
            }
        }
#undef INV_LOAD
#undef INV_ROW
        if (wave == 0 && lane < 32) {
#pragma unroll
            for (int q = 0; q < 4; ++q) { u32x4 w; w.x = pk2(t[8 * q], t[8 * q + 1]); w.y = pk2(t[8 * q + 2], t[8 * q + 3]); w.z = pk2(t[8 * q + 4], t[8 * q + 5]); w.w = pk2(t[8 * q + 6], t[8 * q + 7]);
                *(LAS u32x4*)(ATb + lane * 40 + 8 * q) = w; } }
    } else {
        const int t7 = tid - 128;
        for (int ch = t7; ch < 2560; ch += 384) {
            if (ch < 1024) *(GAS v4u*)(item + GI_KDT + ch * 16) = *(const LAS v4u*)((const LAS unsigned char*)kdtI + (ch >> 3) * 128 + (((ch & 7) ^ ((ch >> 6) & 7)) << 4));
            else if (ch < 2048) *(GAS v4u*)(item + GI_WQ + 16384 + (ch - 1024) * 16) = *(const LAS v4u*)((const LAS unsigned char*)qgI + (ch - 1024) * 16);
            else *(GAS v4u*)(item + GI_ATT + (ch - 2048) * 16) = *(const LAS v4u*)((const LAS unsigned char*)attI + (ch - 2048) * 16);
        }
    }
    if (has_next) GDN_LOAD_GB(gb, hn, nn, tid);
    if (has_next) GDN_LOAD_RAW(raw, hn, nn, tid);
    else {
#pragma unroll
        for (int X_ = 0; X_ < 3; ++X_)
#pragma unroll
            for (int ps_ = 0; ps_ < 2; ++ps_)
#pragma unroll
                for (int j_ = 0; j_ < 4; ++j_) raw[X_][ps_][j_] = (u32x4){0u, 0u, 0u, 0u}; }
    asm volatile("s_waitcnt lgkmcnt(0)" ::: "memory"); __builtin_amdgcn_s_barrier(); asm volatile("" ::: "memory");
    if (wave < 2) {
        const int fr = lane & 15, g = lane >> 4;
        const bf16x8 bfrag = *(const LAS bf16x8*)(ATb + (16 * wave + fr) * 40 + 8 * g);
        f32x4 Y[2];
#pragma unroll
        for (int mt = 0; mt < 2; ++mt) { const LAS float* cp = Lm + (32 + 16 * mt + fr) * 68 + 8 * g; const f32x4 c0 = *(const LAS f32x4*)cp, c1 = *(const LAS f32x4*)(cp + 4);
            u32x4 w; w.x = pk2(c0[0], c0[1]); w.y = pk2(c0[2], c0[3]); w.z = pk2(c1[0], c1[1]); w.w = pk2(c1[2], c1[3]);
            Y[mt] = mfma16(__builtin_bit_cast(bf16x8, w), bfrag, (f32x4){0.f, 0.f, 0.f, 0.f}); }
        u32x4 yb; yb.x = pk2(Y[0][0], Y[0][1]); yb.y = pk2(Y[0][2], Y[0][3]); yb.z = pk2(Y[1][0], Y[1][1]); yb.w = pk2(Y[1][2], Y[1][3]);
#pragma unroll
        for (int mt = 0; mt < 2; ++mt) { const LAS bf16_t* dp = Tb + (32 + 16 * mt + fr) * 72 + 32 + 4 * g; const u32x2 lo = *(const LAS u32x2*)dp, hi = *(const LAS u32x2*)(dp + 16);
            u32x4 a; a.x = lo.x; a.y = lo.y; a.z = hi.x; a.w = hi.y;
            const f32x4 X = mfma16(__builtin_bit_cast(bf16x8, a), __builtin_bit_cast(bf16x8, yb), (f32x4){0.f, 0.f, 0.f, 0.f});
#pragma unroll
            for (int r = 0; r < 4; ++r) Tb[(32 + 16 * mt + 4 * g + r) * 72 + 16 * wave + fr] = f2bf_s(-X[r]); }
    }
    asm volatile("s_waitcnt lgkmcnt(0)" ::: "memory"); __builtin_amdgcn_s_barrier(); asm volatile("" ::: "memory");
    {
        const int fr = lane & 15, g = lane >> 4, col = 16 * wave + fr, pcol = kperm(col);
        bf16x8 bu[2], bw[2];
#pragma unroll
        for (int s = 0; s < 2; ++s) { const int sl = ((4 * s + g) ^ ((col >> 3) & 7)) * 8; bu[s] = *(const LAS bf16x8*)(vbT + col * 72 + sl); bw[s] = *(const LAS bf16x8*)(kbgT + col * 72 + sl); }
#pragma unroll
        for (int mt = 0; mt < 4; ++mt) { f32x4 cu = {0.f, 0.f, 0.f, 0.f}, cw = {0.f, 0.f, 0.f, 0.f};
#pragma unroll
            for (int s = 0; s < 2; ++s) { const bf16x8 a = *(const LAS bf16x8*)(Tb + (16 * mt + fr) * 72 + 32 * s + 8 * g); cu = mfma16(a, bu[s], cu); cw = mfma16(a, bw[s], cw); }
            *(LAS f32x4*)(UTI + col * 64 + 16 * mt + 4 * g) = cu;
#pragma unroll
            for (int r = 0; r < 4; ++r) WI[(16 * mt + 4 * g + r) * 128 + pcol] = f2bf_s(cw[r]); }
    }
    asm volatile("s_waitcnt lgkmcnt(0)" ::: "memory"); __builtin_amdgcn_s_barrier(); asm volatile("" ::: "memory");
    for (int ch = tid; ch < 3072; ch += 512) {
        if (ch < 2048) *(GAS v4u*)(item + GI_UT + ch * 16) = *(const LAS v4u*)((const LAS unsigned char*)UTI + ch * 16);
        else *(GAS v4u*)(item + GI_WQ + (ch - 2048) * 16) = *(const LAS v4u*)((const LAS unsigned char*)WI + (ch - 2048) * 16);
    }
    if (tid == 0) *(float*)(item + GI_EG) = __expf(gl);
    asm volatile("s_waitcnt lgkmcnt(0)" ::: "memory"); __builtin_amdgcn_s_barrier(); asm volatile("" ::: "memory");
}

__device__ __forceinline__ bf16x8 pack_b(const f32x4 lo, const f32x4 hi) {
    u32x4 w; w.x = pg8::cvt_pk_bf16(lo[0], lo[1]); w.y = pg8::cvt_pk_bf16(lo[2], lo[3]); w.z = pg8::cvt_pk_bf16(hi[0], hi[1]); w.w = pg8::cvt_pk_bf16(hi[2], hi[3]);
    return __builtin_bit_cast(bf16x8, w);
}
__device__ __forceinline__ void gdn_scan(const Params& P, int h, int n0, int n1, const float* Sinit, f32x4* Sout, LAS unsigned char* lds, int tid, int wave, int lane) {
    using namespace cfg;
    asm volatile("v_mbcnt_lo_u32_b32 %0, -1, 0\n\tv_mbcnt_hi_u32_b32 %0, -1, %0" : "=v"(lane)); tid = wave * 64 + lane;
    constexpr int WQ_LD = 272, AT_LD = 144, KD_LD = 144;
    constexpr int OFF_WQ = 0, OFF_AT = 128 * WQ_LD, OFF_KD = OFF_AT + 64 * AT_LD, OFF_O = OFF_KD + 128 * KD_LD;
    LAS unsigned char* Abuf = lds;
    LAS float* Oex = (LAS float*)(lds + OFF_O);
    const unsigned char* items = P.ws + WS_GDNP + (size_t)h * NCH * GI_BYTES;
    const bf16_t* graw = (const bf16_t*)(P.ws + WS_GRAW);
    bf16_t* mix = (bf16_t*)(P.ws + WS_MIX);
    const int fr = lane & 15, g = lane >> 4, dv = 16 * wave + fr;
    v4u st[7];
#define SCAN_LOAD(nn) do { const unsigned char* it_ = items + (size_t)(nn) * GI_BYTES; \
        _Pragma("unroll") for (int i_ = 0; i_ < 4; ++i_) st[i_] = __builtin_nontemporal_load((const GAS v4u*)(it_ + GI_WQ + (size_t)(tid + 512 * i_) * 16)); \
        st[4] = __builtin_nontemporal_load((const GAS v4u*)(it_ + GI_ATT + (size_t)tid * 16)); \
        _Pragma("unroll") for (int i_ = 0; i_ < 2; ++i_) st[5 + i_] = __builtin_nontemporal_load((const GAS v4u*)(it_ + GI_KDT + (size_t)(tid + 512 * i_) * 16)); } while (0)
#define SCAN_STORE() do { \
        _Pragma("unroll") for (int i_ = 0; i_ < 4; ++i_) { const int ch_ = tid + 512 * i_; *(LAS v4u*)(Abuf + OFF_WQ + (ch_ >> 4) * WQ_LD + (ch_ & 15) * 16) = st[i_]; } \
        *(LAS v4u*)(Abuf + OFF_AT + (tid >> 3) * AT_LD + (tid & 7) * 16) = st[4]; \
        _Pragma("unroll") for (int i_ = 0; i_ < 2; ++i_) { const int ch_ = tid + 512 * i_; *(LAS v4u*)(Abuf + OFF_KD + (ch_ >> 3) * KD_LD + (ch_ & 7) * 16) = st[5 + i_]; } } while (0)
    f32x4 S[8];
#pragma unroll
    for (int i = 0; i < 8; ++i) S[i] = Sinit ? *(const GAS f32x4*)(Sinit + (size_t)dv * 128 + 16 * i + 4 * g) : (f32x4){0.f, 0.f, 0.f, 0.f};
    SCAN_LOAD(n0); SCAN_STORE();
    const int frow = tid >> 3, fseg = tid & 7;
    LAS float* gnl = (LAS float*)(lds + OFF_O + 64 * 132 * 4);
    if (tid < 128) gnl[tid] = P.gdn_norm[tid];
    __syncthreads();
#pragma unroll 1
    for (int n = n0; n < n1; ++n) {
        const unsigned char* it = items + (size_t)n * GI_BYTES;
        if (n + 1 < n1) SCAN_LOAD(n + 1);
        f32x4 ut[4];
#pragma unroll
        for (int mt = 0; mt < 4; ++mt) ut[mt] = __builtin_nontemporal_load((const GAS f32x4*)(it + GI_UT + ((size_t)dv * 64 + 16 * mt + 4 * g) * 4));
        const float eg = *(const float*)(it + GI_EG);
        u32x4 zr[2];
        if (n > 0) { const bf16_t* zp = graw + (size_t)(64 * n + frow) * 4096 + 3072 + h * 128 + 16 * fseg; zr[0] = *(const u32x4*)zp; zr[1] = *(const u32x4*)(zp + 8); }
#define SB_() __builtin_amdgcn_sched_barrier(0)
#define LD_WQ(dst, mt0) do { _Pragma("unroll") for (int m_ = 0; m_ < 2; ++m_) _Pragma("unroll") for (int s_ = 0; s_ < 4; ++s_) \
            dst[4 * m_ + s_] = *(const LAS bf16x8*)(Abuf + OFF_WQ + (16 * ((mt0) + m_) + fr) * WQ_LD + 64 * s_ + 16 * g); } while (0)
#define LD_AT(dst) do { _Pragma("unroll") for (int m_ = 0; m_ < 4; ++m_) _Pragma("unroll") for (int s_ = 0; s_ < 2; ++s_) \
            dst[2 * m_ + s_] = *(const LAS bf16x8*)(Abuf + OFF_AT + (16 * m_ + fr) * AT_LD + 64 * s_ + 16 * g); } while (0)
#define LD_KD(dst, mt0) do { _Pragma("unroll") for (int m_ = 0; m_ < 4; ++m_) _Pragma("unroll") for (int s_ = 0; s_ < 2; ++s_) \
            dst[2 * m_ + s_] = *(const LAS bf16x8*)(Abuf + OFF_KD + (16 * ((mt0) + m_) + fr) * KD_LD + 64 * s_ + 16 * g); } while (0)
#define MM_WQ(src, mt0) do { _Pragma("unroll") for (int m_ = 0; m_ < 2; ++m_) _Pragma("unroll") for (int s_ = 0; s_ < 4; ++s_) X[(mt0) + m_] = mfma16(src[4 * m_ + s_], bs[s_], X[(mt0) + m_]); } while (0)
        bf16x8 bs[4];
#pragma unroll
        for (int s = 0; s < 4; ++s) bs[s] = pack_b(S[2 * s], S[2 * s + 1]);
        f32x4 X[8];
#pragma unroll
        for (int mt = 0; mt < 8; ++mt) X[mt] = (f32x4){0.f, 0.f, 0.f, 0.f};
        bf16x8 fa[8], fb[8];
        LD_WQ(fa, 0); SB_();
        LD_WQ(fb, 2); SB_(); MM_WQ(fa, 0); SB_();
        LD_WQ(fa, 4); SB_(); MM_WQ(fb, 2); SB_();
        LD_WQ(fb, 6); SB_(); MM_WQ(fa, 4); SB_();
        LD_AT(fa); SB_(); MM_WQ(fb, 6); SB_();
        f32x4 vn[4];
#pragma unroll
        for (int mt = 0; mt < 4; ++mt) vn[mt] = ut[mt] - X[mt];
        bf16x8 bv[2];
#pragma unroll
        for (int s = 0; s < 2; ++s) bv[s] = pack_b(vn[2 * s], vn[2 * s + 1]);
        SB_();
        LD_KD(fb, 0); SB_();
#pragma unroll
        for (int mt = 0; mt < 4; ++mt)
#pragma unroll
            for (int s = 0; s < 2; ++s) X[4 + mt] = mfma16(fa[2 * mt + s], bv[s], X[4 + mt]);
        SB_();
        LD_KD(fa, 4); SB_();
#pragma unroll
        for (int mt = 0; mt < 4; ++mt) { S[mt] = S[mt] * eg;
#pragma unroll
            for (int s = 0; s < 2; ++s) S[mt] = mfma16(fb[2 * mt + s], bv[s], S[mt]); }
        SB_();
#pragma unroll
        for (int mt = 0; mt < 4; ++mt)
#pragma unroll
            for (int r = 0; r < 4; ++r) Oex[(16 * mt + 4 * g + r) * 132 + dv] = X[4 + mt][r];
#pragma unroll
        for (int mt = 4; mt < 8; ++mt) { S[mt] = S[mt] * eg;
#pragma unroll
            for (int s = 0; s < 2; ++s) S[mt] = mfma16(fa[2 * (mt - 4) + s], bv[s], S[mt]); }
#undef SB_
#undef LD_WQ
#undef LD_AT
#undef LD_KD
#undef MM_WQ
        asm volatile("s_waitcnt lgkmcnt(0)" ::: "memory"); __builtin_amdgcn_s_barrier(); asm volatile("" ::: "memory");
        if (n + 1 < n1) SCAN_STORE();
        if (n > 0) {
            f32x4 o4[4]; float ss = 0.f;
#pragma unroll
            for (int i = 0; i < 4; ++i) { o4[i] = *(const LAS f32x4*)(Oex + frow * 132 + 16 * fseg + 4 * i); ss += (o4[i][0] * o4[i][0] + o4[i][1] * o4[i][1]) + (o4[i][2] * o4[i][2] + o4[i][3] * o4[i][3]); }
            ss += __shfl_xor(ss, 1); ss += __shfl_xor(ss, 2); ss += __shfl_xor(ss, 4);
            const float rn = __builtin_amdgcn_rsqf(ss * (1.0f / 128.0f) + 1e-6f);
            float ov[16];
#pragma unroll
            for (int i = 0; i < 16; ++i) { const unsigned wd = zr[i >> 3][(i >> 1) & 3]; const float z = (i & 1) ? __uint_as_float(wd & 0xffff0000u) : __uint_as_float(wd << 16);
                ov[i] = o4[i >> 2][i & 3] * rn * gnl[16 * fseg + i] * pg8::silu_f(z); }
            u32x4 w0, w1; w0.x = pk2(ov[0], ov[1]); w0.y = pk2(ov[2], ov[3]); w0.z = pk2(ov[4], ov[5]); w0.w = pk2(ov[6], ov[7]); w1.x = pk2(ov[8], ov[9]); w1.y = pk2(ov[10], ov[11]); w1.z = pk2(ov[12], ov[13]); w1.w = pk2(ov[14], ov[15]);
            bf16_t* mp = mix + (size_t)(64 * (n - 1) + frow) * 2048 + h * 128 + 16 * fseg;
            *(u32x4*)mp = w0; *(u32x4*)(mp + 8) = w1;
        }
        asm volatile("s_waitcnt lgkmcnt(0)" ::: "memory"); __builtin_amdgcn_s_barrier(); asm volatile("" ::: "memory");
    }
#undef SCAN_LOAD
#undef SCAN_STORE
    if (Sout) {
#pragma unroll
        for (int i = 0; i < 8; ++i) Sout[i] = S[i]; }
}


__device__ __forceinline__ int grp_start(int g) { return 8 * g + 1; }
__device__ __forceinline__ void dep_wait(unsigned* flag, unsigned want, int wave) {
    int l_; asm volatile("v_mbcnt_lo_u32_b32 %0, -1, 0\n\tv_mbcnt_hi_u32_b32 %0, -1, %0" : "=v"(l_));
    if (wave == 0 && l_ == 0) { unsigned sp = 0; while (__hip_atomic_load(flag, __ATOMIC_RELAXED, __HIP_MEMORY_SCOPE_AGENT) < want) { __builtin_amdgcn_s_sleep(8); if (++sp > (1u << 22)) break; }
        __builtin_amdgcn_fence(__ATOMIC_ACQUIRE, "agent"); asm volatile("s_waitcnt vmcnt(0)" ::: "memory"); }
    __syncthreads();
}
#define DEP_PUBLISH_BEGIN() asm volatile("s_waitcnt vmcnt(0)" ::: "memory"); __syncthreads(); if (threadIdx.x == 0) { __builtin_amdgcn_fence(__ATOMIC_RELEASE, "agent"); asm volatile("s_waitcnt vmcnt(0)" ::: "memory");
#define DEP_PUBLISH_END() }
__device__ __forceinline__ void gdn_compose(const Params& P, int h, int gi, int part, LAS unsigned char* lds, unsigned* ctl, int tid, int wave, int lane) {
    using namespace cfg;
    dep_wait(ctl + CW_P2C + 4 * (16 * h + gi), 8u, wave);
    constexpr int WQ_LD = 272, KD_LD = 144, OFF_WQ = 0, OFF_KD = 128 * WQ_LD + 64 * 144;
    LAS unsigned char* Abuf = lds;
    const unsigned char* items = P.ws + WS_GDNP + (size_t)h * NCH * GI_BYTES;
    const int fr = lane & 15, g = lane >> 4, col = 16 * wave + fr;
    const int n0 = grp_start(gi), n1 = 8 * gi + 9;
    v4u stx[4], sty[4];
#define CMP_LOAD(st, nn) do { const unsigned char* it_ = items + (size_t)(nn) * GI_BYTES; \
        _Pragma("unroll") for (int i_ = 0; i_ < 2; ++i_) st[i_] = *(const GAS v4u*)(it_ + GI_WQ + (size_t)(tid + 512 * i_) * 16); \
        _Pragma("unroll") for (int i_ = 0; i_ < 2; ++i_) st[2 + i_] = *(const GAS v4u*)(it_ + GI_KDT + (size_t)(tid + 512 * i_) * 16); } while (0)
#define CMP_STORE(st) do { \
        _Pragma("unroll") for (int i_ = 0; i_ < 2; ++i_) { const int ch_ = tid + 512 * i_; *(LAS v4u*)(Abuf + OFF_WQ + (ch_ >> 4) * WQ_LD + (ch_ & 15) * 16) = st[i_]; } \
        _Pragma("unroll") for (int i_ = 0; i_ < 2; ++i_) { const int ch_ = tid + 512 * i_; *(LAS v4u*)(Abuf + OFF_KD + (ch_ >> 3) * KD_LD + (ch_ & 7) * 16) = st[2 + i_]; } } while (0)
    f32x4 X[8];
#pragma unroll
    for (int mt = 0; mt < 8; ++mt)
#pragma unroll
        for (int r = 0; r < 4; ++r) X[mt][r] = (part == 0 && 16 * mt + 4 * g + r == col) ? 1.0f : 0.0f;
    CMP_LOAD(stx, n0); CMP_STORE(stx);
    if (n0 + 1 < n1) CMP_LOAD(stx, n0 + 1);
    if (n0 + 2 < n1) CMP_LOAD(sty, n0 + 2);
    __syncthreads();
#pragma unroll 1
    for (int nb = n0; nb < n1; nb += 2) {
        { const int n = nb;
#define STCUR stx
        const unsigned char* it = items + (size_t)n * GI_BYTES;
        f32x4 ut[4];
#pragma unroll
        for (int mt = 0; mt < 4; ++mt) ut[mt] = part ? *(const GAS f32x4*)(it + GI_UT + ((size_t)col * 64 + 16 * mt + 4 * g) * 4) : (f32x4){0.f, 0.f, 0.f, 0.f};
        const float eg = *(const float*)(it + GI_EG);
        bf16x8 bs[4];
#pragma unroll
        for (int s = 0; s < 4; ++s) bs[s] = pack_b(X[2 * s], X[2 * s + 1]);
        bf16x8 fa[8], fb[8];
        f32x4 Y[4];
#pragma unroll
        for (int mt = 0; mt < 4; ++mt) Y[mt] = (f32x4){0.f, 0.f, 0.f, 0.f};
#define SB_() __builtin_amdgcn_sched_barrier(0)
#define LD_W(dst, mt0) do { _Pragma("unroll") for (int m_ = 0; m_ < 2; ++m_) _Pragma("unroll") for (int s_ = 0; s_ < 4; ++s_) \
            dst[4 * m_ + s_] = *(const LAS bf16x8*)(Abuf + OFF_WQ + (16 * ((mt0) + m_) + fr) * WQ_LD + 64 * s_ + 16 * g); } while (0)
#define LD_KD(dst, mt0) do { _Pragma("unroll") for (int m_ = 0; m_ < 4; ++m_) _Pragma("unroll") for (int s_ = 0; s_ < 2; ++s_) \
            dst[2 * m_ + s_] = *(const LAS bf16x8*)(Abuf + OFF_KD + (16 * ((mt0) + m_) + fr) * KD_LD + 64 * s_ + 16 * g); } while (0)
#define MM_W(src, mt0) do { _Pragma("unroll") for (int m_ = 0; m_ < 2; ++m_) _Pragma("unroll") for (int s_ = 0; s_ < 4; ++s_) Y[(mt0) + m_] = mfma16(src[4 * m_ + s_], bs[s_], Y[(mt0) + m_]); } while (0)
        LD_W(fa, 0); SB_();
        LD_W(fb, 2); SB_(); MM_W(fa, 0); SB_();
        LD_KD(fa, 0); SB_(); MM_W(fb, 2); SB_();
        f32x4 vn[4];
#pragma unroll
        for (int mt = 0; mt < 4; ++mt) vn[mt] = ut[mt] - Y[mt];
        bf16x8 bv[2];
#pragma unroll
        for (int s = 0; s < 2; ++s) bv[s] = pack_b(vn[2 * s], vn[2 * s + 1]);
        SB_();
        LD_KD(fb, 4); SB_();
#pragma unroll
        for (int mt = 0; mt < 4; ++mt) { X[mt] = X[mt] * eg;
#pragma unroll
            for (int s = 0; s < 2; ++s) X[mt] = mfma16(fa[2 * mt + s], bv[s], X[mt]); }
        SB_();
#pragma unroll
        for (int mt = 4; mt < 8; ++mt) { X[mt] = X[mt] * eg;
#pragma unroll
            for (int s = 0; s < 2; ++s) X[mt] = mfma16(fb[2 * (mt - 4) + s], bv[s], X[mt]); }
#undef SB_
#undef LD_W
#undef LD_KD
#undef MM_W
        asm volatile("s_waitcnt lgkmcnt(0)" ::: "memory"); __builtin_amdgcn_s_barrier(); asm volatile("" ::: "memory");
        if (n + 1 < n1) CMP_STORE(STCUR);
        asm volatile("s_waitcnt lgkmcnt(0)" ::: "memory"); __builtin_amdgcn_s_barrier(); asm volatile("" ::: "memory");
        if (n + 3 < n1) CMP_LOAD(STCUR, n + 3);
#undef STCUR
        }
        if (nb + 1 < n1) { const int n = nb + 1;
#define STCUR sty
        const unsigned char* it = items + (size_t)n * GI_BYTES;
        f32x4 ut[4];
#pragma unroll
        for (int mt = 0; mt < 4; ++mt) ut[mt] = part ? *(const GAS f32x4*)(it + GI_UT + ((size_t)col * 64 + 16 * mt + 4 * g) * 4) : (f32x4){0.f, 0.f, 0.f, 0.f};
        const float eg = *(const float*)(it + GI_EG);
        bf16x8 bs[4];
#pragma unroll
        for (int s = 0; s < 4; ++s) bs[s] = pack_b(X[2 * s], X[2 * s + 1]);
        bf16x8 fa[8], fb[8];
        f32x4 Y[4];
#pragma unroll
        for (int mt = 0; mt < 4; ++mt) Y[mt] = (f32x4){0.f, 0.f, 0.f, 0.f};
#define SB_() __builtin_amdgcn_sched_barrier(0)
#define LD_W(dst, mt0) do { _Pragma("unroll") for (int m_ = 0; m_ < 2; ++m_) _Pragma("unroll") for (int s_ = 0; s_ < 4; ++s_) \
            dst[4 * m_ + s_] = *(const LAS bf16x8*)(Abuf + OFF_WQ + (16 * ((mt0) + m_) + fr) * WQ_LD + 64 * s_ + 16 * g); } while (0)
#define LD_KD(dst, mt0) do { _Pragma("unroll") for (int m_ = 0; m_ < 4; ++m_) _Pragma("unroll") for (int s_ = 0; s_ < 2; ++s_) \
            dst[2 * m_ + s_] = *(const LAS bf16x8*)(Abuf + OFF_KD + (16 * ((mt0) + m_) + fr) * KD_LD + 64 * s_ + 16 * g); } while (0)
#define MM_W(src, mt0) do { _Pragma("unroll") for (int m_ = 0; m_ < 2; ++m_) _Pragma("unroll") for (int s_ = 0; s_ < 4; ++s_) Y[(mt0) + m_] = mfma16(src[4 * m_ + s_], bs[s_], Y[(mt0) + m_]); } while (0)
        LD_W(fa, 0); SB_();
        LD_W(fb, 2); SB_(); MM_W(fa, 0); SB_();
        LD_KD(fa, 0); SB_(); MM_W(fb, 2); SB_();
        f32x4 vn[4];
#pragma unroll
        for (int mt = 0; mt < 4; ++mt) vn[mt] = ut[mt] - Y[mt];
        bf16x8 bv[2];
#pragma unroll
        for (int s = 0; s < 2; ++s) bv[s] = pack_b(vn[2 * s], vn[2 * s + 1]);
        SB_();
        LD_KD(fb, 4); SB_();
#pragma unroll
        for (int mt = 0; mt < 4; ++mt) { X[mt] = X[mt] * eg;
#pragma unroll
            for (int s = 0; s < 2; ++s) X[mt] = mfma16(fa[2 * mt + s], bv[s], X[mt]); }
        SB_();
#pragma unroll
        for (int mt = 4; mt < 8; ++mt) { X[mt] = X[mt] * eg;
#pragma unroll
            for (int s = 0; s < 2; ++s) X[mt] = mfma16(fb[2 * (mt - 4) + s], bv[s], X[mt]); }
#undef SB_
#undef LD_W
#undef LD_KD
#undef MM_W
        asm volatile("s_waitcnt lgkmcnt(0)" ::: "memory"); __builtin_amdgcn_s_barrier(); asm volatile("" ::: "memory");
        if (n + 1 < n1) CMP_STORE(STCUR);
        asm volatile("s_waitcnt lgkmcnt(0)" ::: "memory"); __builtin_amdgcn_s_barrier(); asm volatile("" ::: "memory");
        if (n + 3 < n1) CMP_LOAD(STCUR, n + 3);
#undef STCUR
        }
    }
#undef CMP_LOAD
#undef CMP_STORE
    if (part == 0) {
        LAS bf16_t* img = (LAS bf16_t*)lds; const int pc = kperm(col);
#pragma unroll
        for (int mt = 0; mt < 8; ++mt)
#pragma unroll
            for (int r = 0; r < 4; ++r) img[(16 * mt + 4 * g + r) * 128 + pc] = f2bf_s(X[mt][r]);
        __syncthreads();
        unsigned char* dst = P.ws + WS_MG + (size_t)(h * 15 + gi) * 32768;
        for (int ch = tid; ch < 2048; ch += 512) *(GAS v4u*)(dst + ch * 16) = *(const LAS v4u*)((const LAS unsigned char*)img + ch * 16);
        __syncthreads();
    } else {
        float* dst = (float*)(P.ws + WS_CG + (size_t)(h * 15 + gi) * 65536) + (size_t)col * 128 + 4 * g;
#pragma unroll
        for (int mt = 0; mt < 8; ++mt) *(GAS f32x4*)(dst + 16 * mt) = X[mt];
    }
    DEP_PUBLISH_BEGIN() __hip_atomic_fetch_add(ctl + CW_CMP + 4 * (16 * h + gi), 1u, __ATOMIC_RELAXED, __HIP_MEMORY_SCOPE_AGENT); DEP_PUBLISH_END()
}
__device__ __forceinline__ void gdn_carry(const Params& P, int h, LAS unsigned char* lds, unsigned* ctl, int tid, int wave, int lane) {
    using namespace cfg;
    constexpr int WQ_LD = 272;
    const int fr = lane & 15, g = lane >> 4, dv = 16 * wave + fr;
    f32x4 S[8];
    { u32x4 raw[3][2][4]; float gb[2]; GDN_LOAD_GB(gb, h, 0, tid); GDN_LOAD_RAW(raw, h, 0, tid);
      gdn_prep_item(P, h, 0, raw, gb, 0, 0, false, lds, tid, wave, lane);
      asm volatile("s_waitcnt vmcnt(0)" ::: "memory");
      __syncthreads();
      if (tid == 0) { __builtin_amdgcn_fence(__ATOMIC_ACQ_REL, "agent"); asm volatile("s_waitcnt vmcnt(0)" ::: "memory"); }
      __syncthreads();
      gdn_scan(P, h, 0, 1, nullptr, S, lds, tid, wave, lane); }
#pragma unroll 1
    for (int gi = 0; gi < 16; ++gi) {
        float* sp = (float*)(P.ws + WS_SG + (size_t)(h * 16 + gi) * 65536) + (size_t)dv * 128 + 4 * g;
#pragma unroll
        for (int mt = 0; mt < 8; ++mt) *(GAS f32x4*)(sp + 16 * mt) = S[mt];
        v4u st[4];
        if (gi < 15) { dep_wait(ctl + CW_CMP + 4 * (16 * h + gi), 2u, wave);
            const unsigned char* mg = P.ws + WS_MG + (size_t)(h * 15 + gi) * 32768;
#pragma unroll
            for (int i = 0; i < 4; ++i) st[i] = *(const GAS v4u*)(mg + (size_t)(tid + 512 * i) * 16); }
        asm volatile("s_waitcnt vmcnt(0)" ::: "memory");
        __syncthreads();
        if (tid == 0) { __builtin_amdgcn_fence(__ATOMIC_RELEASE, "agent"); asm volatile("s_waitcnt vmcnt(0)" ::: "memory");
            __hip_atomic_store(ctl + CW_GFLAG + 64 * h, (unsigned)(gi + 1), __ATOMIC_RELAXED, __HIP_MEMORY_SCOPE_AGENT); }
        if (gi == 15) break;
#pragma unroll
        for (int i = 0; i < 4; ++i) { const int ch = tid + 512 * i; *(LAS v4u*)(lds + (ch >> 4) * WQ_LD + (ch & 15) * 16) = st[i]; }
        f32x4 ct[8];
        { const float* cp = (const float*)(P.ws + WS_CG + (size_t)(h * 15 + gi) * 65536) + (size_t)dv * 128 + 4 * g;
#pragma unroll
          for (int mt = 0; mt < 8; ++mt) ct[mt] = *(const GAS f32x4*)(cp + 16 * mt); }
        __syncthreads();
        bf16x8 bs[4];
#pragma unroll
        for (int s = 0; s < 4; ++s) bs[s] = pack_b(S[2 * s], S[2 * s + 1]);
#pragma unroll
        for (int mt = 0; mt < 8; ++mt) { f32x4 x = ct[mt];
#pragma unroll
            for (int s = 0; s < 4; ++s) { const bf16x8 a = *(const LAS bf16x8*)(lds + (16 * mt + fr) * WQ_LD + 64 * s + 16 * g); x = mfma16(a, bs[s], x); }
            S[mt] = x; }
        __syncthreads();
    }
}

__device__ __forceinline__ int crow(int r, int hh) { return (r & 3) + 8 * (r >> 2) + 4 * hh; }
__device__ __forceinline__ s16x4 vtr(const LAS unsigned char* p) { typedef short v4i16_t __attribute__((ext_vector_type(4))); return __builtin_bit_cast(s16x4, __builtin_amdgcn_ds_read_tr16_b64_v4i16((LAS v4i16_t*)p)); }
__device__ __forceinline__ f32x16 mfma32(bf16x8 a, bf16x8 b, f32x16 c) { return __builtin_amdgcn_mfma_f32_32x32x16_bf16(a, b, c, 0, 0, 0); }
#ifndef ATT_TIMING
#define ATT_TIMING 0
#endif
#ifndef ATT_TSEG
#define ATT_TSEG 6
#endif
#ifndef ATT_TWAVE
#define ATT_TWAVE 0
#endif
#if ATT_TIMING
#define TSTAMP(i_) asm volatile("s_memtime %0" : "=s"(ts_[i_]) :: "memory")
#define TACC(MODE) do { asm volatile("s_waitcnt lgkmcnt(0)" ::: "memory"); \
            _Pragma("unroll") for (int i_ = 0; i_ < 7; ++i_) asm volatile("" :: "s"(ts_[i_]));     \
            if ((MODE) == 1) { _Pragma("unroll") for (int i_ = 0; i_ < 6; ++i_) tacc_[i_] += (unsigned)(ts_[i_ + 1] - ts_[i_]); tacc_[6] += (unsigned)(ts_[6] - ts_[0]); tsteps_ += 1u; } } while (0)
#else
#define TSTAMP(i_) do {} while (0)
#define TACC(MODE) do {} while (0)
#endif
#ifndef ATT_STAGGER
#define ATT_STAGGER 0
#endif
#define ATT_WAIT_V(n) asm volatile("s_waitcnt vmcnt(" #n ")" ::: "memory")
__device__ __forceinline__ volatile LAS unsigned* fresh_misc(LAS unsigned char* lds) { const unsigned a = (unsigned)(uintptr_t)(lds + cfg::MISC_OFF); unsigned v; asm volatile("v_mov_b32 %0, %1" : "=v"(v) : "s"(a)); return (volatile LAS unsigned*)(uintptr_t)v; }

template <int ORD> __device__ __forceinline__ void attn_unit_t(const Params& P, int h, int qb, LAS unsigned char* lds, int tid, int wave, int lane) {
    using namespace cfg;
    asm volatile("v_mbcnt_lo_u32_b32 %0, -1, 0\n\tv_mbcnt_hi_u32_b32 %0, -1, %0" : "=v"(lane)); tid = wave * 64 + lane;
    constexpr int SLOT = 32768;
    const float negmb = __uint_as_float(fresh_misc(lds)[18]);
    const int r32 = lane & 31, hh = lane >> 5, map = wave >> 2, wq = wave & 3, hm = 2 * h + map;
    const bf16_t* qbuf = (const bf16_t*)(P.ws + WS_Q);
    const unsigned char* k1g = P.ws + WS_K + (size_t)(2 * h) * NCH * 8192;
    const unsigned char* k2g = P.ws + WS_K + (size_t)(2 * h + 1) * NCH * 8192;
    const unsigned char* vg = P.ws + WS_V + (size_t)h * NCH * 16384;
    const int NT = 2 * qb + 3;
    const unsigned lds0 = (unsigned)(uintptr_t)lds;
#define ATT_GLDS(gsrc, ldsoff) do { unsigned keep_; const unsigned dst_ = (unsigned)__builtin_amdgcn_readfirstlane((int)(lds0 + (unsigned)(ldsoff))); \
        asm volatile("s_mov_b32 %0, m0\n\ts_mov_b32 m0, %2\n\ts_nop 0\n\tglobal_load_lds_dwordx4 %1, off\n\ts_mov_b32 m0, %0" : "=&s"(keep_) : "v"(gsrc), "s"(dst_) : "memory"); } while (0)
#define ATT_DMA_K(t, koff) do { const size_t t_ = (size_t)(t); \
        ATT_GLDS(k1g + t_ * 8192 + wave * 1024 + lane * 16, (koff) + wave * 1024); \
        ATT_GLDS(k2g + t_ * 8192 + wave * 1024 + lane * 16, (koff) + 8192 + wave * 1024); } while (0)
#define ATT_DMA_V(t, voff) do { const size_t t_ = (size_t)(t); \
        ATT_GLDS(vg + t_ * 16384 + wave * 1024 + lane * 16, (voff) + wave * 1024); \
        ATT_GLDS(vg + t_ * 16384 + (wave + 8) * 1024 + lane * 16, (voff) + (wave + 8) * 1024); } while (0)
    constexpr int VRING = 49152;
    ATT_DMA_K(0, 0); ATT_DMA_V(0, VRING); ATT_DMA_K(1, 16384); ATT_DMA_V(1, VRING + 16384); ATT_DMA_K(2, 32768); ATT_DMA_V(2, VRING + 32768);
    bf16x8 qr[4];
    { const bf16_t* qp = qbuf + ((size_t)hm * 8192 + 128 * qb + 32 * wq + r32) * 64 + 8 * hh;
#pragma unroll
        for (int d0 = 0; d0 < 4; ++d0) qr[d0] = *(const bf16x8*)(qp + 16 * d0); }
    f32x16 o[4];
#pragma unroll
    for (int d0 = 0; d0 < 4; ++d0)
#pragma unroll
        for (int r = 0; r < 16; ++r) o[d0][r] = 0.f;
    float lsum = 0.f;
    const int qrel = 32 * wq + r32;
    const int vb0 = ((lane >> 4) & 1) * 32 + (lane & 3) * 8 + (4 * hh + ((lane & 15) >> 2)) * 64;
    const int kb0 = map * 8192 + hh * 1024 + r32 * 16;
#define ATT_QK(P0, P1, slotoff) do { const LAS unsigned char* Ks_ = lds + (slotoff) + kb0; \
        _Pragma("unroll") for (int r_ = 0; r_ < 16; ++r_) { P0[r_] = negmb; P1[r_] = negmb; } \
        _Pragma("unroll") for (int d0_ = 0; d0_ < 4; ++d0_) { \
            const bf16x8 ka_ = *(const LAS bf16x8*)(Ks_ + d0_ * 2048); const bf16x8 kb_ = *(const LAS bf16x8*)(Ks_ + d0_ * 2048 + 512); \
            P0 = mfma32(ka_, qr[d0_], P0); P1 = mfma32(kb_, qr[d0_], P1); } } while (0)
    f32x16 p0, p1;
    ATT_WAIT_V(8);
    __builtin_amdgcn_s_barrier();
    asm volatile("" ::: "memory");
    ATT_QK(p0, p1, 0);
#define SB_() __builtin_amdgcn_sched_barrier(0)
#define LD_V(dst, d0_) do { _Pragma("unroll") for (int s_ = 0; s_ < 4; ++s_) { const s16x4 lo_ = vtr(Vs + (d0_) * 4096 + s_ * 1024), hi_ = vtr(Vs + (d0_) * 4096 + s_ * 1024 + 512); \
            dst[s_] = (bf16x8){lo_[0], lo_[1], lo_[2], lo_[3], hi_[0], hi_[1], hi_[2], hi_[3]}; } } while (0)
#define ATT_PV() do { \
        LD_V(vb, 1); SB_(); \
        _Pragma("unroll") for (int s2 = 0; s2 < 4; ++s2) o[0] = mfma32(pw[s2], va[s2], o[0]); \
        SB_(); LD_V(va, 2); SB_(); \
        _Pragma("unroll") for (int s2 = 0; s2 < 4; ++s2) o[1] = mfma32(pw[s2], vb[s2], o[1]); \
        SB_(); LD_V(vb, 3); SB_(); \
        _Pragma("unroll") for (int s2 = 0; s2 < 4; ++s2) o[2] = mfma32(pw[s2], va[s2], o[2]); \
        SB_(); \
        _Pragma("unroll") for (int s2 = 0; s2 < 4; ++s2) o[3] = mfma32(pw[s2], vb[s2], o[3]); \
        SB_(); } while (0)
#define ATT_PV_B() do { \
        LD_V(vb, 1); LD_V(va, 2); SB_(); \
        _Pragma("unroll") for (int s2 = 0; s2 < 4; ++s2) o[0] = mfma32(pw[s2], pva[s2], o[0]); \
        SB_(); \
        _Pragma("unroll") for (int s2 = 0; s2 < 4; ++s2) o[1] = mfma32(pw[s2], vb[s2], o[1]); \
        SB_(); LD_V(vb, 3); SB_(); \
        _Pragma("unroll") for (int s2 = 0; s2 < 4; ++s2) o[2] = mfma32(pw[s2], va[s2], o[2]); \
        SB_(); \
        _Pragma("unroll") for (int s2 = 0; s2 < 4; ++s2) o[3] = mfma32(pw[s2], vb[s2], o[3]); \
        SB_(); } while (0)
#define ATT_STEP(t_, MODE, HAS_NEXT, ORD) do { const int t = (t_); \
        TSTAMP(0); \
        if (t + 2 < NT) ATT_WAIT_V(4); else ATT_WAIT_V(0);                       \
        __builtin_amdgcn_s_barrier(); \
        asm volatile("" ::: "memory"); \
        TSTAMP(1); \
        const int kn = (kmod == 2) ? 0 : kmod + 1, vp = (vmod == 0) ? 4 : vmod - 1, vd = (vmod >= 2) ? vmod - 2 : vmod + 3;     \
        if (t + 3 < NT) { ATT_DMA_K(t + 3, kmod * 16384); ATT_DMA_V(t + 3, VRING + vd * 16384); }     \
        TSTAMP(2); \
        const LAS unsigned char* Vs = lds + VRING + ((ORD) ? vp : vmod) * 16384 + vb0; \
        const LAS unsigned char* Kn = lds + kn * 16384 + kb0; \
        bf16x8 kf[8], va[4], vb[4]; \
        if (!(ORD)) LD_V(va, 0); \
        if ((MODE) != 0 && (ORD)) ATT_PV_B();                                     \
        if (HAS_NEXT) { \
            _Pragma("unroll") for (int d0 = 0; d0 < 4; ++d0) { kf[2 * d0] = *(const LAS bf16x8*)(Kn + d0 * 2048); kf[2 * d0 + 1] = *(const LAS bf16x8*)(Kn + d0 * 2048 + 512); } } \
        SB_(); \
        TSTAMP(3); SB_(); \
          \
        if ((MODE) == 0) { \
            _Pragma("unroll") for (int r = 0; r < 16; ++r) { p0[r] = 0.f; p1[r] = (r < 8) ? 0.f : __builtin_amdgcn_exp2f(p1[r]); } \
        } else { \
            _Pragma("unroll") for (int r = 0; r < 16; ++r) { p0[r] = __builtin_amdgcn_exp2f(p0[r]); p1[r] = __builtin_amdgcn_exp2f(p1[r]); } \
            if ((MODE) == 2) { const int thr = qrel - 64 * (t - (NT - 2)); \
                _Pragma("unroll") for (int r = 0; r < 16; ++r) { const int kv = crow(r, hh); if (kv > thr) p0[r] = 0.f; if (kv + 32 > thr) p1[r] = 0.f; } } \
        } \
        float sacc = 0.f; \
        _Pragma("unroll") for (int r = 0; r < 16; ++r) sacc += p0[r] + p1[r]; \
        lsum += sacc; \
        { u32x4 w; \
          w.x = pg8::cvt_pk_bf16(p0[0], p0[1]); w.y = pg8::cvt_pk_bf16(p0[2], p0[3]); w.z = pg8::cvt_pk_bf16(p0[4], p0[5]); w.w = pg8::cvt_pk_bf16(p0[6], p0[7]); pw[0] = __builtin_bit_cast(bf16x8, w); \
          w.x = pg8::cvt_pk_bf16(p0[8], p0[9]); w.y = pg8::cvt_pk_bf16(p0[10], p0[11]); w.z = pg8::cvt_pk_bf16(p0[12], p0[13]); w.w = pg8::cvt_pk_bf16(p0[14], p0[15]); pw[1] = __builtin_bit_cast(bf16x8, w); \
          w.x = pg8::cvt_pk_bf16(p1[0], p1[1]); w.y = pg8::cvt_pk_bf16(p1[2], p1[3]); w.z = pg8::cvt_pk_bf16(p1[4], p1[5]); w.w = pg8::cvt_pk_bf16(p1[6], p1[7]); pw[2] = __builtin_bit_cast(bf16x8, w); \
          w.x = pg8::cvt_pk_bf16(p1[8], p1[9]); w.y = pg8::cvt_pk_bf16(p1[10], p1[11]); w.z = pg8::cvt_pk_bf16(p1[12], p1[13]); w.w = pg8::cvt_pk_bf16(p1[14], p1[15]); pw[3] = __builtin_bit_cast(bf16x8, w); } \
        SB_(); \
        TSTAMP(4); SB_(); \
          \
        if (HAS_NEXT) { \
            _Pragma("unroll") for (int r = 0; r < 16; ++r) { p0[r] = negmb; p1[r] = negmb; } \
            _Pragma("unroll") for (int d0 = 0; d0 < 4; ++d0) { p0 = mfma32(kf[2 * d0], qr[d0], p0); p1 = mfma32(kf[2 * d0 + 1], qr[d0], p1); } } \
        SB_(); \
        TSTAMP(5); SB_(); \
        if (!(ORD)) ATT_PV();                                                    \
        else { const LAS unsigned char* Vs = lds + VRING + vmod * 16384 + vb0; LD_V(pva, 0); }     \
        TSTAMP(6); \
        TACC(MODE); \
        kmod = kn; vmod = (vmod == 4) ? 0 : vmod + 1; } while (0)
    bf16x8 pw[4], pva[4];
#pragma unroll
    for (int i = 0; i < 4; ++i) { pw[i] = (bf16x8){0, 0, 0, 0, 0, 0, 0, 0}; pva[i] = pw[i]; }
    int kmod = 0, vmod = 0;
#if ATT_TIMING
    unsigned long long ts_[7]; unsigned tacc_[7] = {0u, 0u, 0u, 0u, 0u, 0u, 0u}, tsteps_ = 0u;
#endif
    ATT_STEP(0, 0, true, ORD);
#pragma unroll 1
    for (int ti = 1; ti < NT - 2; ++ti) ATT_STEP(ti, 1, true, ORD);
    ATT_STEP(NT - 2, 2, true, ORD);
    ATT_STEP(NT - 1, 2, false, ORD);
    if (ORD) { const LAS unsigned char* Vs = lds + VRING + ((vmod == 0) ? 4 : vmod - 1) * 16384 + vb0;
        bf16x8 va[4], vb[4];
        ATT_PV_B(); }
#if ATT_TIMING
    if (blockIdx.x == 100 && qb >= 32 && wave == ATT_TWAVE && tsteps_ > 0u) { int l3_; asm volatile("v_mbcnt_lo_u32_b32 %0, -1, 0\n\tv_mbcnt_hi_u32_b32 %0, -1, %0" : "=v"(l3_));
        if (l3_ == 0) __hip_atomic_store((float*)(P.ws + WS_CTL) + 7700, exp2f(rintf(log2f((float)tacc_[ATT_TSEG] / (float)tsteps_ + 1.0f) * 3.0f) * (1.0f / 3.0f)), __ATOMIC_RELAXED, __HIP_MEMORY_SCOPE_AGENT); }
#endif
#undef ATT_STEP
#undef ATT_PV
#undef ATT_PV_B
#undef SB_
#undef LD_V
#undef ATT_QK
    { int l2_; asm volatile("v_mbcnt_lo_u32_b32 %0, -1, 0\n\tv_mbcnt_hi_u32_b32 %0, -1, %0" : "=v"(l2_));
      lsum += __builtin_bit_cast(float, __builtin_amdgcn_ds_bpermute((l2_ ^ 32) << 2, __builtin_bit_cast(int, lsum))); }
    asm volatile("s_waitcnt lgkmcnt(0)" ::: "memory"); __builtin_amdgcn_s_barrier(); asm volatile("" ::: "memory");
    LAS float* wsf = (LAS float*)(lds + 131072) + wave * 32;
    LAS float* Xc = (LAS float*)lds;
    if (hh == 0) wsf[r32] = lsum;
    asm volatile("s_waitcnt lgkmcnt(0)" ::: "memory");
    float rl[16];
#pragma unroll
    for (int r = 0; r < 16; ++r) rl[r] = 1.0f / wsf[crow(r, hh)];
    if (map == 1) {
#pragma unroll
        for (int d0 = 0; d0 < 4; ++d0)
#pragma unroll
            for (int r = 0; r < 16; ++r) Xc[(32 * wq + crow(r, hh)) * 132 + 32 * d0 + r32] = o[d0][r] * rl[r];
    }
    __syncthreads();
    if (map == 0) { const float lam = __uint_as_float(fresh_misc(lds)[17]);
#pragma unroll
        for (int d0 = 0; d0 < 4; ++d0)
#pragma unroll
            for (int r = 0; r < 16; ++r) { LAS float* xp = Xc + (32 * wq + crow(r, hh)) * 132 + 32 * d0 + r32; *xp = o[d0][r] * rl[r] - lam * (*xp); }
    }
    __syncthreads();
    {
        const int row = tid >> 2, seg = tid & 3; float v[32]; float ss = 0.f;
#pragma unroll
        for (int i = 0; i < 8; ++i) { const f32x4 x4 = *(const LAS f32x4*)(Xc + row * 132 + 32 * seg + 4 * i); v[4 * i] = x4[0]; v[4 * i + 1] = x4[1]; v[4 * i + 2] = x4[2]; v[4 * i + 3] = x4[3];
            ss += (x4[0] * x4[0] + x4[1] * x4[1]) + (x4[2] * x4[2] + x4[3] * x4[3]); }
        ss += __shfl_xor(ss, 1); ss += __shfl_xor(ss, 2);
        const float rn = __builtin_amdgcn_rsqf(ss * (1.0f / 128.0f) + 1e-6f) * 0.8f;
        const float* gp = P.diff_norm + 32 * seg;
        bf16_t* mp = (bf16_t*)(P.ws + WS_MIX) + (size_t)(128 * qb + row) * 2048 + 1024 + h * 128 + 32 * seg;
#pragma unroll
        for (int i = 0; i < 4; ++i) { const f32x4 g0 = *(const f32x4*)(gp + 8 * i), g1 = *(const f32x4*)(gp + 8 * i + 4); u32x4 w;
            w.x = pk2(v[8 * i] * rn * g0[0], v[8 * i + 1] * rn * g0[1]); w.y = pk2(v[8 * i + 2] * rn * g0[2], v[8 * i + 3] * rn * g0[3]);
            w.z = pk2(v[8 * i + 4] * rn * g1[0], v[8 * i + 5] * rn * g1[1]); w.w = pk2(v[8 * i + 6] * rn * g1[2], v[8 * i + 7] * rn * g1[3]);
            *(u32x4*)(mp + 8 * i) = w; }
    }
    __syncthreads();
#undef ATT_DMA
#undef ATT_GLDS
}

__device__ __forceinline__ void attn_unit(const Params& P, int h, int qb, LAS unsigned char* lds, int tid, int wave, int lane) {
    if (__builtin_amdgcn_readfirstlane(wave) < 4) attn_unit_t<0>(P, h, qb, lds, tid, wave, lane); else attn_unit_t<1>(P, h, qb, lds, tid, wave, lane);
}
__device__ __forceinline__ void attn_phase(const Params& P, LAS unsigned char* lds, unsigned* ctl, unsigned* qhead, unsigned xcc, volatile LAS unsigned* misc, int tid, int wave, int lane) {
    using namespace cfg;
    { const float a1 = P.lq1[lane] * P.lk1[lane], a2 = P.lq2[lane] * P.lk2[lane]; float gq = fabsf(P.q_norm[lane]), gk = fabsf(P.k_norm[lane]);
      const float d1 = wave_sum(a1), d2 = wave_sum(a2);
#pragma unroll
      for (int o = 1; o < 64; o <<= 1) { int l_; asm volatile("v_mbcnt_lo_u32_b32 %0, -1, 0\n\tv_mbcnt_hi_u32_b32 %0, -1, %0" : "=v"(l_));
          const int ix_ = (l_ ^ o) << 2;
          gq = fmaxf(gq, __builtin_bit_cast(float, __builtin_amdgcn_ds_bpermute(ix_, __builtin_bit_cast(int, gq)))); gk = fmaxf(gk, __builtin_bit_cast(float, __builtin_amdgcn_ds_bpermute(ix_, __builtin_bit_cast(int, gk)))); }
      volatile LAS unsigned* m_ = fresh_misc(lds); m_[17] = __float_as_uint(__expf(d1) - __expf(d2) + 0.2f);
      m_[18] = __float_as_uint(-(0.18033688011112042f * 64.0f * gq * gk * 1.02f)); }
    int q = (int)(xcc & 7u);
    for (;;) {
        { int l_; asm volatile("v_mbcnt_lo_u32_b32 %0, -1, 0\n\tv_mbcnt_hi_u32_b32 %0, -1, %0" : "=v"(l_));
          if (wave == 0 && l_ == 0) { unsigned item = 0xffffffffu; int qq = q;
              for (int k = 0; k < 8; ++k) { const unsigned v = __hip_atomic_fetch_add(qhead + 64 * qq, 1u, __ATOMIC_RELAXED, __HIP_MEMORY_SCOPE_AGENT); if (v < 80u) { item = v | ((unsigned)qq << 8); break; } qq = (qq + 1) & 7; }
              fresh_misc(lds)[16] = item; } }
        __syncthreads();
        const unsigned it_ = (unsigned)__builtin_amdgcn_readfirstlane((int)fresh_misc(lds)[16]);
        __syncthreads();
        if (it_ == 0xffffffffu) break;
        const unsigned u = it_ & 0xffu; q = (int)(it_ >> 8);
        const int h = q;
        if (u >= 32u && u < 48u) {
            const int gi = (int)u - 32;
            const float* sinit = nullptr;
            {
                int l_; asm volatile("v_mbcnt_lo_u32_b32 %0, -1, 0\n\tv_mbcnt_hi_u32_b32 %0, -1, %0" : "=v"(l_));
                if (wave == 0 && l_ == 0) { unsigned sp = 0; while (__hip_atomic_load(ctl + CW_GFLAG + 64 * h, __ATOMIC_RELAXED, __HIP_MEMORY_SCOPE_AGENT) < (unsigned)(gi + 1)) { __builtin_amdgcn_s_sleep(8); if (++sp > (1u << 22)) break; }
                    sp = 0; while (__hip_atomic_load(ctl + CW_P2C + 4 * (16 * h + gi), __ATOMIC_RELAXED, __HIP_MEMORY_SCOPE_AGENT) < 8u) { __builtin_amdgcn_s_sleep(8); if (++sp > (1u << 22)) break; }
                    __builtin_amdgcn_fence(__ATOMIC_ACQUIRE, "agent"); asm volatile("s_waitcnt vmcnt(0)" ::: "memory"); }
                __syncthreads();
                sinit = (const float*)(P.ws + WS_SG + (size_t)(h * 16 + gi) * 65536);
            }
            gdn_scan(P, h, grp_start(gi), 8 * gi + 9, sinit, nullptr, lds, tid, wave, lane);
        } else {
            const int qb = (u < 32u) ? 63 - (int)u : 79 - (int)u;
            attn_unit(P, h, qb, lds, tid, wave, lane);
        }
    }
}

#ifndef PROBE_DUP
#define PROBE_DUP -1
#endif
#define PHASE_BEGIN() const CAS Params* pp_ = (const CAS Params*)__builtin_amdgcn_kernarg_segment_ptr(); asm volatile("" : "+s"(pp_)); Params P; P.x = (const float*)(const GAS float*)pp_->x; P.meta = (const float*)(const GAS float*)pp_->meta; P.attn_norm = (const float*)(const GAS float*)pp_->attn_norm; P.w_in = (const float*)(const GAS float*)pp_->w_in; P.conv_w = (const float*)(const GAS float*)pp_->conv_w; P.a_log = (const float*)(const GAS float*)pp_->a_log; P.dt_bias = (const float*)(const GAS float*)pp_->dt_bias; P.gdn_norm = (const float*)(const GAS float*)pp_->gdn_norm; P.q_norm = (const float*)(const GAS float*)pp_->q_norm; P.k_norm = (const float*)(const GAS float*)pp_->k_norm; P.lq1 = (const float*)(const GAS float*)pp_->lq1; P.lk1 = (const float*)(const GAS float*)pp_->lk1; P.lq2 = (const float*)(const GAS float*)pp_->lq2; P.lk2 = (const float*)(const GAS float*)pp_->lk2; P.diff_norm = (const float*)(const GAS float*)pp_->diff_norm; P.w_out = (const float*)(const GAS float*)pp_->w_out; P.ffn_norm = (const float*)(const GAS float*)pp_->ffn_norm; P.w_gu = (const float*)(const GAS float*)pp_->w_gu; P.w_dn = (const float*)(const GAS float*)pp_->w_dn; P.out = (float*)(GAS float*)pp_->out; P.ws = (unsigned char*)(GAS unsigned char*)pp_->ws; \
    int tid; asm volatile("v_mbcnt_lo_u32_b32 %0, -1, 0\n\tv_mbcnt_hi_u32_b32 %0, -1, %0" : "=v"(tid)); tid += wave0_ * 64; const int lane = tid & 63, wave = __builtin_amdgcn_readfirstlane(tid >> 6); \
    const int G = gridDim.x, bx = blockIdx.x, vcu = (G % 8 == 0) ? (bx % 8) * (G / 8) + bx / 8 : bx; (void)lane; (void)wave; (void)vcu; (void)bx
__global__ void __launch_bounds__(512, 2) hymba_fwd(Params Pk) {
    using namespace cfg;
    extern __shared__ __attribute__((aligned(16))) unsigned char lds_raw[];
    LAS unsigned char* lds = (LAS unsigned char*)lds_raw;
    volatile LAS unsigned* MISC = (volatile LAS unsigned*)(lds + MISC_OFF);
    const int wave0_ = __builtin_amdgcn_readfirstlane((int)threadIdx.x >> 6);
    XcdBarrier bar;
    {
        PHASE_BEGIN();
        unsigned* ctl = (unsigned*)(P.ws + WS_CTL);
        if (tid < 64) MISC[tid] = 0u;
        __syncthreads();
        bar = xcd_barrier_post(ctl + CW_BAR, MISC + 8);
    }

    for (int rep_ = 0; rep_ < (PROBE_DUP == 0 ? 2 : 1); ++rep_) {
    { PHASE_BEGIN(); p0_prep(P, lds, vcu, G, wave, lane); }
    xcd_barrier(bar); }
    if (PROBE_DUP == 10) { for (int i_ = 0; i_ < 8; ++i_) xcd_barrier(bar); }
    for (int rep_ = 0; rep_ < (PROBE_DUP == 1 ? 2 : 1); ++rep_) {
        PHASE_BEGIN();
        pg8::Gemm g{(const bf16_t*)(P.ws + WS_APAD), (const bf16_t*)(P.ws + WS_WIN), MP, NPROJ, 2048}; pg8::StaticOrder S; S.init(MP, NPROJ, G, bx);
        pg8::EpiInProj E{(const float*)(P.ws + WS_RSTD), (bf16_t*)(P.ws + WS_GRAW), (bf16_t*)(P.ws + WS_Q), (bf16_t*)(P.ws + WS_K), (bf16_t*)(P.ws + WS_V),
                         (float*)(P.ws + WS_BETA), (float*)(P.ws + WS_GDEC), P.q_norm, P.k_norm, P.a_log, P.dt_bias};
        pg8::gemm_phase<pg8::EpiInProj, pg8::StaticOrder, true, true>(lds, g, S, E, tid);
        { constexpr int NU = (MP / 256) * (NPROJ / 256), FIRST_IDLE = NU - (NU / 256) * 256;
          if (G == 256 && bx >= FIRST_IDLE && P1_IDLE_MASK && rep_ == 0) p0_convert(P, lds, (bx - FIRST_IDLE) * 8 + wave, (256 - FIRST_IDLE) * 8, wave, lane, P1_IDLE_MASK, GU_SPLIT, 32);
          else if (G != 256 && P1_IDLE_MASK && rep_ == 0) p0_convert(P, lds, vcu * 8 + wave, G * 8, wave, lane, P1_IDLE_MASK, GU_SPLIT, 32); }
        xcd_barrier(bar);
    }
    for (int rep_ = 0; rep_ < (PROBE_DUP == 2 ? 2 : 1); ++rep_) {
    { PHASE_BEGIN(); u32x4 raw[3][2][4]; float gb[2] = {0.f, 0.f};
      if (vcu < 1024) { GDN_LOAD_GB(gb, vcu & 7, (vcu >> 3) + 1, tid); GDN_LOAD_RAW(raw, vcu & 7, (vcu >> 3) + 1, tid); }
      for (int it = vcu; it < 1024; it += G) { const int nx = it + G; gdn_prep_item(P, it & 7, (it >> 3) + 1, raw, gb, nx & 7, (nx >> 3) + 1, nx < 1024, lds, tid, wave, lane); }
      DEP_PUBLISH_BEGIN() for (int it = vcu; it < 1024; it += G) __hip_atomic_fetch_add((unsigned*)(P.ws + WS_CTL) + CW_P2C + 4 * (16 * (it & 7) + (it >> 6)), 1u, __ATOMIC_RELAXED, __HIP_MEMORY_SCOPE_AGENT); DEP_PUBLISH_END() } }
    for (int rep_ = 0; rep_ < (PROBE_DUP == 7 ? 2 : 1); ++rep_) {
    { PHASE_BEGIN(); for (int it = bx; it < 240; it += G) { const int r_ = it >> 3; gdn_compose(P, it & 7, r_ >> 1, r_ & 1, lds, (unsigned*)(P.ws + WS_CTL), tid, wave, lane); } } }
    for (int rep_ = 0; rep_ < (PROBE_DUP == 3 ? 2 : 1); ++rep_) {
    if (blockIdx.x < 8) { PHASE_BEGIN(); gdn_carry(P, bx, lds, (unsigned*)(P.ws + WS_CTL) + 8192 * rep_, tid, wave, lane); }
    { PHASE_BEGIN(); attn_phase(P, lds, (unsigned*)(P.ws + WS_CTL) + 8192 * rep_, (unsigned*)(P.ws + WS_CTL) + 8192 * rep_ + CW_ATTQ, bar.x, MISC, tid, wave, lane); }
    xcd_barrier(bar); }
    for (int rep_ = 0; rep_ < (PROBE_DUP == 8 ? 2 : 1); ++rep_) {
        PHASE_BEGIN();
        pg8::Gemm g{(const bf16_t*)(P.ws + WS_MIX), (const bf16_t*)(P.ws + WS_WOUT), 8192, 2048, 2048}; pg8::StaticOrder S; S.init(8192, 2048, G, bx);
        pg8::EpiOutProj E{P.x, (bf16_t*)(P.ws + WS_H1B), (float*)(P.ws + WS_SSQ)};
        pg8::gemm_phase<pg8::EpiOutProj, pg8::StaticOrder, true, true>(lds, g, S, E, tid);
        xcd_barrier(bar);
    }
    for (int rep_ = 0; rep_ < (PROBE_DUP == 5 ? 2 : 1); ++rep_) {
        PHASE_BEGIN();
        pg8::Gemm g{(const bf16_t*)(P.ws + WS_H1B), (const bf16_t*)(P.ws + WS_WGU), 8192, 2 * DFF, 2048}; pg8::StaticOrder S; S.init(8192, 2 * DFF, G, bx);
        LAS float* rs2 = (LAS float*)(lds + 131072); int rs2_pm = -1;
        { pg8::Unit u0; if (S.next(0, u0)) { rs2_pm = u0.pm;
            if (tid < 256) { const pg8::f32x4* sp = (const pg8::f32x4*)((const float*)(P.ws + WS_SSQ) + (size_t)(256 * u0.pm + tid) * 32); pg8::f32x4 s4 = sp[0];
#pragma unroll
                for (int i = 1; i < 8; ++i) s4 += sp[i];
                rs2[tid] = __builtin_amdgcn_rsqf(((s4[0] + s4[1]) + (s4[2] + s4[3])) * (1.0f / 2048.0f) + 1e-6f); } }
          __syncthreads(); }
        pg8::EpiGateUp E{(const float*)(P.ws + WS_SSQ), (bf16_t*)(P.ws + WS_HID), rs2, rs2_pm};
        pg8::gemm_phase<pg8::EpiGateUp, pg8::StaticOrder, true, true>(lds, g, S, E, tid);
        { constexpr int NU = 32 * 44, FIRST_IDLE = NU - (NU / 256) * 256;
          if (G == 256 && bx >= FIRST_IDLE && P5_IDLE_MASK && rep_ == 0) p0_convert(P, lds, (bx - FIRST_IDLE) * 8 + wave, (256 - FIRST_IDLE) * 8, wave, lane, P5_IDLE_MASK);
          else if (G != 256 && P5_IDLE_MASK && rep_ == 0) p0_convert(P, lds, vcu * 8 + wave, G * 8, wave, lane, P5_IDLE_MASK); }
        xcd_barrier(bar);
    }
    for (int rep_ = (PROBE_DUP == 9 ? 0 : 1); rep_ < 2; ++rep_) {
        PHASE_BEGIN();
        pg8::Gemm g{(const bf16_t*)(P.ws + WS_HID), (const bf16_t*)(P.ws + WS_WDN), 8192, 2048, DFF}; pg8::StaticOrder S; S.init(8192, 2048, G, bx);
        pg8::EpiDown E{(const bf16_t*)(P.ws + WS_H1B), rep_ == 1 ? P.out : (float*)(P.ws + WS_GDNP)};
        pg8::gemm_phase<pg8::EpiDown, pg8::StaticOrder, true, true>(lds, g, S, E, tid);
        if (rep_ == 0) xcd_barrier(bar);
    }
#if ATT_TIMING
    xcd_barrier(bar);
    { PHASE_BEGIN(); if (bx == 0 && tid == 0) P.out[0] = __hip_atomic_load((float*)(P.ws + WS_CTL) + 7700, __ATOMIC_RELAXED, __HIP_MEMORY_SCOPE_AGENT); }
#endif
}

extern "C" void kernel_launch(void* const* d_in, const int* in_sizes, int n_in, void* d_out, int out_size, void* d_ws, size_t ws_size, hipStream_t stream) {
    using namespace cfg;
    static int grid = 0;
    if (grid == 0) {
        if (n_in != 19 || in_sizes[0] != SEQ * DMODEL || out_size != SEQ * DMODEL || ws_size < WS_END) {
            fprintf(stderr, "kernel_launch: unexpected shapes (n_in %d, in0 %d, out %d, ws %zu, need %zu); nothing launched\n", n_in, n_in > 0 ? in_sizes[0] : -1, out_size, ws_size, (size_t)WS_END); grid = -1; return; }
        int dev = 0, cus = 0, per_cu = 0;
        if (hipGetDevice(&dev) != hipSuccess || hipDeviceGetAttribute(&cus, hipDeviceAttributeMultiprocessorCount, dev) != hipSuccess) { fprintf(stderr, "kernel_launch: device query failed\n"); grid = -1; return; }
        if (hipFuncSetAttribute((const void*)hymba_fwd, hipFuncAttributeMaxDynamicSharedMemorySize, LDS_BYTES) != hipSuccess) { fprintf(stderr, "kernel_launch: hipFuncSetAttribute failed\n"); grid = -1; return; }
        if (hipOccupancyMaxActiveBlocksPerMultiprocessor(&per_cu, (const void*)hymba_fwd, 512, LDS_BYTES) != hipSuccess || per_cu < 1)
            fprintf(stderr, "kernel_launch: note: occupancy query reports %d workgroups per CU\n", per_cu);
        (void)hipGetLastError();
        grid = cus;
    }
    if (grid < 0) return;
    if (hipMemsetAsync((char*)d_ws + WS_CTL, 0, CTL_ZERO_BYTES, stream) != hipSuccess) { fprintf(stderr, "kernel_launch: memset failed\n"); return; }
    Params p{};
    const float** pp = (const float**)&p;
    for (int i = 0; i < 19; ++i) pp[i] = (const float*)d_in[i];
    p.out = (float*)d_out; p.ws = (unsigned char*)d_ws;
    hipLaunchKernelGGL(hymba_fwd, dim3(grid), dim3(512), LDS_BYTES, stream, p);
    const hipError_t le = hipPeekAtLastError();
    if (le != hipSuccess) fprintf(stderr, "kernel_launch: launch failed: %s\n", hipGetErrorName(le));
}
```

```cpp
#include <hip/hip_runtime.h>
#include <hip/hip_bf16.h>
#include <cstdio>
#include <cstdint>
#include <cmath>
#if defined(PROBE_DUP) && PROBE_DUP == 13
#define PG8_EPI_REP 3
#else
#define PG8_EPI_REP 1
#endif
namespace pg8 {
#define PG8_LAS __attribute__((address_space(3)))
typedef unsigned short bf16_t;
typedef short bf16x8 __attribute__((ext_vector_type(8)));
typedef float f32x4 __attribute__((ext_vector_type(4)));
typedef unsigned u32x4 __attribute__((ext_vector_type(4)));
constexpr int BM = 256, BK = 64, HALF = 128, HTB = HALF * BK * 2  , STAGE_BYTES = 8 * HTB, NXCD = 8, WGM = 8;

__host__ __device__ __forceinline__ int lds_byte(int r, int c) { const int st = (r >> 4) * 2 + (c >> 5), rr = r & 15, cc = c & 31, ob = rr * 64 + cc * 2; return st * 1024 + (ob ^ (((ob >> 9) & 1) << 5)); }
__host__ __device__ __forceinline__ void stage_rc(int b, int& R, int& C) { const int st = b / 1024, sb = b % 1024, swz = sb ^ (((sb >> 9) & 1) << 5); R = (st >> 1) * 16 + swz / 64; C = (st & 1) * 32 + (swz % 64) / 2; }
__host__ __device__ __forceinline__ int perm32(int rho) { const int n = rho >> 4, i = rho & 15; return 8 * (i >> 2) + 4 * n + (i & 3); }

struct Unit { int pm, pn; };
struct Gemm { const bf16_t* A; const bf16_t* Bt; int M, N, K; };

struct StaticOrder {
    int nM, nN, nwg, G, c;
    __host__ __device__ __attribute__((always_inline)) void init(int M, int N, int G_, int c_) { nM = M / BM; nN = N / BM; nwg = nM * nN; G = G_; c = c_; }
    __host__ __device__ __attribute__((always_inline)) bool next(int i, Unit& u) const {
        const long L = (long)i * G + c; if (L >= nwg) return false;
        int wgid = (int)L; { const int q = nwg / NXCD, r = nwg % NXCD, xcd = wgid % NXCD, off = wgid / NXCD; wgid = (xcd < r ? xcd * (q + 1) : r * (q + 1) + (xcd - r) * q) + off; }
        const int nig = WGM * nN, gid = wgid / nig, fm = gid * WGM, gsz = (nM - fm) < WGM ? (nM - fm) : WGM;
        u.pm = fm + ((wgid % nig) % gsz); u.pn = (wgid % nig) / gsz; return true;
    }
    __device__ __forceinline__ void a_ready(const Unit&) const {}
    __device__ __forceinline__ void done(const Unit&) const {}
};


__device__ __forceinline__ unsigned cvt_pk_bf16(float lo, float hi) { unsigned r; asm volatile("v_cvt_pk_bf16_f32 %0, %1, %2" : "=v"(r) : "v"(lo), "v"(hi)); return r; }
__device__ __forceinline__ u32x4 pack8(const f32x4 a, const f32x4 b) { u32x4 w; w.x = cvt_pk_bf16(a[0], a[1]); w.y = cvt_pk_bf16(a[2], a[3]); w.z = cvt_pk_bf16(b[0], b[1]); w.w = cvt_pk_bf16(b[2], b[3]); return w; }
__device__ __forceinline__ float silu_f(float v) { return v * __builtin_amdgcn_rcpf(1.0f + __builtin_amdgcn_exp2f(-1.4426950408889634f * v)); }

__constant__ float REV0[32] = {
    1.591549431e-01f, 1.193493785e-01f, 8.949940276e-02f, 6.711508467e-02f, 5.032921177e-02f, 3.774158578e-02f, 2.830219557e-02f, 2.122365077e-02f, 1.591549455e-02f, 1.193493619e-02f, 8.949940158e-03f, 6.711508704e-03f, 5.032920939e-03f, 3.774158578e-03f, 2.830219617e-03f, 2.122365373e-03f,
    1.591549395e-03f, 1.193493663e-03f, 8.949940158e-04f, 6.711507963e-04f, 5.032921162e-04f, 3.774158282e-04f, 2.830219617e-04f, 2.122365299e-04f, 1.591549507e-04f, 1.193493756e-04f, 8.949939787e-05f, 6.711508519e-05f, 5.032921069e-05f, 3.774158467e-05f, 2.830219570e-05f, 2.122365391e-05f};
__constant__ float REV1[32] = {
    1.859163579e-01f, 6.383602235e-01f, 7.279617768e-01f, 2.953654189e-01f, 2.210695530e-01f, 4.154614901e-01f, 8.113405167e-01f, 3.583136490e-01f, 1.859165097e-02f, 7.638359161e-01f, 5.727961701e-01f, 4.295365571e-01f, 3.221069401e-01f, 2.415461490e-01f, 1.811340555e-01f, 1.358313839e-01f,
    1.018591613e-01f, 7.638359446e-02f, 5.727961701e-02f, 4.295365096e-02f, 3.221069544e-02f, 2.415461300e-02f, 1.811340555e-02f, 1.358313791e-02f, 1.018591684e-02f, 7.638360038e-03f, 5.727961464e-03f, 4.295365452e-03f, 3.221069484e-03f, 2.415461419e-03f, 1.811340525e-03f, 1.358313851e-03f};

struct EpiInProj {
    static constexpr bool PERM = true, AFTER_DRAIN = false, INIT = false;
#if defined(PROBE_DUP) && PROBE_DUP == 14
    static constexpr int REP = 3;
#else
    static constexpr int REP = 1;
#endif
    const float* rstd;
    bf16_t* graw;
    bf16_t* qbuf;
    bf16_t* kimg;
    bf16_t* vimg;
    float* beta; float* gdec;
    const float* qn; const float* kn; const float* a_log; const float* dt_bias;
    __device__ __forceinline__ void operator()(const f32x4 (&acc)[2][2][4][2], const Unit& u, int wr, int wc, int fr, int fq) const {
        asm volatile("" : "+v"(fr), "+v"(fq));
        const int pn = u.pn, row0 = u.pm * BM + wr * 64 + fr;
        float rsv[2][4];
#pragma unroll
        for (int ai = 0; ai < 2; ++ai)
#pragma unroll
            for (int m = 0; m < 4; ++m) rsv[ai][m] = rstd[row0 + ai * HALF + m * 16];
        if (pn < 16) {
#pragma unroll
            for (int ai = 0; ai < 2; ++ai)
#pragma unroll
                for (int m = 0; m < 4; ++m) { const int row = row0 + ai * HALF + m * 16; const float rs = rsv[ai][m];
                    bf16_t* rowp = graw + (size_t)row * 4096 + pn * 256 + wc * 32 + 8 * fq;
#pragma unroll
                    for (int bj = 0; bj < 2; ++bj) *(u32x4*)(rowp + bj * HALF) = pack8(acc[ai][bj][m][0] * rs, acc[ai][bj][m][1] * rs); }
        } else if (pn < 24) {
            const int G = 4 * (pn - 16) + wc; const bool isK = G >= 16; const int hm = G & 15;
            const float* gp = (isK ? kn : qn) + 8 * fq;
            f32x4 gn[2][2];
#pragma unroll
            for (int bj = 0; bj < 2; ++bj)
#pragma unroll
                for (int n = 0; n < 2; ++n) gn[bj][n] = *(const f32x4*)(gp + 32 * bj + 4 * n);
            f32x4 rf0[2], rf1[2];
#pragma unroll
            for (int n = 0; n < 2; ++n) { rf0[n] = *(const f32x4*)(REV0 + 8 * fq + 4 * n); rf1[n] = *(const f32x4*)(REV1 + 8 * fq + 4 * n); }
            const float osc = isK ? 1.0f : 0.18033688011112042f;
#pragma unroll
            for (int ai = 0; ai < 2; ++ai)
#pragma unroll
                for (int m = 0; m < 4; ++m) { const int row = row0 + ai * HALF + m * 16; const float rs = rsv[ai][m];
                    f32x4 x[2][2]; float ss = 0.f;
#pragma unroll
                    for (int bj = 0; bj < 2; ++bj)
#pragma unroll
                        for (int n = 0; n < 2; ++n) { x[bj][n] = acc[ai][bj][m][n] * rs; ss += (x[bj][n][0] * x[bj][n][0] + x[bj][n][1] * x[bj][n][1]) + (x[bj][n][2] * x[bj][n][2] + x[bj][n][3] * x[bj][n][3]); }
                    ss += __shfl_xor(ss, 16); ss += __shfl_xor(ss, 32);
                    const float rn = __builtin_amdgcn_rsqf(ss * (1.0f / 64.0f) + 1e-6f) * osc;
                    const int pos = row < 48 ? 0 : row - 48; const float pa = (float)(pos >> 6), pb = (float)(pos & 63);
                    f32x4 o[2][2];
#pragma unroll
                    for (int n = 0; n < 2; ++n)
#pragma unroll
                        for (int j = 0; j < 4; ++j) {
                            const float fr_ = __builtin_amdgcn_fractf(pa * rf1[n][j] + pb * rf0[n][j]);
                            const float sn = __builtin_amdgcn_sinf(fr_), cs = __builtin_amdgcn_cosf(fr_);
                            const float y1 = x[0][n][j] * rn * gn[0][n][j], y2 = x[1][n][j] * rn * gn[1][n][j];
                            o[0][n][j] = y1 * cs - y2 * sn; o[1][n][j] = y2 * cs + y1 * sn; }
                    if (!isK) {
                        if (row >= 64 && row < 8256) { bf16_t* qp = qbuf + ((size_t)hm * 8192 + (row - 64)) * 64 + 8 * fq;
#pragma unroll
                            for (int bj = 0; bj < 2; ++bj) *(u32x4*)(qp + 32 * bj) = pack8(o[bj][0], o[bj][1]); }
                    } else if (row < 8256) { bf16_t* kp = kimg + ((size_t)(hm * 129 + (row >> 6)) * 8 + fq) * 512 + (row & 63) * 8;
#pragma unroll
                        for (int bj = 0; bj < 2; ++bj) *(u32x4*)(kp + bj * 4 * 512) = pack8(o[bj][0], o[bj][1]); }
                }
        } else if (pn < 28) {
#pragma unroll
            for (int ai = 0; ai < 2; ++ai)
#pragma unroll
                for (int m = 0; m < 4; ++m) { const int row = row0 + ai * HALF + m * 16; const float rs = rsv[ai][m];
                    if (row < 8256) {
#pragma unroll
                        for (int bj = 0; bj < 2; ++bj) { const int head = 2 * (pn - 24) + bj;
                            bf16_t* vp = vimg + ((size_t)(head * 129 + (row >> 6)) * 4 + wc) * 2048 + (row & 63) * 32 + 8 * fq;
                            *(u32x4*)vp = pack8(acc[ai][bj][m][0] * rs, acc[ai][bj][m][1] * rs); } } }
        } else {
            if (wc == 0 && fq < 2) {
                f32x4 dtb[2], ea[2];
#pragma unroll
                for (int n = 0; n < 2; ++n) { dtb[n] = *(const f32x4*)(dt_bias + 4 * n); const f32x4 al = *(const f32x4*)(a_log + 4 * n);
#pragma unroll
                    for (int j = 0; j < 4; ++j) ea[n][j] = __builtin_amdgcn_exp2f(1.4426950408889634f * al[j]); }
#pragma unroll
                for (int ai = 0; ai < 2; ++ai)
#pragma unroll
                    for (int m = 0; m < 4; ++m) { const int row = row0 + ai * HALF + m * 16; const float rs = rsv[ai][m];
                        if (row < 8256) {
#pragma unroll
                            for (int n = 0; n < 2; ++n)
#pragma unroll
                                for (int j = 0; j < 4; ++j) { const int hd = 4 * n + j; const float v = acc[ai][0][m][n][j] * rs; float r;
                                    if (fq == 0) { r = __builtin_amdgcn_rcpf(1.0f + __builtin_amdgcn_exp2f(-1.4426950408889634f * v)); if (row < 48) r = 0.f; beta[(size_t)hd * 8256 + row] = r; }
                                    else { const float y = v + dtb[n][j]; const float ey = __builtin_amdgcn_exp2f(1.4426950408889634f * y);
                                        const float sp = (y > 15.f) ? y : ((ey < 1e-4f) ? ey : 0.6931471805599453f * __builtin_amdgcn_logf(1.0f + ey));
                                        r = -ea[n][j] * sp; if (row < 48) r = 0.f; gdec[(size_t)hd * 8256 + row] = r; } } } }
            }
        }
    }
};

struct EpiOutProj {
    static constexpr bool PERM = true, AFTER_DRAIN = false, INIT = true; static constexpr int REP = 1;
    const float* x; bf16_t* h1b; float* ssq;
    __device__ __forceinline__ void init(f32x4 (&acc)[2][2][4][2], const Unit& u, int wr, int wc, int fr, int fq) const {
        asm volatile("" : "+v"(fr), "+v"(fq));
        const int row0 = u.pm * BM + wr * 64 + fr, col0 = u.pn * BM + wc * 32 + 8 * fq;
#pragma unroll
        for (int ai = 0; ai < 2; ++ai)
#pragma unroll
            for (int m = 0; m < 4; ++m) { const size_t off = (size_t)(row0 + ai * HALF + m * 16) * 2048 + col0;
#pragma unroll
                for (int bj = 0; bj < 2; ++bj)
#pragma unroll
                    for (int n = 0; n < 2; ++n) acc[ai][bj][m][n] = *(const f32x4*)(x + off + bj * HALF + 4 * n); }
    }
    __device__ __forceinline__ void operator()(const f32x4 (&acc)[2][2][4][2], const Unit& u, int wr, int wc, int fr, int fq) const {
        asm volatile("" : "+v"(fr), "+v"(fq));
        const int row0 = u.pm * BM + wr * 64 + fr, col0 = u.pn * BM + wc * 32 + 8 * fq;
        int l_; asm volatile("v_mbcnt_lo_u32_b32 %0, -1, 0\n\tv_mbcnt_hi_u32_b32 %0, -1, %0" : "=v"(l_));
        const int ix16 = (l_ ^ 16) << 2, ix32 = (l_ ^ 32) << 2;
#pragma unroll
        for (int ai = 0; ai < 2; ++ai)
#pragma unroll
            for (int m = 0; m < 4; ++m) { const int row = row0 + ai * HALF + m * 16; const size_t off = (size_t)row * 2048 + col0; float ss = 0.f;
#pragma unroll
                for (int bj = 0; bj < 2; ++bj) {
#pragma unroll
                    for (int n = 0; n < 2; ++n) { const f32x4 v = acc[ai][bj][m][n]; ss += (v[0] * v[0] + v[1] * v[1]) + (v[2] * v[2] + v[3] * v[3]); }
                    *(u32x4*)(h1b + off + bj * HALF) = pack8(acc[ai][bj][m][0], acc[ai][bj][m][1]); }
                ss += __builtin_bit_cast(float, __builtin_amdgcn_ds_bpermute(ix16, __builtin_bit_cast(int, ss))); ss += __builtin_bit_cast(float, __builtin_amdgcn_ds_bpermute(ix32, __builtin_bit_cast(int, ss)));
                if (fq == 0) ssq[(size_t)row * 32 + u.pn * 4 + wc] = ss; }
    }
};

struct EpiGateUp {
    static constexpr bool PERM = true, AFTER_DRAIN = false, INIT = false; static constexpr int REP = 1;
    const float* ssq; bf16_t* hid; const PG8_LAS float* rs2; int rs2_pm;
    __device__ __forceinline__ void operator()(const f32x4 (&acc)[2][2][4][2], const Unit& u, int wr, int wc, int fr, int fq) const {
        asm volatile("" : "+v"(fr), "+v"(fq));
        const int row0 = u.pm * BM + wr * 64 + fr, col0 = u.pn * HALF + wc * 32 + 8 * fq;
        float rsv[2][4];
        if (u.pm == rs2_pm) {
#pragma unroll
            for (int ai = 0; ai < 2; ++ai)
#pragma unroll
                for (int m = 0; m < 4; ++m) rsv[ai][m] = rs2[wr * 64 + fr + ai * HALF + m * 16];
        } else {
#pragma unroll
            for (int ai = 0; ai < 2; ++ai)
#pragma unroll
                for (int m = 0; m < 4; ++m) { const f32x4* sp = (const f32x4*)(ssq + (size_t)(row0 + ai * HALF + m * 16) * 32); f32x4 s4 = sp[0];
#pragma unroll
                    for (int i = 1; i < 8; ++i) s4 += sp[i];
                    rsv[ai][m] = __builtin_amdgcn_rsqf(((s4[0] + s4[1]) + (s4[2] + s4[3])) * (1.0f / 2048.0f) + 1e-6f); }
        }
#pragma unroll
        for (int ai = 0; ai < 2; ++ai)
#pragma unroll
            for (int m = 0; m < 4; ++m) { const int row = row0 + ai * HALF + m * 16; const float rs = rsv[ai][m];
                f32x4 hv[2];
#pragma unroll
                for (int n = 0; n < 2; ++n)
#pragma unroll
                    for (int j = 0; j < 4; ++j) { const float g = acc[ai][0][m][n][j] * rs, up = acc[ai][1][m][n][j] * rs; hv[n][j] = silu_f(g) * up; }
                *(u32x4*)(hid + (size_t)row * 5632 + col0) = pack8(hv[0], hv[1]); }
    }
};

struct EpiDown {
    static constexpr bool PERM = true, AFTER_DRAIN = false, INIT = true; static constexpr int REP = 1;
    const bf16_t* h1b; float* out;
    __device__ __forceinline__ void init(f32x4 (&acc)[2][2][4][2], const Unit& u, int wr, int wc, int fr, int fq) const {
        asm volatile("" : "+v"(fr), "+v"(fq));
        const int row0 = u.pm * BM + wr * 64 + fr, col0 = u.pn * BM + wc * 32 + 8 * fq;
#pragma unroll
        for (int ai = 0; ai < 2; ++ai)
#pragma unroll
            for (int m = 0; m < 4; ++m)
#pragma unroll
                for (int bj = 0; bj < 2; ++bj) { const u32x4 h4 = *(const u32x4*)(h1b + (size_t)(row0 + ai * HALF + m * 16) * 2048 + col0 + bj * HALF);
                    f32x4 r0, r1;
                    r0[0] = __uint_as_float(h4.x << 16); r0[1] = __uint_as_float(h4.x & 0xffff0000u); r0[2] = __uint_as_float(h4.y << 16); r0[3] = __uint_as_float(h4.y & 0xffff0000u);
                    r1[0] = __uint_as_float(h4.z << 16); r1[1] = __uint_as_float(h4.z & 0xffff0000u); r1[2] = __uint_as_float(h4.w << 16); r1[3] = __uint_as_float(h4.w & 0xffff0000u);
                    acc[ai][bj][m][0] = r0; acc[ai][bj][m][1] = r1; }
    }
    __device__ __forceinline__ void operator()(const f32x4 (&acc)[2][2][4][2], const Unit& u, int wr, int wc, int fr, int fq) const {
        asm volatile("" : "+v"(fr), "+v"(fq));
        const int row0 = u.pm * BM + wr * 64 + fr, col0 = u.pn * BM + wc * 32 + 8 * fq;
#pragma unroll
        for (int ai = 0; ai < 2; ++ai)
#pragma unroll
            for (int m = 0; m < 4; ++m) { const size_t off = (size_t)(row0 + ai * HALF + m * 16) * 2048 + col0;
#pragma unroll
                for (int bj = 0; bj < 2; ++bj) { *(f32x4*)(out + off + bj * HALF) = acc[ai][bj][m][0]; *(f32x4*)(out + off + bj * HALF + 4) = acc[ai][bj][m][1]; } }
    }
};

template <class Epi, class Sched, bool ALIGN_EPI = false, bool SP2 = false>
__device__ __forceinline__ void gemm_phase(PG8_LAS unsigned char* lds, const Gemm g, const Sched& S, const Epi& E, int tid_in) {
    int tid = tid_in; asm volatile("" : "+v"(tid)); const int wid = __builtin_amdgcn_readfirstlane(tid >> 6), lane = tid & 63, wr = wid >> 2, wc = wid & 3, fr = lane & 15, fq = lane >> 4;
    const int K = g.K, nt = K / BK;
    unsigned voffA[2], voffB[2];
#pragma unroll
    for (int i = 0; i < 2; ++i) { int R, C; stage_rc(tid * 16 + i * 8192, R, C); const int Rb = Epi::PERM ? ((R & ~31) + perm32(R & 31)) : R;
        voffA[i] = (unsigned)(R * K + C) * 2u; voffB[i] = (unsigned)(Rb * K + C) * 2u; }
    const size_t kstep = (size_t)(BK * 2);
    const size_t hstep = (size_t)HALF * K * 2;
    const size_t tstep = 2 * hstep;
    const unsigned ldsw = (unsigned)wid * 1024u;
    const int aoff = lds_byte(wr * 64 + fr, fq * 8), boff = lds_byte(wc * 32 + fr, fq * 8);
#define PG8_SA(b, h) (((b) * 2 + (h)) * HTB)
#define PG8_SB(b, h) ((4 + (b) * 2 + (h)) * HTB)
#define PG8_STAGE(bufoff, gbase, voff) do { _Pragma("unroll") for (int _i = 0; _i < 2; ++_i) \
        __builtin_amdgcn_global_load_lds((const unsigned*)((const char*)(gbase) + (voff)[_i]), (PG8_LAS unsigned*)(lds + (bufoff) + ldsw + _i * 8192), 16, 0, 0); } while (0)
#define PG8_LDA(dst, b, h) do { _Pragma("unroll") for (int m = 0; m < 4; ++m) _Pragma("unroll") for (int k = 0; k < 2; ++k) dst[m][k] = *(const PG8_LAS bf16x8*)(lds + PG8_SA(b, h) + aoff + m * 2048 + k * 1024); } while (0)
#define PG8_LDB(dst, b, h) do { _Pragma("unroll") for (int n = 0; n < 2; ++n) _Pragma("unroll") for (int k = 0; k < 2; ++k) dst[n][k] = *(const PG8_LAS bf16x8*)(lds + PG8_SB(b, h) + boff + n * 2048 + k * 1024); } while (0)
#define PG8_MMA(ai, bj, At, Bt) do { __builtin_amdgcn_s_setprio(1); _Pragma("unroll") for (int m = 0; m < 4; ++m) _Pragma("unroll") for (int n = 0; n < 2; ++n) _Pragma("unroll") for (int k = 0; k < 2; ++k) \
        acc[ai][bj][m][n] = __builtin_amdgcn_mfma_f32_16x16x32_bf16(Bt[n][k], At[m][k], acc[ai][bj][m][n], 0, 0, 0); __builtin_amdgcn_s_setprio(0); } while (0)
#define PG8_WAIT_V(n) asm volatile("s_waitcnt vmcnt(" #n ")" ::: "memory")
#define PG8_WAIT_L(n) asm volatile("s_waitcnt lgkmcnt(" #n ")" ::: "memory")
#define PG8_BAR __builtin_amdgcn_s_barrier()
#define PG8_SCHED __builtin_amdgcn_sched_barrier(0)
    Unit cur, nxt; int ui = 0;
    if (!S.next(0, cur)) return;
    f32x4 acc[2][2][4][2];
    if constexpr (Epi::INIT) E.init(acc, cur, wr, wc, fr, fq);
    else {
#pragma unroll
    for (int a = 0; a < 2; ++a)
#pragma unroll
        for (int b = 0; b < 2; ++b)
#pragma unroll
            for (int m = 0; m < 4; ++m)
#pragma unroll
                for (int n = 0; n < 2; ++n) acc[a][b][m][n] = (f32x4){0.f, 0.f, 0.f, 0.f};
    }
    bf16x8 At[4][2], B0[2][2], B1[2][2];
    const char* cA = (const char*)g.A + (size_t)cur.pm * tstep; const char* cB = (const char*)g.Bt + (size_t)cur.pn * tstep;
    S.a_ready(cur);
    if constexpr (SP2) {
        PG8_STAGE(PG8_SB(0, 0), cB, voffB); PG8_STAGE(PG8_SB(0, 1), cB + hstep, voffB); PG8_STAGE(PG8_SA(0, 0), cA, voffA); PG8_STAGE(PG8_SA(0, 1), cA + hstep, voffA);
        if (wr == 1) PG8_BAR;
        PG8_WAIT_V(2); PG8_BAR;
        PG8_STAGE(PG8_SB(1, 0), cB + kstep, voffB); PG8_STAGE(PG8_SA(1, 0), cA + kstep, voffA); PG8_STAGE(PG8_SB(1, 1), cB + hstep + kstep, voffB);
        PG8_WAIT_V(6); PG8_BAR;
    } else {
        PG8_STAGE(PG8_SB(0, 0), cB, voffB); PG8_STAGE(PG8_SA(0, 0), cA, voffA); PG8_STAGE(PG8_SB(0, 1), cB + hstep, voffB); PG8_STAGE(PG8_SA(0, 1), cA + hstep, voffA);
        if (wr == 1) PG8_BAR;
        PG8_WAIT_V(4); PG8_BAR;
        PG8_STAGE(PG8_SB(1, 0), cB + kstep, voffB); PG8_STAGE(PG8_SA(1, 0), cA + kstep, voffA); PG8_STAGE(PG8_SB(1, 1), cB + hstep + kstep, voffB);
        PG8_WAIT_V(6); PG8_BAR;
    }
    for (;;) {
        const bool has_next = S.next(ui + 1, nxt);
        const char* nA = has_next ? (const char*)g.A + (size_t)nxt.pm * tstep : cA; const char* nB = has_next ? (const char*)g.Bt + (size_t)nxt.pn * tstep : cB;
        for (int t = 0; t < nt; t += 2) {
            const bool last = (t == nt - 2);
            const char* a1 = cA + (size_t)(t + 1) * kstep;
            const char* a2 = last ? nA : cA + (size_t)(t + 2) * kstep; const char* b2 = last ? nB : cB + (size_t)(t + 2) * kstep;
            const char* a3 = a2 + kstep; const char* b3 = b2 + kstep;
            if (last && has_next) S.a_ready(nxt);
            if constexpr (SP2) {
            PG8_LDB(B0, 0, 0); PG8_LDB(B1, 0, 1); PG8_SCHED; PG8_LDA(At, 0, 0); PG8_STAGE(PG8_SA(1, 1), a1 + hstep, voffA);
            PG8_WAIT_V(8); PG8_WAIT_L(0); PG8_BAR; PG8_MMA(0, 0, At, B0); PG8_MMA(0, 1, At, B1); PG8_BAR; PG8_SCHED;
            PG8_LDA(At, 0, 1); PG8_STAGE(PG8_SB(0, 0), b2, voffB); PG8_STAGE(PG8_SB(0, 1), b2 + hstep, voffB); PG8_STAGE(PG8_SA(0, 0), a2, voffA);
            PG8_WAIT_V(8); PG8_WAIT_L(0); PG8_BAR; PG8_MMA(1, 0, At, B0); PG8_MMA(1, 1, At, B1); PG8_BAR; PG8_SCHED;
            PG8_LDB(B0, 1, 0); PG8_LDB(B1, 1, 1); PG8_SCHED; PG8_LDA(At, 1, 0); PG8_STAGE(PG8_SA(0, 1), a2 + hstep, voffA);
            PG8_WAIT_V(8); PG8_WAIT_L(0); PG8_BAR; PG8_MMA(0, 0, At, B0); PG8_MMA(0, 1, At, B1); PG8_BAR; PG8_SCHED;
            PG8_LDA(At, 1, 1); PG8_STAGE(PG8_SB(1, 0), b3, voffB); PG8_STAGE(PG8_SB(1, 1), b3 + hstep, voffB); PG8_STAGE(PG8_SA(1, 0), a3, voffA);
            PG8_WAIT_V(8); PG8_WAIT_L(0); PG8_BAR; PG8_MMA(1, 0, At, B0); PG8_MMA(1, 1, At, B1); PG8_BAR; PG8_SCHED;
            } else {
            PG8_LDB(B0, 0, 0); PG8_SCHED; PG8_LDA(At, 0, 0); PG8_STAGE(PG8_SA(1, 1), a1 + hstep, voffA);
            PG8_WAIT_L(8); PG8_BAR; PG8_WAIT_L(0); PG8_MMA(0, 0, At, B0); PG8_BAR; PG8_SCHED;
            PG8_LDB(B1, 0, 1); PG8_STAGE(PG8_SB(0, 0), b2, voffB);
            PG8_BAR; PG8_WAIT_L(0); PG8_MMA(0, 1, At, B1); PG8_BAR;
            PG8_LDA(At, 0, 1); PG8_STAGE(PG8_SA(0, 0), a2, voffA);
            PG8_BAR; PG8_WAIT_L(0); PG8_MMA(1, 0, At, B0); PG8_BAR; PG8_SCHED;
            PG8_STAGE(PG8_SB(0, 1), b2 + hstep, voffB);
            PG8_WAIT_V(6); PG8_BAR; PG8_MMA(1, 1, At, B1); PG8_BAR;
            PG8_LDB(B0, 1, 0); PG8_SCHED; PG8_LDA(At, 1, 0); PG8_STAGE(PG8_SA(0, 1), a2 + hstep, voffA);
            PG8_WAIT_L(8); PG8_BAR; PG8_WAIT_L(0); PG8_MMA(0, 0, At, B0); PG8_BAR; PG8_SCHED;
            PG8_LDB(B1, 1, 1); PG8_STAGE(PG8_SB(1, 0), b3, voffB);
            PG8_BAR; PG8_WAIT_L(0); PG8_MMA(0, 1, At, B1); PG8_BAR;
            PG8_LDA(At, 1, 1); PG8_STAGE(PG8_SA(1, 0), a3, voffA);
            PG8_BAR; PG8_WAIT_L(0); PG8_MMA(1, 0, At, B0); PG8_BAR; PG8_SCHED;
            PG8_STAGE(PG8_SB(1, 1), b3 + hstep, voffB);
            PG8_WAIT_V(6); PG8_BAR; PG8_MMA(1, 1, At, B1); PG8_BAR;
            }
        }
        if constexpr (ALIGN_EPI) { if (wr == 0) PG8_BAR; }
        if constexpr (!Epi::AFTER_DRAIN) { for (int rp_ = 0; rp_ < PG8_EPI_REP * Epi::REP; ++rp_) E(acc, cur, wr, wc, fr, fq); S.done(cur); }
        if (!has_next) break;
        if constexpr (Epi::INIT) E.init(acc, nxt, wr, wc, fr, fq);
        else {
#pragma unroll
        for (int a = 0; a < 2; ++a)
#pragma unroll
            for (int b = 0; b < 2; ++b)
#pragma unroll
                for (int m = 0; m < 4; ++m)
#pragma unroll
                    for (int n = 0; n < 2; ++n) acc[a][b][m][n] = (f32x4){0.f, 0.f, 0.f, 0.f};
        }
        cur = nxt; cA = nA; cB = nB; ++ui;
        if constexpr (ALIGN_EPI) { if (wr == 1) PG8_BAR; }
    }
    PG8_WAIT_V(0);
    if constexpr (!ALIGN_EPI) { if (wr == 0) PG8_BAR; }
    PG8_BAR;
    if constexpr (Epi::AFTER_DRAIN) { E.fused(acc, cur, wr, wc, fr, fq, lds, wid, lane); S.done(cur); }
#undef PG8_SA
#undef PG8_SB
#undef PG8_STAGE
#undef PG8_LDA
#undef PG8_LDB
#undef PG8_MMA
#undef PG8_WAIT_V
#undef PG8_WAIT_L
#undef PG8_BAR
#undef PG8_SCHED
}
}
#define GAS __attribute__((address_space(1)))
#define LAS __attribute__((address_space(3)))
typedef unsigned short bf16;
typedef unsigned v4u __attribute__((ext_vector_type(4)));
typedef float f32x4 __attribute__((ext_vector_type(4)));
typedef short bf16x8 __attribute__((ext_vector_type(8)));
typedef GAS unsigned gu32;
typedef GAS unsigned long long gu64;
#define RLX_AGENT __ATOMIC_RELAXED, __HIP_MEMORY_SCOPE_AGENT
#define LDS_WAIT() asm volatile("s_waitcnt lgkmcnt(0)" ::: "memory")
#define VM_WAIT() asm volatile("s_waitcnt vmcnt(0)" ::: "memory")
__device__ __forceinline__ unsigned long long rt() { return __builtin_amdgcn_s_memrealtime(); }
__device__ __forceinline__ unsigned f2bf(float f) { unsigned u = __builtin_bit_cast(unsigned, f); return (u + 0x7fffu + ((u >> 16) & 1u)) >> 16; }
typedef float f32x2_cv __attribute__((ext_vector_type(2))); typedef __bf16 bf16x2_cv __attribute__((ext_vector_type(2)));
__device__ __forceinline__ unsigned pk2(float lo, float hi) { const f32x2_cv v = {lo, hi}; return __builtin_bit_cast(unsigned, __builtin_convertvector(v, bf16x2_cv)); }

#define XB_TMO      128
#define XB_XCNT(j)  (256  + 64 * (j))
#define XB_XSUB(j)  (1280 + 64 * (j))
#define XB_XGEN(j)  (2304 + 64 * (j))
#define XB_TOP      3328
#define XB_TOPGEN   3392
#define XCD_BAR_WORDS 3456
#define XB_SPIN_CAP (1u << 18)

__device__ __forceinline__ unsigned xb_ld(unsigned* p)              { return __hip_atomic_load(p, __ATOMIC_RELAXED, __HIP_MEMORY_SCOPE_AGENT); }
__device__ __forceinline__ unsigned xb_add(unsigned* p, unsigned v) { return __hip_atomic_fetch_add(p, v, __ATOMIC_RELAXED, __HIP_MEMORY_SCOPE_AGENT); }
__device__ __forceinline__ unsigned xb_xcc_id() { return (unsigned)__builtin_amdgcn_s_getreg((3 << 11) | 20) & 0xFu; }
#define XB_SPIN(cond, bar) do { unsigned _sp = 0; while (cond) { __builtin_amdgcn_s_sleep(1); \
    if ((++_sp & 255u) == 0u) { if (xb_ld(&(bar)[XB_TMO])) break; if (_sp > XB_SPIN_CAP) { atomicAdd(&(bar)[XB_TMO], 1u); break; } } } } while (0)

struct XcdBarrier {
    unsigned* bar; unsigned x;
    volatile LAS unsigned* st;
};

__device__ __forceinline__ XcdBarrier xcd_barrier_post(unsigned* bar, volatile LAS unsigned* st) {
    XcdBarrier b; b.bar = bar; b.x = xb_xcc_id(); b.st = st;
    if (threadIdx.x == 0) (void)xb_add(&bar[XB_XCNT(b.x)], 1u);
    return b;
}
__device__ __forceinline__ void xcd_barrier_complete(unsigned* bar, unsigned x, unsigned& nloc, unsigned& nx) {
    const unsigned G = gridDim.x * gridDim.y * gridDim.z;
    unsigned sum, cnt, mine, sp = 0u;
    for (;;) {
        sum = 0u; cnt = 0u; mine = 0u;
#pragma unroll
        for (unsigned j = 0; j < 16; ++j) { const unsigned c = xb_ld(&bar[XB_XCNT(j)]); sum += c; cnt += (c > 0u) ? 1u : 0u; mine = (j == x) ? c : mine; }
        if (sum == G) break;
        __builtin_amdgcn_s_sleep(1);
        if ((++sp & 255u) == 0u) { if (xb_ld(&bar[XB_TMO])) break; if (sp > XB_SPIN_CAP) { atomicAdd(&bar[XB_TMO], 1u); break; } }
    }
    nloc = mine > 0u ? mine : 1u; nx = cnt > 0u ? cnt : 1u;
}

__device__ __forceinline__ void xcd_barrier(const XcdBarrier& b) {
    asm volatile("s_waitcnt vmcnt(0)" ::: "memory");
    __syncthreads();
    if (threadIdx.x == 0) {
        unsigned* bar = b.bar;
        __builtin_amdgcn_s_waitcnt(0);
        unsigned nloc = b.st[0], nx = b.st[1];
        if (nloc == 0u) { xcd_barrier_complete(bar, b.x, nloc, nx); b.st[0] = nloc; b.st[1] = nx; }
        const unsigned old = xb_add(&bar[XB_XSUB(b.x)], 1u);
        const unsigned gen = old / nloc;
        if (old + 1u == (gen + 1u) * nloc) {
            __builtin_amdgcn_fence(__ATOMIC_RELEASE, "agent");
            asm volatile("s_waitcnt vmcnt(0)" ::: "memory");
            const unsigned og = xb_add(&bar[XB_TOP], 1u);
            const unsigned tg = og / nx;
            if (og + 1u == (tg + 1u) * nx) xb_add(&bar[XB_TOPGEN], 1u);
            else XB_SPIN(xb_ld(&bar[XB_TOPGEN]) == tg, bar);
            __builtin_amdgcn_fence(__ATOMIC_ACQUIRE, "agent");
            xb_add(&bar[XB_XGEN(b.x)], 1u);
            asm volatile("s_waitcnt vmcnt(0)" ::: "memory");
        } else {
            XB_SPIN(xb_ld(&bar[XB_XGEN(b.x)]) == gen, bar);
            __builtin_amdgcn_fence(__ATOMIC_ACQUIRE, "agent");
            asm volatile("s_waitcnt vmcnt(0)" ::: "memory");
        }
    }
    __syncthreads();
}


namespace cfg {
constexpr int DMODEL = 2048, SEQ = 8192;
constexpr int LP = 8256;
constexpr int MP = 8448;
constexpr int NCH = 129;
constexpr int NPROJ = 7424;
constexpr int WIN_N = 7184;
constexpr int DFF = 5632;
constexpr size_t MiB = 1u << 20;
constexpr size_t WS_CTL = 0, CTL_ZERO_BYTES = 65536;
constexpr size_t WS_WOUT = 1 * MiB;
constexpr size_t WS_WGU = WS_WOUT + (size_t)2048 * 2048 * 2;
constexpr size_t WS_WDN = WS_WGU + (size_t)11264 * 2048 * 2;
constexpr size_t R1 = WS_WDN + (size_t)2048 * 5632 * 2;
constexpr size_t WS_WIN = R1;
constexpr size_t WS_APAD = WS_WIN + (size_t)NPROJ * 2048 * 2;
constexpr size_t WS_MIX = R1;
constexpr size_t WS_H1B = R1 + (size_t)8192 * 2048 * 2;
constexpr size_t WS_MG = WS_H1B;
constexpr size_t WS_CG = WS_MG + (size_t)8 * 15 * 32768;
constexpr size_t WS_SG = WS_CG + (size_t)8 * 15 * 65536;
constexpr size_t R2 = R1 + (size_t)2 * 8192 * 2048 * 2;
static_assert(WS_SG + (size_t)8 * 16 * 65536 <= R2, "group tables fit the H1B region");
static_assert(WS_APAD + (size_t)MP * 2048 * 2 <= R2, "R1");
constexpr size_t WS_GRAW = R2;
constexpr size_t WS_HID = R2;
constexpr size_t R3 = R2 + (size_t)MP * 4096 * 2;
constexpr size_t WS_Q = R3;
constexpr size_t WS_K = WS_Q + (size_t)16 * 8192 * 64 * 2;
constexpr size_t WS_V = WS_K + (size_t)16 * 129 * 4096 * 2;
constexpr size_t WS_RSTD = WS_V + (size_t)8 * 129 * 8192 * 2;
constexpr size_t WS_BETA = WS_RSTD + (size_t)MP * 4;
constexpr size_t WS_GDEC = WS_BETA + (size_t)8 * LP * 4;
constexpr size_t WS_SSQ = WS_GDEC + (size_t)8 * LP * 4;
constexpr size_t R4 = WS_SSQ + (size_t)8192 * 32 * 4;
static_assert(WS_HID + (size_t)8192 * DFF * 2 <= WS_RSTD, "hidden overlay must stay below the small f32 tables");
constexpr size_t GI_WQ = 0, GI_ATT = 32768, GI_KDT = 40960, GI_UT = 57344, GI_EG = 90112, GI_BYTES = 90368;
constexpr size_t WS_GDNP = R4;
constexpr size_t WS_END = WS_GDNP + (size_t)8 * NCH * GI_BYTES;
static_assert(WS_WGU % 256 == 0 && WS_WDN % 256 == 0 && R1 % 256 == 0 && WS_APAD % 256 == 0 && R2 % 256 == 0 && R3 % 256 == 0 && WS_K % 256 == 0 && WS_V % 256 == 0 && WS_RSTD % 256 == 0 && WS_BETA % 256 == 0 && WS_GDEC % 256 == 0 && WS_SSQ % 256 == 0 && R4 % 256 == 0, "alignment");
#ifndef PROBE_DUP
#define PROBE_DUP -1
#endif
constexpr int CW_BAR = 4096;
constexpr int CW_ATTQ = 1024;
constexpr int CW_GFLAG = 2048;
constexpr int CW_P2C = 2560;
constexpr int CW_CMP = 3072;
constexpr int P0_MASK = 1 | 4, P1_IDLE_MASK = 2 | 4, P5_IDLE_MASK = 8, GU_SPLIT = 10;
constexpr int LDS_BYTES = 163840;
constexpr int MISC_OFF = LDS_BYTES - 256;
}
#define CAS __attribute__((address_space(4)))
using pg8::bf16_t; using pg8::bf16x8; using pg8::u32x4;
typedef float f32x16 __attribute__((ext_vector_type(16)));
typedef short s16x4 __attribute__((ext_vector_type(4)));
typedef unsigned u32x2 __attribute__((ext_vector_type(2)));

struct Params {
    const float *x, *meta, *attn_norm, *w_in, *conv_w, *a_log, *dt_bias, *gdn_norm, *q_norm, *k_norm, *lq1, *lk1, *lq2, *lk2, *diff_norm, *w_out, *ffn_norm, *w_gu, *w_dn;
    float* out; unsigned char* ws;
};

__device__ __forceinline__ float wave_sum(float v) {
#pragma unroll
    for (int o = 1; o < 64; o <<= 1) v += __shfl_xor(v, o);
    return v;
}

__device__ __forceinline__ int win_src(int a, int& nvalid) {
    const int pn = a >> 3, b8 = a & 7; nvalid = 32;
    if (pn < 16) return 256 * pn + 32 * b8;
    if (pn < 24) return 4112 + 256 * (pn - 16) + 64 * (b8 & 3) + 32 * (b8 >> 2);
    if (pn < 28) return 6160 + 256 * (pn - 24) + 32 * b8;
    if (b8 == 0) { nvalid = 16; return 4096; }
    nvalid = 0; return 0;
}
__device__ __forceinline__ void p0_transpose_item(const float* W, int Nsrc, int K, bf16* WT, int k0, int dstrow0, int srccol, int nvalid, const float* gain, LAS float* scr, int lane) {
    const int c = lane & 31;
    float vv[32];
#pragma unroll
    for (int i = 0; i < 32; ++i) { const int kk = 2 * i + (lane >> 5); vv[i] = (c < nvalid) ? __builtin_nontemporal_load(W + (size_t)(k0 + kk) * Nsrc + srccol + c) : 0.f; }
    if (gain) {
#pragma unroll
        for (int i = 0; i < 32; ++i) vv[i] *= gain[k0 + 2 * i + (lane >> 5)]; }
#pragma unroll
    for (int i = 0; i < 32; ++i) scr[(2 * i + (lane >> 5)) * 33 + c] = vv[i];
    LDS_WAIT(); asm volatile("" ::: "memory");
    const int c8 = lane & 7;
#pragma unroll
    for (int j = 0; j < 4; ++j) { const int n = (lane >> 3) + 8 * j; const LAS float* s = scr + (8 * c8) * 33 + n;
        v4u o; o.x = pk2(s[0 * 33], s[1 * 33]); o.y = pk2(s[2 * 33], s[3 * 33]); o.z = pk2(s[4 * 33], s[5 * 33]); o.w = pk2(s[6 * 33], s[7 * 33]);
        *(GAS v4u*)(WT + (size_t)(dstrow0 + n) * K + k0 + 8 * c8) = o; }
    LDS_WAIT(); asm volatile("" ::: "memory");
}
__device__ __forceinline__ void p0_convert(const Params& P, LAS unsigned char* lds, int gw, int NGW, int wave, int lane, int mask, int gu_kb0 = 0, int gu_kb1 = 32) {
    using namespace cfg;
    LAS float* scr = (LAS float*)(lds + wave * 16384);
    bf16* Wt_in = (bf16*)(P.ws + WS_WIN); bf16* Wt_out = (bf16*)(P.ws + WS_WOUT); bf16* Wt_gu = (bf16*)(P.ws + WS_WGU); bf16* Wt_dn = (bf16*)(P.ws + WS_WDN);
    const int I_IN = (mask & 1) ? 32 * 232 : 0, I_OUT = (mask & 2) ? 32 * 64 : 0, I_GU = (mask & 4) ? (gu_kb1 - gu_kb0) * 352 : 0, I_DN = (mask & 8) ? 88 * 64 : 0, NITEMS = I_IN + I_OUT + I_GU + I_DN;
    for (int it = gw; it < NITEMS; it += NGW) {
        int r = it;
        if (r < I_IN) { const int kb = r / 232, a = r % 232; int nv; const int src = win_src(a, nv); p0_transpose_item(P.w_in, WIN_N, 2048, Wt_in, 64 * kb, 32 * a, src, nv, P.attn_norm, scr, lane); continue; } r -= I_IN;
        if (r < I_OUT) { const int kb = r / 64, a = r % 64; p0_transpose_item(P.w_out, 2048, 2048, Wt_out, 64 * kb, 32 * a, 32 * a, 32, nullptr, scr, lane); continue; } r -= I_OUT;
        if (r < I_GU) { const int kb = gu_kb0 + r / 352, a = r % 352, pn = a >> 3, b8 = a & 7; const int src = (b8 < 4) ? 128 * pn + 32 * b8 : DFF + 128 * pn + 32 * (b8 - 4);
            p0_transpose_item(P.w_gu, 2 * DFF, 2048, Wt_gu, 64 * kb, 32 * a, src, 32, P.ffn_norm, scr, lane); continue; } r -= I_GU;
        { const int kb = r / 64, a = r % 64; p0_transpose_item(P.w_dn, 2048, DFF, Wt_dn, 64 * kb, 32 * a, 32 * a, 32, nullptr, scr, lane); }
    }
}
__device__ __forceinline__ void p0_prep(const Params& P, LAS unsigned char* lds, int vcu, int G, int wave, int lane) {
    using namespace cfg;
    const int gw = vcu * 8 + wave, NGW = G * 8;
    p0_convert(P, lds, gw, NGW, wave, lane, P0_MASK, 0, GU_SPLIT);
    bf16* Apad = (bf16*)(P.ws + WS_APAD); float* rstd = (float*)(P.ws + WS_RSTD);
    for (int r = gw; r < MP; r += NGW) {
        GAS unsigned long long* o8 = (GAS unsigned long long*)(Apad + (size_t)r * 2048) + lane;
        const float* src = (r >= 64 && r < LP) ? P.x + (size_t)(r - 64) * 2048 : ((r >= 48 && r < 64) ? P.meta + (size_t)(r - 48) * 2048 : nullptr);
        if (!src) {
#pragma unroll
            for (int j = 0; j < 8; ++j) o8[64 * j] = 0ull;
            if (lane == 0) rstd[r] = 0.f;
        } else {
            const GAS f32x4* xr = (const GAS f32x4*)src + lane; f32x4 v[8]; float s = 0.f;
#pragma unroll
            for (int j = 0; j < 8; ++j) { v[j] = __builtin_nontemporal_load(xr + 64 * j); s += (v[j].x * v[j].x + v[j].y * v[j].y) + (v[j].z * v[j].z + v[j].w * v[j].w); }
            const float rs = 1.0f / sqrtf(wave_sum(s) * (1.0f / 2048.0f) + 1e-6f);
#pragma unroll
            for (int j = 0; j < 8; ++j) o8[64 * j] = (unsigned long long)pk2(v[j].x, v[j].y) | ((unsigned long long)pk2(v[j].z, v[j].w) << 32);
            if (lane == 0) rstd[r] = rs;
        }
    }
}

__device__ __forceinline__ int kperm32(int a) { return 8 * ((a >> 2) & 3) + 4 * (a >> 4) + (a & 3); }
__device__ __forceinline__ int kperm(int a) { return (a & ~31) + kperm32(a & 31); }
__device__ __forceinline__ unsigned short f2bf_s(float f) { return (unsigned short)pk2(f, 0.f); }
__device__ __forceinline__ f32x4 mfma16(bf16x8 a, bf16x8 b, f32x4 c) { return __builtin_amdgcn_mfma_f32_16x16x32_bf16(a, b, c, 0, 0, 0); }

#define GDN_LOAD_RAW(raw_, h_, n_, tid_) do { const int c0_ = 8 * ((tid_) & 15); \
        _Pragma("unroll") for (int X_ = 0; X_ < 3; ++X_) _Pragma("unroll") for (int ps_ = 0; ps_ < 2; ++ps_) _Pragma("unroll") for (int j_ = 0; j_ < 4; ++j_) { const int Rj_ = 64 * (n_) + 32 * ps_ + ((tid_) >> 4) - 3 + j_; \
            raw_[X_][ps_][j_] = (Rj_ >= 0) ? __builtin_nontemporal_load((const u32x4*)((const bf16_t*)(P.ws + cfg::WS_GRAW) + (size_t)Rj_ * 4096 + X_ * 1024 + (h_) * 128 + c0_)) : (u32x4){0u, 0u, 0u, 0u}; } } while (0)
#define GDN_LOAD_GB(gb_, h_, n_, tid_) do { const size_t o_ = (size_t)(h_) * cfg::LP + 64 * (n_) + ((tid_) & 63); gb_[0] = ((const float*)(P.ws + cfg::WS_GDEC))[o_]; gb_[1] = ((const float*)(P.ws + cfg::WS_BETA))[o_]; } while (0)
__device__ __forceinline__ void gdn_prep_item(const Params& P, int h, int n, u32x4 (&raw)[3][2][4], float (&gb)[2], int hn, int nn, bool has_next, LAS unsigned char* lds, int tid, int wave, int lane) {
    using namespace cfg;
    asm volatile("" : "+v"(tid)); lane = tid & 63;
    LAS bf16_t* qs = (LAS bf16_t*)(lds + 0);
    LAS bf16_t* ks = (LAS bf16_t*)(lds + 17408);
    LAS bf16_t* kb = (LAS bf16_t*)(lds + 34816);
    LAS bf16_t* kbgT = (LAS bf16_t*)(lds + 52224);
    LAS bf16_t* vbT = (LAS bf16_t*)(lds + 70656);
    LAS bf16_t* kdtI = (LAS bf16_t*)(lds + 89088);
    LAS bf16_t* qgI = (LAS bf16_t*)(lds + 105472);
    LAS float* Lm = (LAS float*)(lds + 121856);
    LAS bf16_t* attI = (LAS bf16_t*)(lds + 139264);
    LAS float* gcs = (LAS float*)(lds + 147456);
    LAS bf16_t* Tb = (LAS bf16_t*)(lds + 0);
    LAS float* UTI = (LAS float*)(lds + 17408);
    LAS bf16_t* WI = (LAS bf16_t*)(lds + 89088);
    const bf16_t* graw = (const bf16_t*)(P.ws + WS_GRAW);
    unsigned char* item = P.ws + WS_GDNP + (size_t)(h * NCH + n) * GI_BYTES;

    if (tid < 64) { float g = gb[0]; const float b = gb[1];
#pragma unroll
        for (int o = 1; o < 64; o <<= 1) { const float t = __shfl_up(g, o); if (lane >= o) g += t; }
        gcs[tid] = g; gcs[64 + tid] = b; }
    __syncthreads();
    const float gl = gcs[63];
    {
        const int cg = tid & 15, c0 = 8 * cg;
#pragma unroll
        for (int X = 0; X < 3; ++X) {
            const float* cw = P.conv_w + X * 1024 + h * 128 + c0; f32x4 w[4][2];
#pragma unroll
            for (int j = 0; j < 4; ++j) { w[j][0] = *(const f32x4*)(cw + (size_t)j * 3072); w[j][1] = *(const f32x4*)(cw + (size_t)j * 3072 + 4); }
#pragma unroll
            for (int pass = 0; pass < 2; ++pass) {
                const int rl = 32 * pass + (tid >> 4);
                float y[8];
#pragma unroll
                for (int i = 0; i < 8; ++i) y[i] = 0.f;
#pragma unroll
                for (int j = 0; j < 4; ++j) {
#pragma unroll
                    for (int i = 0; i < 4; ++i) { const unsigned wd = raw[X][pass][j][i]; y[2 * i] += __uint_as_float(wd << 16) * w[j][i >> 1][(2 * i) & 3]; y[2 * i + 1] += __uint_as_float(wd & 0xffff0000u) * w[j][i >> 1][(2 * i + 1) & 3]; } }
                float ss = 0.f;
#pragma unroll
                for (int i = 0; i < 8; ++i) { y[i] = pg8::silu_f(y[i]); ss += y[i] * y[i]; }
                const float gc = gcs[rl], bt = gcs[64 + rl];
                if (X < 2) { ss += __shfl_xor(ss, 1); ss += __shfl_xor(ss, 2); ss += __shfl_xor(ss, 4); ss += __shfl_xor(ss, 8);
                    const float rn = __builtin_amdgcn_rsqf(ss + 1e-6f) * (X == 0 ? 0.08838834764831845f : 1.0f);
#pragma unroll
                    for (int i = 0; i < 8; ++i) y[i] *= rn; }
                if (X == 0) {
                    u32x4 pk; pk.x = pk2(y[0], y[1]); pk.y = pk2(y[2], y[3]); pk.z = pk2(y[4], y[5]); pk.w = pk2(y[6], y[7]);
                    *(LAS u32x4*)(qs + rl * 136 + c0) = pk;
                    const float e = __expf(gc);
                    u32x2 a, b; a.x = pk2(y[0] * e, y[1] * e); a.y = pk2(y[2] * e, y[3] * e); b.x = pk2(y[4] * e, y[5] * e); b.y = pk2(y[6] * e, y[7] * e);
                    *(LAS u32x2*)(qgI + rl * 128 + kperm(c0)) = a; *(LAS u32x2*)(qgI + rl * 128 + kperm(c0 + 4)) = b;
                } else if (X == 1) {
                    u32x4 pk; pk.x = pk2(y[0], y[1]); pk.y = pk2(y[2], y[3]); pk.z = pk2(y[4], y[5]); pk.w = pk2(y[6], y[7]);
                    *(LAS u32x4*)(ks + rl * 136 + c0) = pk;
                    u32x4 pb; pb.x = pk2(y[0] * bt, y[1] * bt); pb.y = pk2(y[2] * bt, y[3] * bt); pb.z = pk2(y[4] * bt, y[5] * bt); pb.w = pk2(y[6] * bt, y[7] * bt);
                    *(LAS u32x4*)(kb + rl * 136 + c0) = pb;
                    const float eg = bt * __expf(gc), ed = __expf(gl - gc); const int prl = kperm(rl);
                    const int swz_rl = (((rl >> 3) ^ (cg & 7)) << 3) | (rl & 7), swz_prl = (((prl >> 3) ^ (cg & 7)) << 3) | (prl & 7);
#pragma unroll
                    for (int i = 0; i < 8; ++i) { kbgT[(c0 + i) * 72 + swz_rl] = f2bf_s(y[i] * eg); kdtI[(c0 + i) * 64 + swz_prl] = f2bf_s(y[i] * ed); }
                } else {
                    const int swz_rl = (((rl >> 3) ^ (cg & 7)) << 3) | (rl & 7);
#pragma unroll
                    for (int i = 0; i < 8; ++i) vbT[(c0 + i) * 72 + swz_rl] = f2bf_s(y[i] * bt);
                }
            }
        }
    }
    __syncthreads();
    {
        const int mt = wave & 3, fr = lane & 15, g = lane >> 4;
        bf16x8 ak[4], aq[4];
#pragma unroll
        for (int s = 0; s < 4; ++s) { ak[s] = *(const LAS bf16x8*)(kb + (16 * mt + fr) * 136 + 32 * s + 8 * g); aq[s] = *(const LAS bf16x8*)(qs + (16 * mt + fr) * 136 + 32 * s + 8 * g); }
#pragma unroll
        for (int t2 = 0; t2 < 2; ++t2) { const int nt = 2 * (wave >> 2) + t2;
            f32x4 ckk = {0.f, 0.f, 0.f, 0.f}, cqk = {0.f, 0.f, 0.f, 0.f};
#pragma unroll
            for (int s = 0; s < 4; ++s) { const bf16x8 b = *(const LAS bf16x8*)(ks + (16 * nt + fr) * 136 + 32 * s + 8 * g); ckk = mfma16(ak[s], b, ckk); cqk = mfma16(aq[s], b, cqk); }
            const int sc = 16 * nt + fr; const float gs = gcs[sc]; const int psc = kperm(sc);
#pragma unroll
            for (int r = 0; r < 4; ++r) { const int c = 16 * mt + 4 * g + r; const float dec = (c >= sc) ? __expf(gcs[c] - gs) : 0.f;
                Lm[c * 68 + sc] = (c > sc) ? ckk[r] * dec : 0.f;
                attI[c * 64 + psc] = f2bf_s((c >= sc) ? cqk[r] * dec : 0.f); }
        }
    }
    __syncthreads();
    LAS bf16_t* ATb = (LAS bf16_t*)(lds + 9216);
    if (wave < 2) {
        float t[32];
        const LAS float* Lb = Lm + wave * (32 * 68 + 32); asm volatile("" : "+v"(Lb));
        LAS bf16_t* Tq = Tb + wave * (32 * 72 + 32);
        const bool wr_ok = (wave == 0) || (lane < 32);
        f32x4 la[8], lb[8];
#define INV_LOAD(dst, i_) do { _Pragma("unroll") for (int j4_ = 0; j4_ < ((i_) + 3) / 4; ++j4_) dst[j4_] = *(const LAS f32x4*)(Lb + (i_) * 68 + 4 * j4_); } while (0)
#define INV_ROW(src, i_) do { float a4_[4] = {(lane == (i_)) ? 1.0f : 0.0f, 0.f, 0.f, 0.f}; \
            _Pragma("unroll") for (int j4_ = 0; j4_ < ((i_) + 3) / 4; ++j4_) _Pragma("unroll") for (int jj_ = 0; jj_ < 4; ++jj_) { if (4 * j4_ + jj_ < (i_)) a4_[jj_] -= src[j4_][jj_] * t[4 * j4_ + jj_]; } \
            const float a_ = (a4_[0] + a4_[1]) + (a4_[2] + a4_[3]); t[(i_)] = a_; if (wr_ok) Tq[(i_) * 72 + lane] = f2bf_s(a_); } while (0)
        t[0] = (lane == 0) ? 1.0f : 0.0f; if (wr_ok) Tq[lane] = f2bf_s(t[0]);
        INV_LOAD(lb, 1);
#pragma unroll
        for (int i = 1; i < 32; i += 2) {
            if (i + 1 < 32) INV_LOAD(la, i + 1);
            __builtin_amdgcn_sched_barrier(0);
            INV_ROW(lb, i);
            __builtin_amdgcn_sched_barrier(0);
            if (i + 1 < 32) {
                if (i + 2 < 32) INV_LOAD(lb, i + 2);
                __builtin_amdgcn_sched_barrier(0);
                INV_ROW(la, i + 1);
                __builtin_amdgcn_sched_barrier(0);
            }
        }
#undef INV_LOAD
#undef INV_ROW
        if (wave == 0 && lane < 32) {
#pragma unroll
            for (int q = 0; q < 4; ++q) { u32x4 w; w.x = pk2(t[8 * q], t[8 * q + 1]); w.y = pk2(t[8 * q + 2], t[8 * q + 3]); w.z = pk2(t[8 * q + 4], t[8 * q + 5]); w.w = pk2(t[8 * q + 6], t[8 * q + 7]);
                *(LAS u32x4*)(ATb + lane * 40 + 8 * q) = w; } }
    } else {
        const int t7 = tid - 128;
        for (int ch = t7; ch < 2560; ch += 384) {
            if (ch < 1024) *(GAS v4u*)(item + GI_KDT + ch * 16) = *(const LAS v4u*)((const LAS unsigned char*)kdtI + (ch >> 3) * 128 + (((ch & 7) ^ ((ch >> 6) & 7)) << 4));
            else if (ch < 2048) *(GAS v4u*)(item + GI_WQ + 16384 + (ch - 1024) * 16) = *(const LAS v4u*)((const LAS unsigned char*)qgI + (ch - 1024) * 16);
            else *(GAS v4u*)(item + GI_ATT + (ch - 2048) * 16) = *(const LAS v4u*)((const LAS unsigned char*)attI + (ch - 2048) * 16);
        }
    }
    if (has_next) GDN_LOAD_GB(gb, hn, nn, tid);
    if (has_next) GDN_LOAD_RAW(raw, hn, nn, tid);
    else {
#pragma unroll
        for (int X_ = 0; X_ < 3; ++X_)
#pragma unroll
            for (int ps_ = 0; ps_ < 2; ++ps_)
#pragma unroll
                for (int j_ = 0; j_ < 4; ++j_) raw[X_][ps_][j_] = (u32x4){0u, 0u, 0u, 0u}; }
    asm volatile("s_waitcnt lgkmcnt(0)" ::: "memory"); __builtin_amdgcn_s_barrier(); asm volatile("" ::: "memory");
    if (wave < 2) {
        const int fr = lane & 15, g = lane >> 4;
        const bf16x8 bfrag = *(const LAS bf16x8*)(ATb + (16 * wave + fr) * 40 + 8 * g);
        f32x4 Y[2];
#pragma unroll
        for (int mt = 0; mt < 2; ++mt) { const LAS float* cp = Lm + (32 + 16 * mt + fr) * 68 + 8 * g; const f32x4 c0 = *(const LAS f32x4*)cp, c1 = *(const LAS f32x4*)(cp + 4);
            u32x4 w; w.x = pk2(c0[0], c0[1]); w.y = pk2(c0[2], c0[3]); w.z = pk2(c1[0], c1[1]); w.w = pk2(c1[2], c1[3]);
            Y[mt] = mfma16(__builtin_bit_cast(bf16x8, w), bfrag, (f32x4){0.f, 0.f, 0.f, 0.f}); }
        u32x4 yb; yb.x = pk2(Y[0][0], Y[0][1]); yb.y = pk2(Y[0][2], Y[0][3]); yb.z = pk2(Y[1][0], Y[1][1]); yb.w = pk2(Y[1][2], Y[1][3]);
#pragma unroll
        for (int mt = 0; mt < 2; ++mt) { const LAS bf16_t* dp = Tb + (32 + 16 * mt + fr) * 72 + 32 + 4 * g; const u32x2 lo = *(const LAS u32x2*)dp, hi = *(const LAS u32x2*)(dp + 16);
            u32x4 a; a.x = lo.x; a.y = lo.y; a.z = hi.x; a.w = hi.y;
            const f32x4 X = mfma16(__builtin_bit_cast(bf16x8, a), __builtin_bit_cast(bf16x8, yb), (f32x4){0.f, 0.f, 0.f, 0.f});
#pragma unroll
            for (int r = 0; r < 4; ++r) Tb[(32 + 16 * mt + 4 * g + r) * 72 + 16 * wave + fr] = f2bf_s(-X[r]); }
    }
    asm volatile("s_waitcnt lgkmcnt(0)" ::: "memory"); __builtin_amdgcn_s_barrier(); asm volatile("" ::: "memory");
    {
        const int fr = lane & 15, g = lane >> 4, col = 16 * wave + fr, pcol = kperm(col);
        bf16x8 bu[2], bw[2];
#pragma unroll
        for (int s = 0; s < 2; ++s) { const int sl = ((4 * s + g) ^ ((col >> 3) & 7)) * 8; bu[s] = *(const LAS bf16x8*)(vbT + col * 72 + sl); bw[s] = *(const LAS bf16x8*)(kbgT + col * 72 + sl); }
#pragma unroll
        for (int mt = 0; mt < 4; ++mt) { f32x4 cu = {0.f, 0.f, 0.f, 0.f}, cw = {0.f, 0.f, 0.f, 0.f};
#pragma unroll
            for (int s = 0; s < 2; ++s) { const bf16x8 a = *(const LAS bf16x8*)(Tb + (16 * mt + fr) * 72 + 32 * s + 8 * g); cu = mfma16(a, bu[s], cu); cw = mfma16(a, bw[s], cw); }
            *(LAS f32x4*)(UTI + col * 64 + 16 * mt + 4 * g) = cu;
#pragma unroll
            for (int r = 0; r < 4; ++r) WI[(16 * mt + 4 * g + r) * 128 + pcol] = f2bf_s(cw[r]); }
    }
    asm volatile("s_waitcnt lgkmcnt(0)" ::: "memory"); __builtin_amdgcn_s_barrier(); asm volatile("" ::: "memory");
    for (int ch = tid; ch < 3072; ch += 512) {
        if (ch < 2048) *(GAS v4u*)(item + GI_UT + ch * 16) = *(const LAS v4u*)((const LAS unsigned char*)UTI + ch * 16);
        else *(GAS v4u*)(item + GI_WQ + (ch - 2048) * 16) = *(const LAS v4u*)((const LAS unsigned char*)WI + (ch - 2048) * 16);
    }
    if (tid == 0) *(float*)(item + GI_EG) = __expf(gl);
    asm volatile("s_waitcnt lgkmcnt(0)" ::: "memory"); __builtin_amdgcn_s_barrier(); asm volatile("" ::: "memory");
}

__device__ __forceinline__ bf16x8 pack_b(const f32x4 lo, const f32x4 hi) {
    u32x4 w; w.x = pg8::cvt_pk_bf16(lo[0], lo[1]); w.y = pg8::cvt_pk_bf16(lo[2], lo[3]); w.z = pg8::cvt_pk_bf16(hi[0], hi[1]); w.w = pg8::cvt_pk_bf16(hi[2], hi[3]);
    return __builtin_bit_cast(bf16x8, w);
}
__device__ __forceinline__ void gdn_scan(const Params& P, int h, int n0, int n1, const float* Sinit, f32x4* Sout, LAS unsigned char* lds, int tid, int wave, int lane) {
    using namespace cfg;
    asm volatile("v_mbcnt_lo_u32_b32 %0, -1, 0\n\tv_mbcnt_hi_u32_b32 %0, -1, %0" : "=v"(lane)); tid = wave * 64 + lane;
    constexpr int WQ_LD = 272, AT_LD = 144, KD_LD = 144;
    constexpr int OFF_WQ = 0, OFF_AT = 128 * WQ_LD, OFF_KD = OFF_AT + 64 * AT_LD, OFF_O = OFF_KD + 128 * KD_LD;
    LAS unsigned char* Abuf = lds;
    LAS float* Oex = (LAS float*)(lds + OFF_O);
    const unsigned char* items = P.ws + WS_GDNP + (size_t)h * NCH * GI_BYTES;
    const bf16_t* graw = (const bf16_t*)(P.ws + WS_GRAW);
    bf16_t* mix = (bf16_t*)(P.ws + WS_MIX);
    const int fr = lane & 15, g = lane >> 4, dv = 16 * wave + fr;
    v4u st[7];
#define SCAN_LOAD(nn) do { const unsigned char* it_ = items + (size_t)(nn) * GI_BYTES; \
        _Pragma("unroll") for (int i_ = 0; i_ < 4; ++i_) st[i_] = __builtin_nontemporal_load((const GAS v4u*)(it_ + GI_WQ + (size_t)(tid + 512 * i_) * 16)); \
        st[4] = __builtin_nontemporal_load((const GAS v4u*)(it_ + GI_ATT + (size_t)tid * 16)); \
        _Pragma("unroll") for (int i_ = 0; i_ < 2; ++i_) st[5 + i_] = __builtin_nontemporal_load((const GAS v4u*)(it_ + GI_KDT + (size_t)(tid + 512 * i_) * 16)); } while (0)
#define SCAN_STORE() do { \
        _Pragma("unroll") for (int i_ = 0; i_ < 4; ++i_) { const int ch_ = tid + 512 * i_; *(LAS v4u*)(Abuf + OFF_WQ + (ch_ >> 4) * WQ_LD + (ch_ & 15) * 16) = st[i_]; } \
        *(LAS v4u*)(Abuf + OFF_AT + (tid >> 3) * AT_LD + (tid & 7) * 16) = st[4]; \
        _Pragma("unroll") for (int i_ = 0; i_ < 2; ++i_) { const int ch_ = tid + 512 * i_; *(LAS v4u*)(Abuf + OFF_KD + (ch_ >> 3) * KD_LD + (ch_ & 7) * 16) = st[5 + i_]; } } while (0)
    f32x4 S[8];
#pragma unroll
    for (int i = 0; i < 8; ++i) S[i] = Sinit ? *(const GAS f32x4*)(Sinit + (size_t)dv * 128 + 16 * i + 4 * g) : (f32x4){0.f, 0.f, 0.f, 0.f};
    SCAN_LOAD(n0); SCAN_STORE();
    const int frow = tid >> 3, fseg = tid & 7;
    LAS float* gnl = (LAS float*)(lds + OFF_O + 64 * 132 * 4);
    if (tid < 128) gnl[tid] = P.gdn_norm[tid];
    __syncthreads();
#pragma unroll 1
    for (int n = n0; n < n1; ++n) {
        const unsigned char* it = items + (size_t)n * GI_BYTES;
        if (n + 1 < n1) SCAN_LOAD(n + 1);
        f32x4 ut[4];
#pragma unroll
        for (int mt = 0; mt < 4; ++mt) ut[mt] = __builtin_nontemporal_load((const GAS f32x4*)(it + GI_UT + ((size_t)dv * 64 + 16 * mt + 4 * g) * 4));
        const float eg = *(const float*)(it + GI_EG);
        u32x4 zr[2];
        if (n > 0) { const bf16_t* zp = graw + (size_t)(64 * n + frow) * 4096 + 3072 + h * 128 + 16 * fseg; zr[0] = *(const u32x4*)zp; zr[1] = *(const u32x4*)(zp + 8); }
#define SB_() __builtin_amdgcn_sched_barrier(0)
#define LD_WQ(dst, mt0) do { _Pragma("unroll") for (int m_ = 0; m_ < 2; ++m_) _Pragma("unroll") for (int s_ = 0; s_ < 4; ++s_) \
            dst[4 * m_ + s_] = *(const LAS bf16x8*)(Abuf + OFF_WQ + (16 * ((mt0) + m_) + fr) * WQ_LD + 64 * s_ + 16 * g); } while (0)
#define LD_AT(dst) do { _Pragma("unroll") for (int m_ = 0; m_ < 4; ++m_) _Pragma("unroll") for (int s_ = 0; s_ < 2; ++s_) \
            dst[2 * m_ + s_] = *(const LAS bf16x8*)(Abuf + OFF_AT + (16 * m_ + fr) * AT_LD + 64 * s_ + 16 * g); } while (0)
#define LD_KD(dst, mt0) do { _Pragma("unroll") for (int m_ = 0; m_ < 4; ++m_) _Pragma("unroll") for (int s_ = 0; s_ < 2; ++s_) \
            dst[2 * m_ + s_] = *(const LAS bf16x8*)(Abuf + OFF_KD + (16 * ((mt0) + m_) + fr) * KD_LD + 64 * s_ + 16 * g); } while (0)
#define MM_WQ(src, mt0) do { _Pragma("unroll") for (int m_ = 0; m_ < 2; ++m_) _Pragma("unroll") for (int s_ = 0; s_ < 4; ++s_) X[(mt0) + m_] = mfma16(src[4 * m_ + s_], bs[s_], X[(mt0) + m_]); } while (0)
        bf16x8 bs[4];
#pragma unroll
        for (int s = 0; s < 4; ++s) bs[s] = pack_b(S[2 * s], S[2 * s + 1]);
        f32x4 X[8];
#pragma unroll
        for (int mt = 0; mt < 8; ++mt) X[mt] = (f32x4){0.f, 0.f, 0.f, 0.f};
        bf16x8 fa[8], fb[8];
        LD_WQ(fa, 0); SB_();
        LD_WQ(fb, 2); SB_(); MM_WQ(fa, 0); SB_();
        LD_WQ(fa, 4); SB_(); MM_WQ(fb, 2); SB_();
        LD_WQ(fb, 6); SB_(); MM_WQ(fa, 4); SB_();
        LD_AT(fa); SB_(); MM_WQ(fb, 6); SB_();
        f32x4 vn[4];
#pragma unroll
        for (int mt = 0; mt < 4; ++mt) vn[mt] = ut[mt] - X[mt];
        bf16x8 bv[2];
#pragma unroll
        for (int s = 0; s < 2; ++s) bv[s] = pack_b(vn[2 * s], vn[2 * s + 1]);
        SB_();
        LD_KD(fb, 0); SB_();
#pragma unroll
        for (int mt = 0; mt < 4; ++mt)
#pragma unroll
            for (int s = 0; s < 2; ++s) X[4 + mt] = mfma16(fa[2 * mt + s], bv[s], X[4 + mt]);
        SB_();
        LD_KD(fa, 4); SB_();
#pragma unroll
        for (int mt = 0; mt < 4; ++mt) { S[mt] = S[mt] * eg;
#pragma unroll
            for (int s = 0; s < 2; ++s) S[mt] = mfma16(fb[2 * mt + s], bv[s], S[mt]); }
        SB_();
#pragma unroll
        for (int mt = 0; mt < 4; ++mt)
#pragma unroll
            for (int r = 0; r < 4; ++r) Oex[(16 * mt + 4 * g + r) * 132 + dv] = X[4 + mt][r];
#pragma unroll
        for (int mt = 4; mt < 8; ++mt) { S[mt] = S[mt] * eg;
#pragma unroll
            for (int s = 0; s < 2; ++s) S[mt] = mfma16(fa[2 * (mt - 4) + s], bv[s], S[mt]); }
#undef SB_
#undef LD_WQ
#undef LD_AT
#undef LD_KD
#undef MM_WQ
        asm volatile("s_waitcnt lgkmcnt(0)" ::: "memory"); __builtin_amdgcn_s_barrier(); asm volatile("" ::: "memory");
        if (n + 1 < n1) SCAN_STORE();
        if (n > 0) {
            f32x4 o4[4]; float ss = 0.f;
#pragma unroll
            for (int i = 0; i < 4; ++i) { o4[i] = *(const LAS f32x4*)(Oex + frow * 132 + 16 * fseg + 4 * i); ss += (o4[i][0] * o4[i][0] + o4[i][1] * o4[i][1]) + (o4[i][2] * o4[i][2] + o4[i][3] * o4[i][3]); }
            ss += __shfl_xor(ss, 1); ss += __shfl_xor(ss, 2); ss += __shfl_xor(ss, 4);
            const float rn = __builtin_amdgcn_rsqf(ss * (1.0f / 128.0f) + 1e-6f);
            float ov[16];
#pragma unroll
            for (int i = 0; i < 16; ++i) { const unsigned wd = zr[i >> 3][(i >> 1) & 3]; const float z = (i & 1) ? __uint_as_float(wd & 0xffff0000u) : __uint_as_float(wd << 16);
                ov[i] = o4[i >> 2][i & 3] * rn * gnl[16 * fseg + i] * pg8::silu_f(z); }
            u32x4 w0, w1; w0.x = pk2(ov[0], ov[1]); w0.y = pk2(ov[2], ov[3]); w0.z = pk2(ov[4], ov[5]); w0.w = pk2(ov[6], ov[7]); w1.x = pk2(ov[8], ov[9]); w1.y = pk2(ov[10], ov[11]); w1.z = pk2(ov[12], ov[13]); w1.w = pk2(ov[14], ov[15]);
            bf16_t* mp = mix + (size_t)(64 * (n - 1) + frow) * 2048 + h * 128 + 16 * fseg;
            *(u32x4*)mp = w0; *(u32x4*)(mp + 8) = w1;
        }
        asm volatile("s_waitcnt lgkmcnt(0)" ::: "memory"); __builtin_amdgcn_s_barrier(); asm volatile("" ::: "memory");
    }
#undef SCAN_LOAD
#undef SCAN_STORE
    if (Sout) {
#pragma unroll
        for (int i = 0; i < 8; ++i) Sout[i] = S[i]; }
}


__device__ __forceinline__ int grp_start(int g) { return 8 * g + 1; }
__device__ __forceinline__ void dep_wait(unsigned* flag, unsigned want, int wave) {
    int l_; asm volatile("v_mbcnt_lo_u32_b32 %0, -1, 0\n\tv_mbcnt_hi_u32_b32 %0, -1, %0" : "=v"(l_));
    if (wave == 0 && l_ == 0) { unsigned sp = 0; while (__hip_atomic_load(flag, __ATOMIC_RELAXED, __HIP_MEMORY_SCOPE_AGENT) < want) { __builtin_amdgcn_s_sleep(8); if (++sp > (1u << 22)) break; }
        __builtin_amdgcn_fence(__ATOMIC_ACQUIRE, "agent"); asm volatile("s_waitcnt vmcnt(0)" ::: "memory"); }
    __syncthreads();
}
#define DEP_PUBLISH_BEGIN() asm volatile("s_waitcnt vmcnt(0)" ::: "memory"); __syncthreads(); if (threadIdx.x == 0) { __builtin_amdgcn_fence(__ATOMIC_RELEASE, "agent"); asm volatile("s_waitcnt vmcnt(0)" ::: "memory");
#define DEP_PUBLISH_END() }
__device__ __forceinline__ void gdn_compose(const Params& P, int h, int gi, int part, LAS unsigned char* lds, unsigned* ctl, int tid, int wave, int lane) {
    using namespace cfg;
    dep_wait(ctl + CW_P2C + 4 * (16 * h + gi), 8u, wave);
    constexpr int WQ_LD = 272, KD_LD = 144, OFF_WQ = 0, OFF_KD = 128 * WQ_LD + 64 * 144;
    LAS unsigned char* Abuf = lds;
    const unsigned char* items = P.ws + WS_GDNP + (size_t)h * NCH * GI_BYTES;
    const int fr = lane & 15, g = lane >> 4, col = 16 * wave + fr;
    const int n0 = grp_start(gi), n1 = 8 * gi + 9;
    v4u stx[4], sty[4];
#define CMP_LOAD(st, nn) do { const unsigned char* it_ = items + (size_t)(nn) * GI_BYTES; \
        _Pragma("unroll") for (int i_ = 0; i_ < 2; ++i_) st[i_] = *(const GAS v4u*)(it_ + GI_WQ + (size_t)(tid + 512 * i_) * 16); \
        _Pragma("unroll") for (int i_ = 0; i_ < 2; ++i_) st[2 + i_] = *(const GAS v4u*)(it_ + GI_KDT + (size_t)(tid + 512 * i_) * 16); } while (0)
#define CMP_STORE(st) do { \
        _Pragma("unroll") for (int i_ = 0; i_ < 2; ++i_) { const int ch_ = tid + 512 * i_; *(LAS v4u*)(Abuf + OFF_WQ + (ch_ >> 4) * WQ_LD + (ch_ & 15) * 16) = st[i_]; } \
        _Pragma("unroll") for (int i_ = 0; i_ < 2; ++i_) { const int ch_ = tid + 512 * i_; *(LAS v4u*)(Abuf + OFF_KD + (ch_ >> 3) * KD_LD + (ch_ & 7) * 16) = st[2 + i_]; } } while (0)
    f32x4 X[8];
#pragma unroll
    for (int mt = 0; mt < 8; ++mt)
#pragma unroll
        for (int r = 0; r < 4; ++r) X[mt][r] = (part == 0 && 16 * mt + 4 * g + r == col) ? 1.0f : 0.0f;
    CMP_LOAD(stx, n0); CMP_STORE(stx);
    if (n0 + 1 < n1) CMP_LOAD(stx, n0 + 1);
    if (n0 + 2 < n1) CMP_LOAD(sty, n0 + 2);
    __syncthreads();
#pragma unroll 1
    for (int nb = n0; nb < n1; nb += 2) {
        { const int n = nb;
#define STCUR stx
        const unsigned char* it = items + (size_t)n * GI_BYTES;
        f32x4 ut[4];
#pragma unroll
        for (int mt = 0; mt < 4; ++mt) ut[mt] = part ? *(const GAS f32x4*)(it + GI_UT + ((size_t)col * 64 + 16 * mt + 4 * g) * 4) : (f32x4){0.f, 0.f, 0.f, 0.f};
        const float eg = *(const float*)(it + GI_EG);
        bf16x8 bs[4];
#pragma unroll
        for (int s = 0; s < 4; ++s) bs[s] = pack_b(X[2 * s], X[2 * s + 1]);
        bf16x8 fa[8], fb[8];
        f32x4 Y[4];
#pragma unroll
        for (int mt = 0; mt < 4; ++mt) Y[mt] = (f32x4){0.f, 0.f, 0.f, 0.f};
#define SB_() __builtin_amdgcn_sched_barrier(0)
#define LD_W(dst, mt0) do { _Pragma("unroll") for (int m_ = 0; m_ < 2; ++m_) _Pragma("unroll") for (int s_ = 0; s_ < 4; ++s_) \
            dst[4 * m_ + s_] = *(const LAS bf16x8*)(Abuf + OFF_WQ + (16 * ((mt0) + m_) + fr) * WQ_LD + 64 * s_ + 16 * g); } while (0)
#define LD_KD(dst, mt0) do { _Pragma("unroll") for (int m_ = 0; m_ < 4; ++m_) _Pragma("unroll") for (int s_ = 0; s_ < 2; ++s_) \
            dst[2 * m_ + s_] = *(const LAS bf16x8*)(Abuf + OFF_KD + (16 * ((mt0) + m_) + fr) * KD_LD + 64 * s_ + 16 * g); } while (0)
#define MM_W(src, mt0) do { _Pragma("unroll") for (int m_ = 0; m_ < 2; ++m_) _Pragma("unroll") for (int s_ = 0; s_ < 4; ++s_) Y[(mt0) + m_] = mfma16(src[4 * m_ + s_], bs[s_], Y[(mt0) + m_]); } while (0)
        LD_W(fa, 0); SB_();
        LD_W(fb, 2); SB_(); MM_W(fa, 0); SB_();
        LD_KD(fa, 0); SB_(); MM_W(fb, 2); SB_();
        f32x4 vn[4];
#pragma unroll
        for (int mt = 0; mt < 4; ++mt) vn[mt] = ut[mt] - Y[mt];
        bf16x8 bv[2];
#pragma unroll
        for (int s = 0; s < 2; ++s) bv[s] = pack_b(vn[2 * s], vn[2 * s + 1]);
        SB_();
        LD_KD(fb, 4); SB_();
#pragma unroll
        for (int mt = 0; mt < 4; ++mt) { X[mt] = X[mt] * eg;
#pragma unroll
            for (int s = 0; s < 2; ++s) X[mt] = mfma16(fa[2 * mt + s], bv[s], X[mt]); }
        SB_();
#pragma unroll
        for (int mt = 4; mt < 8; ++mt) { X[mt] = X[mt] * eg;
#pragma unroll
            for (int s = 0; s < 2; ++s) X[mt] = mfma16(fb[2 * (mt - 4) + s], bv[s], X[mt]); }
#undef SB_
#undef LD_W
#undef LD_KD
#undef MM_W
        asm volatile("s_waitcnt lgkmcnt(0)" ::: "memory"); __builtin_amdgcn_s_barrier(); asm volatile("" ::: "memory");
        if (n + 1 < n1) CMP_STORE(STCUR);
        asm volatile("s_waitcnt lgkmcnt(0)" ::: "memory"); __builtin_amdgcn_s_barrier(); asm volatile("" ::: "memory");
        if (n + 3 < n1) CMP_LOAD(STCUR, n + 3);
#undef STCUR
        }
        if (nb + 1 < n1) { const int n = nb + 1;
#define STCUR sty
        const unsigned char* it = items + (size_t)n * GI_BYTES;
        f32x4 ut[4];
#pragma unroll
        for (int mt = 0; mt < 4; ++mt) ut[mt] = part ? *(const GAS f32x4*)(it + GI_UT + ((size_t)col * 64 + 16 * mt + 4 * g) * 4) : (f32x4){0.f, 0.f, 0.f, 0.f};
        const float eg = *(const float*)(it + GI_EG);
        bf16x8 bs[4];
#pragma unroll
        for (int s = 0; s < 4; ++s) bs[s] = pack_b(X[2 * s], X[2 * s + 1]);
        bf16x8 fa[8], fb[8];
        f32x4 Y[4];
#pragma unroll
        for (int mt = 0; mt < 4; ++mt) Y[mt] = (f32x4){0.f, 0.f, 0.f, 0.f};
#define SB_() __builtin_amdgcn_sched_barrier(0)
#define LD_W(dst, mt0) do { _Pragma("unroll") for (int m_ = 0; m_ < 2; ++m_) _Pragma("unroll") for (int s_ = 0; s_ < 4; ++s_) \
            dst[4 * m_ + s_] = *(const LAS bf16x8*)(Abuf + OFF_WQ + (16 * ((mt0) + m_) + fr) * WQ_LD + 64 * s_ + 16 * g); } while (0)
#define LD_KD(dst, mt0) do { _Pragma("unroll") for (int m_ = 0; m_ < 4; ++m_) _Pragma("unroll") for (int s_ = 0; s_ < 2; ++s_) \
            dst[2 * m_ + s_] = *(const LAS bf16x8*)(Abuf + OFF_KD + (16 * ((mt0) + m_) + fr) * KD_LD + 64 * s_ + 16 * g); } while (0)
#define MM_W(src, mt0) do { _Pragma("unroll") for (int m_ = 0; m_ < 2; ++m_) _Pragma("unroll") for (int s_ = 0; s_ < 4; ++s_) Y[(mt0) + m_] = mfma16(src[4 * m_ + s_], bs[s_], Y[(mt0) + m_]); } while (0)
        LD_W(fa, 0); SB_();
        LD_W(fb, 2); SB_(); MM_W(fa, 0); SB_();
        LD_KD(fa, 0); SB_(); MM_W(fb, 2); SB_();
        f32x4 vn[4];
#pragma unroll
        for (int mt = 0; mt < 4; ++mt) vn[mt] = ut[mt] - Y[mt];
        bf16x8 bv[2];
#pragma unroll
        for (int s = 0; s < 2; ++s) bv[s] = pack_b(vn[2 * s], vn[2 * s + 1]);
        SB_();
        LD_KD(fb, 4); SB_();
#pragma unroll
        for (int mt = 0; mt < 4; ++mt) { X[mt] = X[mt] * eg;
#pragma unroll
            for (int s = 0; s < 2; ++s) X[mt] = mfma16(fa[2 * mt + s], bv[s], X[mt]); }
        SB_();
#pragma unroll
        for (int mt = 4; mt < 8; ++mt) { X[mt] = X[mt] * eg;
#pragma unroll
            for (int s = 0; s < 2; ++s) X[mt] = mfma16(fb[2 * (mt - 4) + s], bv[s], X[mt]); }
#undef SB_
#undef LD_W
#undef LD_KD
#undef MM_W
        asm volatile("s_waitcnt lgkmcnt(0)" ::: "memory"); __builtin_amdgcn_s_barrier(); asm volatile("" ::: "memory");
        if (n + 1 < n1) CMP_STORE(STCUR);
        asm volatile("s_waitcnt lgkmcnt(0)" ::: "memory"); __builtin_amdgcn_s_barrier(); asm volatile("" ::: "memory");
        if (n + 3 < n1) CMP_LOAD(STCUR, n + 3);
#undef STCUR
        }
    }
#undef CMP_LOAD
#undef CMP_STORE
    if (part == 0) {
        LAS bf16_t* img = (LAS bf16_t*)lds; const int pc = kperm(col);
#pragma unroll
        for (int mt = 0; mt < 8; ++mt)
#pragma unroll
            for (int r = 0; r < 4; ++r) img[(16 * mt + 4 * g + r) * 128 + pc] = f2bf_s(X[mt][r]);
        __syncthreads();
        unsigned char* dst = P.ws + WS_MG + (size_t)(h * 15 + gi) * 32768;
        for (int ch = tid; ch < 2048; ch += 512) *(GAS v4u*)(dst + ch * 16) = *(const LAS v4u*)((const LAS unsigned char*)img + ch * 16);
        __syncthreads();
    } else {
        float* dst = (float*)(P.ws + WS_CG + (size_t)(h * 15 + gi) * 65536) + (size_t)col * 128 + 4 * g;
#pragma unroll
        for (int mt = 0; mt < 8; ++mt) *(GAS f32x4*)(dst + 16 * mt) = X[mt];
    }
    DEP_PUBLISH_BEGIN() __hip_atomic_fetch_add(ctl + CW_CMP + 4 * (16 * h + gi), 1u, __ATOMIC_RELAXED, __HIP_MEMORY_SCOPE_AGENT); DEP_PUBLISH_END()
}
__device__ __forceinline__ void gdn_carry(const Params& P, int h, LAS unsigned char* lds, unsigned* ctl, int tid, int wave, int lane) {
    using namespace cfg;
    constexpr int WQ_LD = 272;
    const int fr = lane & 15, g = lane >> 4, dv = 16 * wave + fr;
    f32x4 S[8];
    { u32x4 raw[3][2][4]; float gb[2]; GDN_LOAD_GB(gb, h, 0, tid); GDN_LOAD_RAW(raw, h, 0, tid);
      gdn_prep_item(P, h, 0, raw, gb, 0, 0, false, lds, tid, wave, lane);
      asm volatile("s_waitcnt vmcnt(0)" ::: "memory");
      __syncthreads();
      if (tid == 0) { __builtin_amdgcn_fence(__ATOMIC_ACQ_REL, "agent"); asm volatile("s_waitcnt vmcnt(0)" ::: "memory"); }
      __syncthreads();
      gdn_scan(P, h, 0, 1, nullptr, S, lds, tid, wave, lane); }
#pragma unroll 1
    for (int gi = 0; gi < 16; ++gi) {
        float* sp = (float*)(P.ws + WS_SG + (size_t)(h * 16 + gi) * 65536) + (size_t)dv * 128 + 4 * g;
#pragma unroll
        for (int mt = 0; mt < 8; ++mt) *(GAS f32x4*)(sp + 16 * mt) = S[mt];
        v4u st[4];
        if (gi < 15) { dep_wait(ctl + CW_CMP + 4 * (16 * h + gi), 2u, wave);
            const unsigned char* mg = P.ws + WS_MG + (size_t)(h * 15 + gi) * 32768;
#pragma unroll
            for (int i = 0; i < 4; ++i) st[i] = *(const GAS v4u*)(mg + (size_t)(tid + 512 * i) * 16); }
        asm volatile("s_waitcnt vmcnt(0)" ::: "memory");
        __syncthreads();
        if (tid == 0) { __builtin_amdgcn_fence(__ATOMIC_RELEASE, "agent"); asm volatile("s_waitcnt vmcnt(0)" ::: "memory");
            __hip_atomic_store(ctl + CW_GFLAG + 64 * h, (unsigned)(gi + 1), __ATOMIC_RELAXED, __HIP_MEMORY_SCOPE_AGENT); }
        if (gi == 15) break;
#pragma unroll
        for (int i = 0; i < 4; ++i) { const int ch = tid + 512 * i; *(LAS v4u*)(lds + (ch >> 4) * WQ_LD + (ch & 15) * 16) = st[i]; }
        f32x4 ct[8];
        { const float* cp = (const float*)(P.ws + WS_CG + (size_t)(h * 15 + gi) * 65536) + (size_t)dv * 128 + 4 * g;
#pragma unroll
          for (int mt = 0; mt < 8; ++mt) ct[mt] = *(const GAS f32x4*)(cp + 16 * mt); }
        __syncthreads();
        bf16x8 bs[4];
#pragma unroll
        for (int s = 0; s < 4; ++s) bs[s] = pack_b(S[2 * s], S[2 * s + 1]);
#pragma unroll
        for (int mt = 0; mt < 8; ++mt) { f32x4 x = ct[mt];
#pragma unroll
            for (int s = 0; s < 4; ++s) { const bf16x8 a = *(const LAS bf16x8*)(lds + (16 * mt + fr) * WQ_LD + 64 * s + 16 * g); x = mfma16(a, bs[s], x); }
            S[mt] = x; }
        __syncthreads();
    }
}

__device__ __forceinline__ int crow(int r, int hh) { return (r & 3) + 8 * (r >> 2) + 4 * hh; }
__device__ __forceinline__ s16x4 vtr(const LAS unsigned char* p) { typedef short v4i16_t __attribute__((ext_vector_type(4))); return __builtin_bit_cast(s16x4, __builtin_amdgcn_ds_read_tr16_b64_v4i16((LAS v4i16_t*)p)); }
__device__ __forceinline__ f32x16 mfma32(bf16x8 a, bf16x8 b, f32x16 c) { return __builtin_amdgcn_mfma_f32_32x32x16_bf16(a, b, c, 0, 0, 0); }
#ifndef ATT_TIMING
#define ATT_TIMING 0
#endif
#ifndef ATT_TSEG
#define ATT_TSEG 6
#endif
#ifndef ATT_TWAVE
#define ATT_TWAVE 0
#endif
#if ATT_TIMING
#define TSTAMP(i_) asm volatile("s_memtime %0" : "=s"(ts_[i_]) :: "memory")
#define TACC(MODE) do { asm volatile("s_waitcnt lgkmcnt(0)" ::: "memory"); \
            _Pragma("unroll") for (int i_ = 0; i_ < 7; ++i_) asm volatile("" :: "s"(ts_[i_]));     \
            if ((MODE) == 1) { _Pragma("unroll") for (int i_ = 0; i_ < 6; ++i_) tacc_[i_] += (unsigned)(ts_[i_ + 1] - ts_[i_]); tacc_[6] += (unsigned)(ts_[6] - ts_[0]); tsteps_ += 1u; } } while (0)
#else
#define TSTAMP(i_) do {} while (0)
#define TACC(MODE) do {} while (0)
#endif
#ifndef ATT_STAGGER
#define ATT_STAGGER 0
#endif
#define ATT_WAIT_V(n) asm volatile("s_waitcnt vmcnt(" #n ")" ::: "memory")
__device__ __forceinline__ volatile LAS unsigned* fresh_misc(LAS unsigned char* lds) { const unsigned a = (unsigned)(uintptr_t)(lds + cfg::MISC_OFF); unsigned v; asm volatile("v_mov_b32 %0, %1" : "=v"(v) : "s"(a)); return (volatile LAS unsigned*)(uintptr_t)v; }

template <int ORD> __device__ __forceinline__ void attn_unit_t(const Params& P, int h, int qb, LAS unsigned char* lds, int tid, int wave, int lane) {
    using namespace cfg;
    asm volatile("v_mbcnt_lo_u32_b32 %0, -1, 0\n\tv_mbcnt_hi_u32_b32 %0, -1, %0" : "=v"(lane)); tid = wave * 64 + lane;
    constexpr int SLOT = 32768;
    const float negmb = __uint_as_float(fresh_misc(lds)[18]);
    const int r32 = lane & 31, hh = lane >> 5, map = wave >> 2, wq = wave & 3, hm = 2 * h + map;
    const bf16_t* qbuf = (const bf16_t*)(P.ws + WS_Q);
    const unsigned char* k1g = P.ws + WS_K + (size_t)(2 * h) * NCH * 8192;
    const unsigned char* k2g = P.ws + WS_K + (size_t)(2 * h + 1) * NCH * 8192;
    const unsigned char* vg = P.ws + WS_V + (size_t)h * NCH * 16384;
    const int NT = 2 * qb + 3;
    const unsigned lds0 = (unsigned)(uintptr_t)lds;
#define ATT_GLDS(gsrc, ldsoff) do { unsigned keep_; const unsigned dst_ = (unsigned)__builtin_amdgcn_readfirstlane((int)(lds0 + (unsigned)(ldsoff))); \
        asm volatile("s_mov_b32 %0, m0\n\ts_mov_b32 m0, %2\n\ts_nop 0\n\tglobal_load_lds_dwordx4 %1, off\n\ts_mov_b32 m0, %0" : "=&s"(keep_) : "v"(gsrc), "s"(dst_) : "memory"); } while (0)
#define ATT_DMA_K(t, koff) do { const size_t t_ = (size_t)(t); \
        ATT_GLDS(k1g + t_ * 8192 + wave * 1024 + lane * 16, (koff) + wave * 1024); \
        ATT_GLDS(k2g + t_ * 8192 + wave * 1024 + lane * 16, (koff) + 8192 + wave * 1024); } while (0)
#define ATT_DMA_V(t, voff) do { const size_t t_ = (size_t)(t); \
        ATT_GLDS(vg + t_ * 16384 + wave * 1024 + lane * 16, (voff) + wave * 1024); \
        ATT_GLDS(vg + t_ * 16384 + (wave + 8) * 1024 + lane * 16, (voff) + (wave + 8) * 1024); } while (0)
    constexpr int VRING = 49152;
    ATT_DMA_K(0, 0); ATT_DMA_V(0, VRING); ATT_DMA_K(1, 16384); ATT_DMA_V(1, VRING + 16384); ATT_DMA_K(2, 32768); ATT_DMA_V(2, VRING + 32768);
    bf16x8 qr[4];
    { const bf16_t* qp = qbuf + ((size_t)hm * 8192 + 128 * qb + 32 * wq + r32) * 64 + 8 * hh;
#pragma unroll
        for (int d0 = 0; d0 < 4; ++d0) qr[d0] = *(const bf16x8*)(qp + 16 * d0); }
    f32x16 o[4];
#pragma unroll
    for (int d0 = 0; d0 < 4; ++d0)
#pragma unroll
        for (int r = 0; r < 16; ++r) o[d0][r] = 0.f;
    float lsum = 0.f;
    const int qrel = 32 * wq + r32;
    const int vb0 = ((lane >> 4) & 1) * 32 + (lane & 3) * 8 + (4 * hh + ((lane & 15) >> 2)) * 64;
    const int kb0 = map * 8192 + hh * 1024 + r32 * 16;
#define ATT_QK(P0, P1, slotoff) do { const LAS unsigned char* Ks_ = lds + (slotoff) + kb0; \
        _Pragma("unroll") for (int r_ = 0; r_ < 16; ++r_) { P0[r_] = negmb; P1[r_] = negmb; } \
        _Pragma("unroll") for (int d0_ = 0; d0_ < 4; ++d0_) { \
            const bf16x8 ka_ = *(const LAS bf16x8*)(Ks_ + d0_ * 2048); const bf16x8 kb_ = *(const LAS bf16x8*)(Ks_ + d0_ * 2048 + 512); \
            P0 = mfma32(ka_, qr[d0_], P0); P1 = mfma32(kb_, qr[d0_], P1); } } while (0)
    f32x16 p0, p1;
    ATT_WAIT_V(8);
    __builtin_amdgcn_s_barrier();
    asm volatile("" ::: "memory");
    ATT_QK(p0, p1, 0);
#define SB_() __builtin_amdgcn_sched_barrier(0)
#define LD_V(dst, d0_) do { _Pragma("unroll") for (int s_ = 0; s_ < 4; ++s_) { const s16x4 lo_ = vtr(Vs + (d0_) * 4096 + s_ * 1024), hi_ = vtr(Vs + (d0_) * 4096 + s_ * 1024 + 512); \
            dst[s_] = (bf16x8){lo_[0], lo_[1], lo_[2], lo_[3], hi_[0], hi_[1], hi_[2], hi_[3]}; } } while (0)
#define ATT_PV() do { \
        LD_V(vb, 1); SB_(); \
        _Pragma("unroll") for (int s2 = 0; s2 < 4; ++s2) o[0] = mfma32(pw[s2], va[s2], o[0]); \
        SB_(); LD_V(va, 2); SB_(); \
        _Pragma("unroll") for (int s2 = 0; s2 < 4; ++s2) o[1] = mfma32(pw[s2], vb[s2], o[1]); \
        SB_(); LD_V(vb, 3); SB_(); \
        _Pragma("unroll") for (int s2 = 0; s2 < 4; ++s2) o[2] = mfma32(pw[s2], va[s2], o[2]); \
        SB_(); \
        _Pragma("unroll") for (int s2 = 0; s2 < 4; ++s2) o[3] = mfma32(pw[s2], vb[s2], o[3]); \
        SB_(); } while (0)
#define ATT_PV_B() do { \
        LD_V(vb, 1); LD_V(va, 2); SB_(); \
        _Pragma("unroll") for (int s2 = 0; s2 < 4; ++s2) o[0] = mfma32(pw[s2], pva[s2], o[0]); \
        SB_(); \
        _Pragma("unroll") for (int s2 = 0; s2 < 4; ++s2) o[1] = mfma32(pw[s2], vb[s2], o[1]); \
        SB_(); LD_V(vb, 3); SB_(); \
        _Pragma("unroll") for (int s2 = 0; s2 < 4; ++s2) o[2] = mfma32(pw[s2], va[s2], o[2]); \
        SB_(); \
        _Pragma("unroll") for (int s2 = 0; s2 < 4; ++s2) o[3] = mfma32(pw[s2], vb[s2], o[3]); \
        SB_(); } while (0)
#define ATT_STEP(t_, MODE, HAS_NEXT, ORD) do { const int t = (t_); \
        TSTAMP(0); \
        if (t + 2 < NT) ATT_WAIT_V(4); else ATT_WAIT_V(0);                       \
        __builtin_amdgcn_s_barrier(); \
        asm volatile("" ::: "memory"); \
        TSTAMP(1); \
        const int kn = (kmod == 2) ? 0 : kmod + 1, vp = (vmod == 0) ? 4 : vmod - 1, vd = (vmod >= 2) ? vmod - 2 : vmod + 3;     \
        if (t + 3 < NT) { ATT_DMA_K(t + 3, kmod * 16384); ATT_DMA_V(t + 3, VRING + vd * 16384); }     \
        TSTAMP(2); \
        const LAS unsigned char* Vs = lds + VRING + ((ORD) ? vp : vmod) * 16384 + vb0; \
        const LAS unsigned char* Kn = lds + kn * 16384 + kb0; \
        bf16x8 kf[8], va[4], vb[4]; \
        if (!(ORD)) LD_V(va, 0); \
        if ((MODE) != 0 && (ORD)) ATT_PV_B();                                     \
        if (HAS_NEXT) { \
            _Pragma("unroll") for (int d0 = 0; d0 < 4; ++d0) { kf[2 * d0] = *(const LAS bf16x8*)(Kn + d0 * 2048); kf[2 * d0 + 1] = *(const LAS bf16x8*)(Kn + d0 * 2048 + 512); } } \
        SB_(); \
        TSTAMP(3); SB_(); \
          \
        if ((MODE) == 0) { \
            _Pragma("unroll") for (int r = 0; r < 16; ++r) { p0[r] = 0.f; p1[r] = (r < 8) ? 0.f : __builtin_amdgcn_exp2f(p1[r]); } \
        } else { \
            _Pragma("unroll") for (int r = 0; r < 16; ++r) { p0[r] = __builtin_amdgcn_exp2f(p0[r]); p1[r] = __builtin_amdgcn_exp2f(p1[r]); } \
            if ((MODE) == 2) { const int thr = qrel - 64 * (t - (NT - 2)); \
                _Pragma("unroll") for (int r = 0; r < 16; ++r) { const int kv = crow(r, hh); if (kv > thr) p0[r] = 0.f; if (kv + 32 > thr) p1[r] = 0.f; } } \
        } \
        float sacc = 0.f; \
        _Pragma("unroll") for (int r = 0; r < 16; ++r) sacc += p0[r] + p1[r]; \
        lsum += sacc; \
        { u32x4 w; \
          w.x = pg8::cvt_pk_bf16(p0[0], p0[1]); w.y = pg8::cvt_pk_bf16(p0[2], p0[3]); w.z = pg8::cvt_pk_bf16(p0[4], p0[5]); w.w = pg8::cvt_pk_bf16(p0[6], p0[7]); pw[0] = __builtin_bit_cast(bf16x8, w); \
          w.x = pg8::cvt_pk_bf16(p0[8], p0[9]); w.y = pg8::cvt_pk_bf16(p0[10], p0[11]); w.z = pg8::cvt_pk_bf16(p0[12], p0[13]); w.w = pg8::cvt_pk_bf16(p0[14], p0[15]); pw[1] = __builtin_bit_cast(bf16x8, w); \
          w.x = pg8::cvt_pk_bf16(p1[0], p1[1]); w.y = pg8::cvt_pk_bf16(p1[2], p1[3]); w.z = pg8::cvt_pk_bf16(p1[4], p1[5]); w.w = pg8::cvt_pk_bf16(p1[6], p1[7]); pw[2] = __builtin_bit_cast(bf16x8, w); \
          w.x = pg8::cvt_pk_bf16(p1[8], p1[9]); w.y = pg8::cvt_pk_bf16(p1[10], p1[11]); w.z = pg8::cvt_pk_bf16(p1[12], p1[13]); w.w = pg8::cvt_pk_bf16(p1[14], p1[15]); pw[3] = __builtin_bit_cast(bf16x8, w); } \
        SB_(); \
        TSTAMP(4); SB_(); \
          \
        if (HAS_NEXT) { \
            _Pragma("unroll") for (int r = 0; r < 16; ++r) { p0[r] = negmb; p1[r] = negmb; } \
            _Pragma("unroll") for (int d0 = 0; d0 < 4; ++d0) { p0 = mfma32(kf[2 * d0], qr[d0], p0); p1 = mfma32(kf[2 * d0 + 1], qr[d0], p1); } } \
        SB_(); \
        TSTAMP(5); SB_(); \
        if (!(ORD)) ATT_PV();                                                    \
        else { const LAS unsigned char* Vs = lds + VRING + vmod * 16384 + vb0; LD_V(pva, 0); }     \
        TSTAMP(6); \
        TACC(MODE); \
        kmod = kn; vmod = (vmod == 4) ? 0 : vmod + 1; } while (0)
    bf16x8 pw[4], pva[4];
#pragma unroll
    for (int i = 0; i < 4; ++i) { pw[i] = (bf16x8){0, 0, 0, 0, 0, 0, 0, 0}; pva[i] = pw[i]; }
    int kmod = 0, vmod = 0;
#if ATT_TIMING
    unsigned long long ts_[7]; unsigned tacc_[7] = {0u, 0u, 0u, 0u, 0u, 0u, 0u}, tsteps_ = 0u;
#endif
    if (!ORD) __builtin_amdgcn_s_setprio(1);
    ATT_STEP(0, 0, true, ORD);
#pragma unroll 1
    for (int ti = 1; ti < NT - 2; ++ti) ATT_STEP(ti, 1, true, ORD);
    ATT_STEP(NT - 2, 2, true, ORD);
    ATT_STEP(NT - 1, 2, false, ORD);
    if (ORD) { const LAS unsigned char* Vs = lds + VRING + ((vmod == 0) ? 4 : vmod - 1) * 16384 + vb0;
        bf16x8 va[4], vb[4];
        ATT_PV_B(); }
    if (!ORD) __builtin_amdgcn_s_setprio(0);
#if ATT_TIMING
    if (blockIdx.x == 100 && qb >= 32 && wave == ATT_TWAVE && tsteps_ > 0u) { int l3_; asm volatile("v_mbcnt_lo_u32_b32 %0, -1, 0\n\tv_mbcnt_hi_u32_b32 %0, -1, %0" : "=v"(l3_));
        if (l3_ == 0) __hip_atomic_store((float*)(P.ws + WS_CTL) + 7700, exp2f(rintf(log2f((float)tacc_[ATT_TSEG] / (float)tsteps_ + 1.0f) * 3.0f) * (1.0f / 3.0f)), __ATOMIC_RELAXED, __HIP_MEMORY_SCOPE_AGENT); }
#endif
#undef ATT_STEP
#undef ATT_PV
#undef ATT_PV_B
#undef SB_
#undef LD_V
#undef ATT_QK
    { int l2_; asm volatile("v_mbcnt_lo_u32_b32 %0, -1, 0\n\tv_mbcnt_hi_u32_b32 %0, -1, %0" : "=v"(l2_));
      lsum += __builtin_bit_cast(float, __builtin_amdgcn_ds_bpermute((l2_ ^ 32) << 2, __builtin_bit_cast(int, lsum))); }
    asm volatile("s_waitcnt lgkmcnt(0)" ::: "memory"); __builtin_amdgcn_s_barrier(); asm volatile("" ::: "memory");
    LAS float* wsf = (LAS float*)(lds + 131072) + wave * 32;
    LAS float* Xc = (LAS float*)lds;
    if (hh == 0) wsf[r32] = lsum;
    asm volatile("s_waitcnt lgkmcnt(0)" ::: "memory");
    float rl[16];
#pragma unroll
    for (int r = 0; r < 16; ++r) rl[r] = 1.0f / wsf[crow(r, hh)];
    if (map == 1) {
#pragma unroll
        for (int d0 = 0; d0 < 4; ++d0)
#pragma unroll
            for (int r = 0; r < 16; ++r) Xc[(32 * wq + crow(r, hh)) * 132 + 32 * d0 + r32] = o[d0][r] * rl[r];
    }
    __syncthreads();
    if (map == 0) { const float lam = __uint_as_float(fresh_misc(lds)[17]);
#pragma unroll
        for (int d0 = 0; d0 < 4; ++d0)
#pragma unroll
            for (int r = 0; r < 16; ++r) { LAS float* xp = Xc + (32 * wq + crow(r, hh)) * 132 + 32 * d0 + r32; *xp = o[d0][r] * rl[r] - lam * (*xp); }
    }
    __syncthreads();
    {
        const int row = tid >> 2, seg = tid & 3; float v[32]; float ss = 0.f;
#pragma unroll
        for (int i = 0; i < 8; ++i) { const f32x4 x4 = *(const LAS f32x4*)(Xc + row * 132 + 32 * seg + 4 * i); v[4 * i] = x4[0]; v[4 * i + 1] = x4[1]; v[4 * i + 2] = x4[2]; v[4 * i + 3] = x4[3];
            ss += (x4[0] * x4[0] + x4[1] * x4[1]) + (x4[2] * x4[2] + x4[3] * x4[3]); }
        ss += __shfl_xor(ss, 1); ss += __shfl_xor(ss, 2);
        const float rn = __builtin_amdgcn_rsqf(ss * (1.0f / 128.0f) + 1e-6f) * 0.8f;
        const float* gp = P.diff_norm + 32 * seg;
        bf16_t* mp = (bf16_t*)(P.ws + WS_MIX) + (size_t)(128 * qb + row) * 2048 + 1024 + h * 128 + 32 * seg;
#pragma unroll
        for (int i = 0; i < 4; ++i) { const f32x4 g0 = *(const f32x4*)(gp + 8 * i), g1 = *(const f32x4*)(gp + 8 * i + 4); u32x4 w;
            w.x = pk2(v[8 * i] * rn * g0[0], v[8 * i + 1] * rn * g0[1]); w.y = pk2(v[8 * i + 2] * rn * g0[2], v[8 * i + 3] * rn * g0[3]);
            w.z = pk2(v[8 * i + 4] * rn * g1[0], v[8 * i + 5] * rn * g1[1]); w.w = pk2(v[8 * i + 6] * rn * g1[2], v[8 * i + 7] * rn * g1[3]);
            *(u32x4*)(mp + 8 * i) = w; }
    }
    __syncthreads();
#undef ATT_DMA
#undef ATT_GLDS
}

__device__ __forceinline__ void attn_unit(const Params& P, int h, int qb, LAS unsigned char* lds, int tid, int wave, int lane) {
    if (__builtin_amdgcn_readfirstlane(wave) < 4) attn_unit_t<0>(P, h, qb, lds, tid, wave, lane); else attn_unit_t<1>(P, h, qb, lds, tid, wave, lane);
}
__device__ __forceinline__ void attn_phase(const Params& P, LAS unsigned char* lds, unsigned* ctl, unsigned* qhead, unsigned xcc, volatile LAS unsigned* misc, int tid, int wave, int lane) {
    using namespace cfg;
    { const float a1 = P.lq1[lane] * P.lk1[lane], a2 = P.lq2[lane] * P.lk2[lane]; float gq = fabsf(P.q_norm[lane]), gk = fabsf(P.k_norm[lane]);
      const float d1 = wave_sum(a1), d2 = wave_sum(a2);
#pragma unroll
      for (int o = 1; o < 64; o <<= 1) { int l_; asm volatile("v_mbcnt_lo_u32_b32 %0, -1, 0\n\tv_mbcnt_hi_u32_b32 %0, -1, %0" : "=v"(l_));
          const int ix_ = (l_ ^ o) << 2;
          gq = fmaxf(gq, __builtin_bit_cast(float, __builtin_amdgcn_ds_bpermute(ix_, __builtin_bit_cast(int, gq)))); gk = fmaxf(gk, __builtin_bit_cast(float, __builtin_amdgcn_ds_bpermute(ix_, __builtin_bit_cast(int, gk)))); }
      volatile LAS unsigned* m_ = fresh_misc(lds); m_[17] = __float_as_uint(__expf(d1) - __expf(d2) + 0.2f);
      m_[18] = __float_as_uint(-(0.18033688011112042f * 64.0f * gq * gk * 1.02f)); }
    int q = (int)(xcc & 7u);
    for (;;) {
        { int l_; asm volatile("v_mbcnt_lo_u32_b32 %0, -1, 0\n\tv_mbcnt_hi_u32_b32 %0, -1, %0" : "=v"(l_));
          if (wave == 0 && l_ == 0) { unsigned item = 0xffffffffu; int qq = q;
              for (int k = 0; k < 8; ++k) { const unsigned v = __hip_atomic_fetch_add(qhead + 64 * qq, 1u, __ATOMIC_RELAXED, __HIP_MEMORY_SCOPE_AGENT); if (v < 80u) { item = v | ((unsigned)qq << 8); break; } qq = (qq + 1) & 7; }
              fresh_misc(lds)[16] = item; } }
        __syncthreads();
        const unsigned it_ = (unsigned)__builtin_amdgcn_readfirstlane((int)fresh_misc(lds)[16]);
        __syncthreads();
        if (it_ == 0xffffffffu) break;
        const unsigned u = it_ & 0xffu; q = (int)(it_ >> 8);
        const int h = q;
        if (u >= 32u && u < 48u) {
            const int gi = (int)u - 32;
            const float* sinit = nullptr;
            {
                int l_; asm volatile("v_mbcnt_lo_u32_b32 %0, -1, 0\n\tv_mbcnt_hi_u32_b32 %0, -1, %0" : "=v"(l_));
                if (wave == 0 && l_ == 0) { unsigned sp = 0; while (__hip_atomic_load(ctl + CW_GFLAG + 64 * h, __ATOMIC_RELAXED, __HIP_MEMORY_SCOPE_AGENT) < (unsigned)(gi + 1)) { __builtin_amdgcn_s_sleep(8); if (++sp > (1u << 22)) break; }
                    sp = 0; while (__hip_atomic_load(ctl + CW_P2C + 4 * (16 * h + gi), __ATOMIC_RELAXED, __HIP_MEMORY_SCOPE_AGENT) < 8u) { __builtin_amdgcn_s_sleep(8); if (++sp > (1u << 22)) break; }
                    __builtin_amdgcn_fence(__ATOMIC_ACQUIRE, "agent"); asm volatile("s_waitcnt vmcnt(0)" ::: "memory"); }
                __syncthreads();
                sinit = (const float*)(P.ws + WS_SG + (size_t)(h * 16 + gi) * 65536);
            }
            gdn_scan(P, h, grp_start(gi), 8 * gi + 9, sinit, nullptr, lds, tid, wave, lane);
        } else {
            const int qb = (u < 32u) ? 63 - (int)u : 79 - (int)u;
            attn_unit(P, h, qb, lds, tid, wave, lane);
        }
    }
}

#ifndef PROBE_DUP
#define PROBE_DUP -1
#endif
#define PHASE_BEGIN() const CAS Params* pp_ = (const CAS Params*)__builtin_amdgcn_kernarg_segment_ptr(); asm volatile("" : "+s"(pp_)); Params P; P.x = (const float*)(const GAS float*)pp_->x; P.meta = (const float*)(const GAS float*)pp_->meta; P.attn_norm = (const float*)(const GAS float*)pp_->attn_norm; P.w_in = (const float*)(const GAS float*)pp_->w_in; P.conv_w = (const float*)(const GAS float*)pp_->conv_w; P.a_log = (const float*)(const GAS float*)pp_->a_log; P.dt_bias = (const float*)(const GAS float*)pp_->dt_bias; P.gdn_norm = (const float*)(const GAS float*)pp_->gdn_norm; P.q_norm = (const float*)(const GAS float*)pp_->q_norm; P.k_norm = (const float*)(const GAS float*)pp_->k_norm; P.lq1 = (const float*)(const GAS float*)pp_->lq1; P.lk1 = (const float*)(const GAS float*)pp_->lk1; P.lq2 = (const float*)(const GAS float*)pp_->lq2; P.lk2 = (const float*)(const GAS float*)pp_->lk2; P.diff_norm = (const float*)(const GAS float*)pp_->diff_norm; P.w_out = (const float*)(const GAS float*)pp_->w_out; P.ffn_norm = (const float*)(const GAS float*)pp_->ffn_norm; P.w_gu = (const float*)(const GAS float*)pp_->w_gu; P.w_dn = (const float*)(const GAS float*)pp_->w_dn; P.out = (float*)(GAS float*)pp_->out; P.ws = (unsigned char*)(GAS unsigned char*)pp_->ws; \
    int tid; asm volatile("v_mbcnt_lo_u32_b32 %0, -1, 0\n\tv_mbcnt_hi_u32_b32 %0, -1, %0" : "=v"(tid)); tid += wave0_ * 64; const int lane = tid & 63, wave = __builtin_amdgcn_readfirstlane(tid >> 6); \
    const int G = gridDim.x, bx = blockIdx.x, vcu = (G % 8 == 0) ? (bx % 8) * (G / 8) + bx / 8 : bx; (void)lane; (void)wave; (void)vcu; (void)bx
__global__ void __launch_bounds__(512, 2) hymba_fwd(Params Pk) {
    using namespace cfg;
    extern __shared__ __attribute__((aligned(16))) unsigned char lds_raw[];
    LAS unsigned char* lds = (LAS unsigned char*)lds_raw;
    volatile LAS unsigned* MISC = (volatile LAS unsigned*)(lds + MISC_OFF);
    const int wave0_ = __builtin_amdgcn_readfirstlane((int)threadIdx.x >> 6);
    XcdBarrier bar;
    {
        PHASE_BEGIN();
        unsigned* ctl = (unsigned*)(P.ws + WS_CTL);
        if (tid < 64) MISC[tid] = 0u;
        __syncthreads();
        bar = xcd_barrier_post(ctl + CW_BAR, MISC + 8);
    }

    for (int rep_ = 0; rep_ < (PROBE_DUP == 0 ? 2 : 1); ++rep_) {
    { PHASE_BEGIN(); p0_prep(P, lds, vcu, G, wave, lane); }
    xcd_barrier(bar); }
    if (PROBE_DUP == 10) { for (int i_ = 0; i_ < 8; ++i_) xcd_barrier(bar); }
    for (int rep_ = 0; rep_ < (PROBE_DUP == 1 ? 2 : 1); ++rep_) {
        PHASE_BEGIN();
        pg8::Gemm g{(const bf16_t*)(P.ws + WS_APAD), (const bf16_t*)(P.ws + WS_WIN), MP, NPROJ, 2048}; pg8::StaticOrder S; S.init(MP, NPROJ, G, bx);
        pg8::EpiInProj E{(const float*)(P.ws + WS_RSTD), (bf16_t*)(P.ws + WS_GRAW), (bf16_t*)(P.ws + WS_Q), (bf16_t*)(P.ws + WS_K), (bf16_t*)(P.ws + WS_V),
                         (float*)(P.ws + WS_BETA), (float*)(P.ws + WS_GDEC), P.q_norm, P.k_norm, P.a_log, P.dt_bias};
        pg8::gemm_phase<pg8::EpiInProj, pg8::StaticOrder, true, true>(lds, g, S, E, tid);
        { constexpr int NU = (MP / 256) * (NPROJ / 256), FIRST_IDLE = NU - (NU / 256) * 256;
          if (G == 256 && bx >= FIRST_IDLE && P1_IDLE_MASK && rep_ == 0) p0_convert(P, lds, (bx - FIRST_IDLE) * 8 + wave, (256 - FIRST_IDLE) * 8, wave, lane, P1_IDLE_MASK, GU_SPLIT, 32);
          else if (G != 256 && P1_IDLE_MASK && rep_ == 0) p0_convert(P, lds, vcu * 8 + wave, G * 8, wave, lane, P1_IDLE_MASK, GU_SPLIT, 32); }
        xcd_barrier(bar);
    }
    for (int rep_ = 0; rep_ < (PROBE_DUP == 2 ? 2 : 1); ++rep_) {
    { PHASE_BEGIN(); u32x4 raw[3][2][4]; float gb[2] = {0.f, 0.f};
      if (vcu < 1024) { GDN_LOAD_GB(gb, vcu & 7, (vcu >> 3) + 1, tid); GDN_LOAD_RAW(raw, vcu & 7, (vcu >> 3) + 1, tid); }
      for (int it = vcu; it < 1024; it += G) { const int nx = it + G; gdn_prep_item(P, it & 7, (it >> 3) + 1, raw, gb, nx & 7, (nx >> 3) + 1, nx < 1024, lds, tid, wave, lane); }
      DEP_PUBLISH_BEGIN() for (int it = vcu; it < 1024; it += G) __hip_atomic_fetch_add((unsigned*)(P.ws + WS_CTL) + CW_P2C + 4 * (16 * (it & 7) + (it >> 6)), 1u, __ATOMIC_RELAXED, __HIP_MEMORY_SCOPE_AGENT); DEP_PUBLISH_END() } }
    for (int rep_ = 0; rep_ < (PROBE_DUP == 7 ? 2 : 1); ++rep_) {
    { PHASE_BEGIN(); for (int it = bx; it < 240; it += G) { const int r_ = it >> 3; gdn_compose(P, it & 7, r_ >> 1, r_ & 1, lds, (unsigned*)(P.ws + WS_CTL), tid, wave, lane); } } }
    for (int rep_ = 0; rep_ < (PROBE_DUP == 3 ? 2 : 1); ++rep_) {
    if (blockIdx.x < 8) { PHASE_BEGIN(); gdn_carry(P, bx, lds, (unsigned*)(P.ws + WS_CTL) + 8192 * rep_, tid, wave, lane); }
    { PHASE_BEGIN(); attn_phase(P, lds, (unsigned*)(P.ws + WS_CTL) + 8192 * rep_, (unsigned*)(P.ws + WS_CTL) + 8192 * rep_ + CW_ATTQ, bar.x, MISC, tid, wave, lane); }
    xcd_barrier(bar); }
    for (int rep_ = 0; rep_ < (PROBE_DUP == 8 ? 2 : 1); ++rep_) {
        PHASE_BEGIN();
        pg8::Gemm g{(const bf16_t*)(P.ws + WS_MIX), (const bf16_t*)(P.ws + WS_WOUT), 8192, 2048, 2048}; pg8::StaticOrder S; S.init(8192, 2048, G, bx);
        pg8::EpiOutProj E{P.x, (bf16_t*)(P.ws + WS_H1B), (float*)(P.ws + WS_SSQ)};
        pg8::gemm_phase<pg8::EpiOutProj, pg8::StaticOrder, true, true>(lds, g, S, E, tid);
        xcd_barrier(bar);
    }
    for (int rep_ = 0; rep_ < (PROBE_DUP == 5 ? 2 : 1); ++rep_) {
        PHASE_BEGIN();
        pg8::Gemm g{(const bf16_t*)(P.ws + WS_H1B), (const bf16_t*)(P.ws + WS_WGU), 8192, 2 * DFF, 2048}; pg8::StaticOrder S; S.init(8192, 2 * DFF, G, bx);
        LAS float* rs2 = (LAS float*)(lds + 131072); int rs2_pm = -1;
        { pg8::Unit u0; if (S.next(0, u0)) { rs2_pm = u0.pm;
            if (tid < 256) { const pg8::f32x4* sp = (const pg8::f32x4*)((const float*)(P.ws + WS_SSQ) + (size_t)(256 * u0.pm + tid) * 32); pg8::f32x4 s4 = sp[0];
#pragma unroll
                for (int i = 1; i < 8; ++i) s4 += sp[i];
                rs2[tid] = __builtin_amdgcn_rsqf(((s4[0] + s4[1]) + (s4[2] + s4[3])) * (1.0f / 2048.0f) + 1e-6f); } }
          __syncthreads(); }
        pg8::EpiGateUp E{(const float*)(P.ws + WS_SSQ), (bf16_t*)(P.ws + WS_HID), rs2, rs2_pm};
        pg8::gemm_phase<pg8::EpiGateUp, pg8::StaticOrder, true, true>(lds, g, S, E, tid);
        { constexpr int NU = 32 * 44, FIRST_IDLE = NU - (NU / 256) * 256;
          if (G == 256 && bx >= FIRST_IDLE && P5_IDLE_MASK && rep_ == 0) p0_convert(P, lds, (bx - FIRST_IDLE) * 8 + wave, (256 - FIRST_IDLE) * 8, wave, lane, P5_IDLE_MASK);
          else if (G != 256 && P5_IDLE_MASK && rep_ == 0) p0_convert(P, lds, vcu * 8 + wave, G * 8, wave, lane, P5_IDLE_MASK); }
        xcd_barrier(bar);
    }
    for (int rep_ = (PROBE_DUP == 9 ? 0 : 1); rep_ < 2; ++rep_) {
        PHASE_BEGIN();
        pg8::Gemm g{(const bf16_t*)(P.ws + WS_HID), (const bf16_t*)(P.ws + WS_WDN), 8192, 2048, DFF}; pg8::StaticOrder S; S.init(8192, 2048, G, bx);
        pg8::EpiDown E{(const bf16_t*)(P.ws + WS_H1B), rep_ == 1 ? P.out : (float*)(P.ws + WS_GDNP)};
        pg8::gemm_phase<pg8::EpiDown, pg8::StaticOrder, true, true>(lds, g, S, E, tid);
        if (rep_ == 0) xcd_barrier(bar);
    }
#if ATT_TIMING
    xcd_barrier(bar);
    { PHASE_BEGIN(); if (bx == 0 && tid == 0) P.out[0] = __hip_atomic_load((float*)(P.ws + WS_CTL) + 7700, __ATOMIC_RELAXED, __HIP_MEMORY_SCOPE_AGENT); }
#endif
}

extern "C" void kernel_launch(void* const* d_in, const int* in_sizes, int n_in, void* d_out, int out_size, void* d_ws, size_t ws_size, hipStream_t stream) {
    using namespace cfg;
    static int grid = 0;
    if (grid == 0) {
        if (n_in != 19 || in_sizes[0] != SEQ * DMODEL || out_size != SEQ * DMODEL || ws_size < WS_END) {
            fprintf(stderr, "kernel_launch: unexpected shapes (n_in %d, in0 %d, out %d, ws %zu, need %zu); nothing launched\n", n_in, n_in > 0 ? in_sizes[0] : -1, out_size, ws_size, (size_t)WS_END); grid = -1; return; }
        int dev = 0, cus = 0, per_cu = 0;
        if (hipGetDevice(&dev) != hipSuccess || hipDeviceGetAttribute(&cus, hipDeviceAttributeMultiprocessorCount, dev) != hipSuccess) { fprintf(stderr, "kernel_launch: device query failed\n"); grid = -1; return; }
        if (hipFuncSetAttribute((const void*)hymba_fwd, hipFuncAttributeMaxDynamicSharedMemorySize, LDS_BYTES) != hipSuccess) { fprintf(stderr, "kernel_launch: hipFuncSetAttribute failed\n"); grid = -1; return; }
        if (hipOccupancyMaxActiveBlocksPerMultiprocessor(&per_cu, (const void*)hymba_fwd, 512, LDS_BYTES) != hipSuccess || per_cu < 1)
            fprintf(stderr, "kernel_launch: note: occupancy query reports %d workgroups per CU\n", per_cu);
        (void)hipGetLastError();
        grid = cus;
    }
    if (grid < 0) return;
    if (hipMemsetAsync((char*)d_ws + WS_CTL, 0, CTL_ZERO_BYTES, stream) != hipSuccess) { fprintf(stderr, "kernel_launch: memset failed\n"); return; }
    Params p{};
    const float** pp = (const float**)&p;
    for (int i = 0; i < 19; ++i) pp[i] = (const float*)d_in[i];
    p.out = (float*)d_out; p.ws = (unsigned char*)d_ws;
    hipLaunchKernelGGL(hymba_fwd, dim3(grid), dim3(512), LDS_BYTES, stream, p);
    const hipError_t le = hipPeekAtLastError();
    if (le != hipSuccess) fprintf(stderr, "kernel_launch: launch failed: %s\n", hipGetErrorName(le));
}
```
